# Optimizing an MI355X kernel written in HIP

```python
import math
import jax, jax.numpy as jnp
from jax import lax
import numpy as np

D_MODEL = 2048
BATCH = 4
SEQ = 4096
DEPTH = 1

N_META = 16
GLA_HEADS = 4
GLA_DK = 256
GLA_DV = 512
GLA_LOWRANK = 16
GLA_TAU = 16.0
GLA_CHUNK = 64
DIFF_HEADS = 8
DIFF_HD = 128
Q_BLOCK = 128
D_FF = 5504
EPS = 1e-6

GLA_QK_W = GLA_HEADS * GLA_DK
GLA_V_W = GLA_HEADS * GLA_DV
DIFF_QK_W = DIFF_HEADS * 2 * DIFF_HD
DIFF_V_W = DIFF_HEADS * 2 * DIFF_HD
IN_SIZES = [GLA_QK_W, GLA_QK_W, GLA_V_W, GLA_V_W, GLA_LOWRANK, GLA_LOWRANK,
            DIFF_QK_W, DIFF_QK_W, DIFF_V_W, D_MODEL, D_MODEL]
IN_W = int(sum(IN_SIZES))
IN_SPLITS = [int(c) for c in np.cumsum(IN_SIZES)[:-1]]

kernel_name = "hybrid_gla_diffattn_macaron_block"


def rms_norm(x, g):
    xf = x.astype(jnp.float32)
    y = xf * lax.rsqrt(jnp.mean(xf * xf, axis=-1, keepdims=True) + EPS)
    return (y * g.astype(jnp.float32)).astype(x.dtype)


def swiglu(x, w_gate, w_up, w_down):
    return (jax.nn.silu(x @ w_gate) * (x @ w_up)) @ w_down


def alibi_slopes(n_heads):
    return jnp.asarray(np.array([2.0 ** (-8.0 * (i + 1) / n_heads) for i in range(n_heads)], np.float32))


def diff_lambda_init(layer_idx):
    return 0.8 - 0.6 * math.exp(-0.3 * layer_idx)


def gla_chunked(q, k, v, log_a, strict):
    B, H, P, dk = q.shape
    dv = v.shape[-1]
    n = P // GLA_CHUNK
    C = GLA_CHUNK
    q = q.reshape(B, H, n, C, dk)
    k = k.reshape(B, H, n, C, dk)
    v = v.reshape(B, H, n, C, dv)
    b = jnp.cumsum(log_a.reshape(B, H, n, C, dk), axis=3)
    b_last = b[:, :, :, -1:, :]
    q_dec = q * jnp.exp(b)
    k_inv = k * jnp.exp(-b)
    k_end = k * jnp.exp(b_last - b)
    mask = jnp.tril(jnp.ones((C, C), dtype=bool), k=-1 if strict else 0)
    scores = jnp.einsum('bhnik,bhnjk->bhnij', q_dec, k_inv)
    o_intra = jnp.einsum('bhnij,bhnjv->bhniv', jnp.where(mask, scores, 0.0), v)

    def step(state, xs):
        qd, ke, vc, dl = xs
        o = jnp.einsum('bhck,bhkv->bhcv', qd, state)
        state = state * dl[..., None] + jnp.einsum('bhck,bhcv->bhkv', ke, vc)
        return state, o

    xs = (jnp.moveaxis(q_dec, 2, 0), jnp.moveaxis(k_end, 2, 0), jnp.moveaxis(v, 2, 0),
          jnp.moveaxis(jnp.exp(b_last[:, :, :, 0, :]), 2, 0))
    state0 = jnp.zeros((B, H, dk, dv), jnp.float32)
    _, o_inter = lax.scan(step, state0, xs)
    o = o_intra + jnp.moveaxis(o_inter, 0, 2)
    return o.reshape(B, H, P, dv)


def gla_branch(p_q, p_k, p_v, p_r, p_af, p_ab, wa2_f, ba_f, wa2_b, ba_b, norm_w):
    B, L, _ = p_q.shape
    in_dtype = p_q.dtype

    def heads(t, d):
        return t.reshape(B, L, GLA_HEADS, d).transpose(0, 2, 1, 3).astype(jnp.float32)

    q = heads(p_q, GLA_DK) * (GLA_DK ** -0.5)
    k = heads(p_k, GLA_DK)
    v = heads(p_v, GLA_DV)
    log_af = heads(jax.nn.log_sigmoid((p_af @ wa2_f + ba_f).astype(jnp.float32)) / GLA_TAU, GLA_DK)
    log_ab = heads(jax.nn.log_sigmoid((p_ab @ wa2_b + ba_b).astype(jnp.float32)) / GLA_TAU, GLA_DK)
    pad = (-N_META) % GLA_CHUNK

    def padt(t):
        return jnp.pad(t, ((0, 0), (0, 0), (pad, 0), (0, 0)))

    def flip(t):
        return jnp.flip(t, axis=2)

    q, k, v, log_af, log_ab = padt(q), padt(k), padt(v), padt(log_af), padt(log_ab)
    o_fwd = gla_chunked(q, k, v, log_af, strict=False)
    o_bwd = flip(gla_chunked(flip(q), flip(k), flip(v), flip(log_ab), strict=True))
    o = (o_fwd + o_bwd)[:, :, pad:]
    o = rms_norm(o, norm_w)
    o = o.transpose(0, 2, 1, 3).reshape(B, L, GLA_V_W).astype(in_dtype)
    return o * jax.nn.silu(p_r)


def diff_branch(p_q, p_k, p_v, lq1, lk1, lq2, lk2, norm_w, lambda_init):
    B, L, _ = p_q.shape
    q = p_q.reshape(B, L, DIFF_HEADS, 2, DIFF_HD).transpose(3, 0, 2, 1, 4) * (DIFF_HD ** -0.5)
    k = p_k.reshape(B, L, DIFF_HEADS, 2, DIFF_HD).transpose(3, 0, 2, 1, 4)
    v = p_v.reshape(B, L, DIFF_HEADS, 2 * DIFF_HD).transpose(0, 2, 1, 3)
    lam = (jnp.exp(jnp.sum(lq1 * lk1)) - jnp.exp(jnp.sum(lq2 * lk2)) + lambda_init).astype(jnp.float32)
    pos = jnp.arange(L)
    slopes = alibi_slopes(DIFF_HEADS)
    k1, k2 = k[0], k[1]

    def attend(q1b, q2b, pos_b):
        dist = jnp.abs(pos_b[:, None] - pos[None, :]).astype(jnp.float32)
        bias = -slopes[:, None, None] * dist
        a1 = jax.nn.softmax(jnp.einsum('bhqd,bhkd->bhqk', q1b, k1).astype(jnp.float32) + bias, axis=-1)
        a2 = jax.nn.softmax(jnp.einsum('bhqd,bhkd->bhqk', q2b, k2).astype(jnp.float32) + bias, axis=-1)
        w = a1 - lam * a2
        return jnp.einsum('bhqk,bhkv->bhqv', w.astype(v.dtype), v)

    o_meta = attend(q[0][:, :, :N_META], q[1][:, :, :N_META], pos[:N_META])
    n_blocks = (L - N_META) // Q_BLOCK

    def blocks(t):
        return t[:, :, N_META:].reshape(B, DIFF_HEADS, n_blocks, Q_BLOCK, DIFF_HD).transpose(2, 0, 1, 3, 4)

    o_real = lax.map(lambda a: attend(a[0], a[1], a[2]),
                     (blocks(q[0]), blocks(q[1]), pos[N_META:].reshape(n_blocks, Q_BLOCK)))
    o_real = o_real.transpose(1, 2, 0, 3, 4).reshape(B, DIFF_HEADS, L - N_META, 2 * DIFF_HD)
    o = jnp.concatenate([o_meta, o_real], axis=2)
    o = rms_norm(o, norm_w) * (1.0 - lambda_init)
    return o.transpose(0, 2, 1, 3).reshape(B, L, DIFF_V_W)


def setup_inputs(seed: int = 0) -> dict:
    key = jax.random.key(seed)
    ks = jax.random.split(key, 32)
    f32 = jnp.float32

    def nrm(k, shape, scale):
        return jax.random.normal(k, shape, f32) * scale

    def gain(k, shape):
        return 1.0 + 0.02 * jax.random.normal(k, shape, f32)

    dm = D_MODEL ** -0.5
    return {
        "x": nrm(ks[0], (BATCH, SEQ, D_MODEL), 1.0),
        "meta_tokens": nrm(ks[1], (N_META, D_MODEL), 1.0),
        "ffn1_norm": gain(ks[2], (DEPTH, D_MODEL)),
        "ffn1_w_gate": nrm(ks[3], (DEPTH, D_MODEL, D_FF), dm),
        "ffn1_w_up": nrm(ks[4], (DEPTH, D_MODEL, D_FF), dm),
        "ffn1_w_down": nrm(ks[5], (DEPTH, D_FF, D_MODEL), D_FF ** -0.5),
        "mix_norm": gain(ks[6], (DEPTH, D_MODEL)),
        "w_in": nrm(ks[7], (DEPTH, D_MODEL, IN_W), dm),
        "gla_wa2_fwd": nrm(ks[8], (DEPTH, GLA_LOWRANK, GLA_QK_W), GLA_LOWRANK ** -0.5),
        "gla_ba_fwd": nrm(ks[9], (DEPTH, GLA_QK_W), 0.1),
        "gla_wa2_bwd": nrm(ks[10], (DEPTH, GLA_LOWRANK, GLA_QK_W), GLA_LOWRANK ** -0.5),
        "gla_ba_bwd": nrm(ks[11], (DEPTH, GLA_QK_W), 0.1),
        "gla_out_norm": gain(ks[12], (DEPTH, GLA_DV)),
        "diff_lambda_q1": nrm(ks[13], (DEPTH, DIFF_HD), 0.1),
        "diff_lambda_k1": nrm(ks[14], (DEPTH, DIFF_HD), 0.1),
        "diff_lambda_q2": nrm(ks[15], (DEPTH, DIFF_HD), 0.1),
        "diff_lambda_k2": nrm(ks[16], (DEPTH, DIFF_HD), 0.1),
        "diff_out_norm": gain(ks[17], (DEPTH, 2 * DIFF_HD)),
        "w_branch_gla": nrm(ks[18], (DEPTH, GLA_V_W, D_MODEL), GLA_V_W ** -0.5),
        "w_branch_diff": nrm(ks[19], (DEPTH, DIFF_V_W, D_MODEL), DIFF_V_W ** -0.5),
        "w_out": nrm(ks[20], (DEPTH, D_MODEL, D_MODEL), dm),
        "ffn2_norm": gain(ks[21], (DEPTH, D_MODEL)),
        "ffn2_w_gate": nrm(ks[22], (DEPTH, D_MODEL, D_FF), dm),
        "ffn2_w_up": nrm(ks[23], (DEPTH, D_MODEL, D_FF), dm),
        "ffn2_w_down": nrm(ks[24], (DEPTH, D_FF, D_MODEL), D_FF ** -0.5),
        "final_norm": gain(ks[25], (D_MODEL,)),
    }


def reference(x, meta_tokens, ffn1_norm, ffn1_w_gate, ffn1_w_up, ffn1_w_down, mix_norm, w_in,
              gla_wa2_fwd, gla_ba_fwd, gla_wa2_bwd, gla_ba_bwd, gla_out_norm,
              diff_lambda_q1, diff_lambda_k1, diff_lambda_q2, diff_lambda_k2, diff_out_norm,
              w_branch_gla, w_branch_diff, w_out, ffn2_norm, ffn2_w_gate, ffn2_w_up, ffn2_w_down,
              final_norm):
    B = x.shape[0]
    meta = jnp.broadcast_to(meta_tokens[None].astype(x.dtype), (B, N_META, x.shape[-1]))
    h = jnp.concatenate([meta, x], axis=1)
    for l in range(DEPTH):
        h = h + 0.5 * swiglu(rms_norm(h, ffn1_norm[l]), ffn1_w_gate[l], ffn1_w_up[l], ffn1_w_down[l])
        u = rms_norm(h, mix_norm[l])
        p = u @ w_in[l]
        g_q, g_k, g_v, g_r, g_af, g_ab, d_q, d_k, d_v, gate_a, gate_b = jnp.split(p, IN_SPLITS, axis=-1)
        y_gla = gla_branch(g_q, g_k, g_v, g_r, g_af, g_ab, gla_wa2_fwd[l], gla_ba_fwd[l],
                           gla_wa2_bwd[l], gla_ba_bwd[l], gla_out_norm[l])
        y_diff = diff_branch(d_q, d_k, d_v, diff_lambda_q1[l], diff_lambda_k1[l], diff_lambda_q2[l],
                             diff_lambda_k2[l], diff_out_norm[l], diff_lambda_init(l))
        merged = (jax.nn.sigmoid(gate_a) * (y_gla @ w_branch_gla[l])
                  + jax.nn.sigmoid(gate_b) * (y_diff @ w_branch_diff[l]))
        h = h + merged @ w_out[l]
        h = h + 0.5 * swiglu(rms_norm(h, ffn2_norm[l]), ffn2_w_gate[l], ffn2_w_up[l], ffn2_w_down[l])
    return rms_norm(h, final_norm)[:, N_META:]
```

```cpp
#include <hip/hip_runtime.h>
#include <hip/hip_cooperative_groups.h>
#include <stdint.h>
#include <cstdio>
namespace cg = cooperative_groups;

#define DEV __device__ __forceinline__
typedef unsigned short bf16_t;
using bf16x8 = __attribute__((ext_vector_type(8))) short;
using s16x4  = __attribute__((ext_vector_type(4))) short;
using f32x4  = __attribute__((ext_vector_type(4))) float;
using f32x16 = __attribute__((ext_vector_type(16))) float;
using u32x4  = __attribute__((ext_vector_type(4))) unsigned;
using u32x2  = __attribute__((ext_vector_type(2))) unsigned;

constexpr int DM = 2048, DFF = 5504, NB = 4, SEQ = 4096, LP = 4160, RP = NB * LP  , TR = NB * SEQ  ;
constexpr int INW = 16416;
constexpr float EPS = 1e-6f;
constexpr int NTHR = 512;

constexpr size_t SZ_ACT = (size_t)RP * 2048 * 2;
constexpr size_t SZ_HALF = (size_t)RP * 1024 * 2;
constexpr size_t SZ_SQ = (size_t)2048 * 2048 * 2;
constexpr size_t SZ_FW = (size_t)DFF * 2048 * 2;
constexpr size_t SZ_HID = (size_t)RP * DFF * 2;
constexpr size_t O_ACTB = 0;
constexpr size_t O_WIN = O_ACTB + SZ_ACT;
constexpr size_t O_WS = O_WIN + SZ_ACT;
constexpr size_t O_WF = O_WS + 3 * SZ_SQ;
constexpr size_t O_HID = O_WF + 3 * SZ_FW;
constexpr size_t O_R = O_HID + SZ_HID;
constexpr size_t O_F = O_R;
constexpr size_t O_GR = O_F + SZ_ACT;
constexpr size_t O_P = O_GR + SZ_ACT;
constexpr size_t SZ_P = (size_t)16 * 65 * 4096 * 2;
constexpr size_t O_LOW = O_P + SZ_P;
constexpr size_t O_DL = O_LOW + (size_t)RP * 32 * 4;
constexpr size_t O_ST = O_DL + (size_t)16 * 2 * 65 * 256 * 4;
constexpr size_t O_ST1 = O_ST + (size_t)RP * 4, O_ST2 = O_ST1 + (size_t)RP * 32 * 4;
constexpr size_t O_DST = O_ST2 + (size_t)RP * 32 * 4;
constexpr size_t O_DKM = O_DST + (size_t)RP * 16 * 4;
constexpr size_t O_DVM = O_DKM + (size_t)64 * 2048 * 2;
constexpr size_t WS_TOTAL = O_DVM + (size_t)64 * 2048 * 2;
constexpr size_t O_GQ = O_WF + SZ_FW, O_GK = O_HID + (size_t)256 * DFF * 2, O_GV = O_GK + SZ_HALF, O_QDB = O_GV + SZ_ACT, O_KIB = O_QDB + SZ_HALF;
static_assert(O_GQ + SZ_HALF <= O_HID && O_KIB + SZ_HALF <= O_R, "gla overlay 2");
constexpr size_t O_DQ = O_WF, O_DK = O_DQ + SZ_ACT, O_DV = O_DK + SZ_ACT;
constexpr size_t O_MRG = O_DK;
constexpr size_t O_DD = O_WIN;
static_assert(O_DV + SZ_ACT <= O_R, "diff overlay");

struct Params {
  const float *x, *meta, *n1, *w1g, *w1u, *w1d, *nmix, *win, *wa2f, *baf, *wa2b, *bab, *gnorm,
      *lq1, *lk1, *lq2, *lk2, *dnorm, *wbg, *wbd, *wout, *n2, *w2g, *w2u, *w2d, *nfin;
  float* out;
  unsigned char* ws;
};

extern __shared__ __attribute__((aligned(16))) unsigned char shm_raw[];
#define shm ((bf16_t*)shm_raw)

DEV float bf2f(bf16_t v) { return __uint_as_float(((unsigned)v) << 16); }
typedef __bf16 bf16x2_t __attribute__((ext_vector_type(2)));
typedef float f32x2_t __attribute__((ext_vector_type(2)));
DEV unsigned pk2(float lo, float hi) { f32x2_t v = {lo, hi}; bf16x2_t b = __builtin_convertvector(v, bf16x2_t); return __builtin_bit_cast(unsigned, b); }
DEV bf16_t f2bf(float f) { return (bf16_t)(pk2(f, 0.f) & 0xffffu); }
DEV float sigm(float v) { return 1.f / (1.f + __expf(-v)); }

constexpr int BM = 256, BK = 64, HALF = 128, HT = HALF * BK, NXCD = 8, WGM = 8;
DEV int lds_byte(int r, int c) { int st = (r >> 4) * 2 + (c >> 5), rr = r & 15, cc = c & 31, ob = rr * 64 + cc * 2; return st * 1024 + (ob ^ (((ob >> 9) & 1) << 5)); }
DEV void stage_rc(int b, int& R, int& C) { int st = b / 1024, sb = b % 1024, swz = sb ^ (((sb >> 9) & 1) << 5); R = (st >> 1) * 16 + swz / 64; C = (st & 1) * 32 + (swz % 64) / 2; }

#define LAS __attribute__((address_space(3)))
constexpr int HTB = HALF * BK * 2;
#define PG8_SA(b, h) (((b) * 2 + (h)) * HTB)
#define PG8_SB(b, h) ((4 + (b) * 2 + (h)) * HTB)
#define STAGE(bufoff, gbase, voff) do { _Pragma("unroll") for (int _i = 0; _i < 2; ++_i) \
    __builtin_amdgcn_global_load_lds((const unsigned*)((const char*)(gbase) + (voff)[_i]), (LAS unsigned*)(lds + (bufoff) + ldsw + _i * 8192), 16, 0, 0); } while (0)
#define LDA(dst, b, h) do { _Pragma("unroll") for (int m = 0; m < 4; ++m) _Pragma("unroll") for (int k = 0; k < 2; ++k) dst[m][k] = *(const LAS bf16x8*)(lds + PG8_SA(b, h) + aoff + m * 2048 + k * 1024); } while (0)
#define LDB(dst, b, h) do { _Pragma("unroll") for (int n = 0; n < 2; ++n) _Pragma("unroll") for (int k = 0; k < 2; ++k) dst[n][k] = *(const LAS bf16x8*)(lds + PG8_SB(b, h) + boff + n * 2048 + k * 1024); } while (0)
#define MMA(ai, bj, At_, Bt_) do { __builtin_amdgcn_s_setprio(1); \
    _Pragma("unroll") for (int m = 0; m < 4; ++m) _Pragma("unroll") for (int n = 0; n < 2; ++n) _Pragma("unroll") for (int k = 0; k < 2; ++k) \
      acc[ai][bj][m][n] = __builtin_amdgcn_mfma_f32_16x16x32_bf16(Bt_[n][k], At_[m][k], acc[ai][bj][m][n], 0, 0, 0); \
    __builtin_amdgcn_s_setprio(0); } while (0)
#define WAIT_V(n) asm volatile("s_waitcnt vmcnt(" #n ")" ::: "memory")
#define WAIT_L(n) asm volatile("s_waitcnt lgkmcnt(" #n ")" ::: "memory")
#define BAR __builtin_amdgcn_s_barrier()
#define SCHED __builtin_amdgcn_sched_barrier(0)

DEV void gemm_mainloop(const char* __restrict__ cA, const char* __restrict__ cB0, const char* __restrict__ cB1, const int K, f32x4 (&acc)[2][2][4][2]) {
  LAS unsigned char* lds = (LAS unsigned char*)shm_raw;
  int tid = threadIdx.x; asm volatile("" : "+v"(tid));
  const int wid = __builtin_amdgcn_readfirstlane(tid >> 6), lane = tid & 63, wr = wid >> 2, wc = wid & 3, fr = lane & 15, fq = lane >> 4;
  unsigned voff[2];
#pragma unroll
  for (int i = 0; i < 2; ++i) { int R, C; stage_rc(tid * 16 + i * 8192, R, C); voff[i] = (unsigned)(R * K + C) * 2u; }
  const size_t kstep = (size_t)(BK * 2), hstep = (size_t)HALF * K * 2;
  const unsigned ldsw = (unsigned)wid * 1024u;
  const int aoff = lds_byte(wr * 64 + fr, fq * 8), boff = lds_byte(wc * 32 + fr, fq * 8);
  bf16x8 At[4][2], B0[2][2], B1[2][2];
  const int nt = K / BK;
  STAGE(PG8_SB(0, 0), cB0, voff); STAGE(PG8_SA(0, 0), cA, voff); STAGE(PG8_SB(0, 1), cB1, voff); STAGE(PG8_SA(0, 1), cA + hstep, voff);
  if (wr == 1) BAR;
  WAIT_V(4); BAR;
  STAGE(PG8_SB(1, 0), cB0 + kstep, voff); STAGE(PG8_SA(1, 0), cA + kstep, voff); STAGE(PG8_SB(1, 1), cB1 + kstep, voff);
  WAIT_V(6); BAR;
  for (int t = 0; t < nt - 2; t += 2) {
    const char* a1 = cA + (size_t)(t + 1) * kstep;
    const char* a2 = a1 + kstep; const char* a3 = a2 + kstep;
    const char* b02 = cB0 + (size_t)(t + 2) * kstep; const char* b12 = cB1 + (size_t)(t + 2) * kstep;
    LDB(B0, 0, 0); SCHED; LDA(At, 0, 0); STAGE(PG8_SA(1, 1), a1 + hstep, voff);
    WAIT_L(8); BAR; WAIT_L(0); MMA(0, 0, At, B0); BAR; SCHED;
    LDB(B1, 0, 1); STAGE(PG8_SB(0, 0), b02, voff);
    BAR; WAIT_L(0); MMA(0, 1, At, B1); BAR;
    LDA(At, 0, 1); STAGE(PG8_SA(0, 0), a2, voff);
    BAR; WAIT_L(0); MMA(1, 0, At, B0); BAR; SCHED;
    STAGE(PG8_SB(0, 1), b12, voff);
    WAIT_V(6); BAR; MMA(1, 1, At, B1); BAR;
    LDB(B0, 1, 0); SCHED; LDA(At, 1, 0); STAGE(PG8_SA(0, 1), a2 + hstep, voff);
    WAIT_L(8); BAR; WAIT_L(0); MMA(0, 0, At, B0); BAR; SCHED;
    LDB(B1, 1, 1); STAGE(PG8_SB(1, 0), b02 + kstep, voff);
    BAR; WAIT_L(0); MMA(0, 1, At, B1); BAR;
    LDA(At, 1, 1); STAGE(PG8_SA(1, 0), a3, voff);
    BAR; WAIT_L(0); MMA(1, 0, At, B0); BAR; SCHED;
    STAGE(PG8_SB(1, 1), b12 + kstep, voff);
    WAIT_V(6); BAR; MMA(1, 1, At, B1); BAR;
  }
  { LDB(B0, 0, 0); LDA(At, 0, 0); STAGE(PG8_SA(1, 1), cA + (size_t)(nt - 1) * kstep + hstep, voff);
    BAR; WAIT_L(0); MMA(0, 0, At, B0); BAR;
    LDB(B1, 0, 1); BAR; WAIT_L(0); MMA(0, 1, At, B1); BAR;
    LDA(At, 0, 1); WAIT_V(4); BAR; WAIT_L(0); MMA(1, 0, At, B0); MMA(1, 1, At, B1); BAR; }
  { LDB(B0, 1, 0); LDA(At, 1, 0); WAIT_V(2); BAR; WAIT_L(0); MMA(0, 0, At, B0); BAR;
    LDB(B1, 1, 1); WAIT_V(0); BAR; WAIT_L(0); MMA(0, 1, At, B1); BAR;
    LDA(At, 1, 1); BAR; WAIT_L(0); MMA(1, 0, At, B0); MMA(1, 1, At, B1); BAR; }
  if (wr == 0) BAR;
}

enum { G_FFN1_GU = 0, G_FFN1_D, G_WIN_A, G_WIN_META, G_WIN_B, G_MERGE, G_OUT, G_FFN2_GU, G_FFN2_D };

DEV void store_bf4(bf16_t* p, f32x4 v) { u32x2 w; w.x = pk2(v[0], v[1]); w.y = pk2(v[2], v[3]); *(u32x2*)p = w; }
DEV f32x4 load_bf4(const bf16_t* p) { u32x2 w = *(const u32x2*)p; f32x4 v; v[0] = __uint_as_float(w.x << 16); v[1] = __uint_as_float(w.x & 0xffff0000u); v[2] = __uint_as_float(w.y << 16); v[3] = __uint_as_float(w.y & 0xffff0000u); return v; }

DEV void main_order(int L, int nN, int& pm, int& pn) {
  const int nwg = 64 * nN;
  int wgid = L; { const int q = nwg / NXCD, r = nwg % NXCD, xcd = wgid % NXCD, off = wgid / NXCD; wgid = (xcd < r ? xcd * (q + 1) : r * (q + 1) + (xcd - r) * q) + off; }
  const int nig = WGM * nN, gid = wgid / nig, fm = gid * WGM;
  pm = fm + ((wgid % nig) % WGM); pn = (wgid % nig) / WGM;
}

DEV void gemm_phase(const Params& P, const int gp) {
  int tid = threadIdx.x; asm volatile("" : "+v"(tid));
  const int wid = __builtin_amdgcn_readfirstlane(tid >> 6), lane = tid & 63, wr = wid >> 2, wc = wid & 3, fr_ = lane & 15, fq_ = lane >> 4;
  unsigned char* ws = P.ws;
  float* stats = (float*)(ws + O_ST);
  int nN, nPre = 0, nMain, nMeta = 0, pnoff = 0;
  switch (gp) {
    case G_FFN1_GU: nN = 43; nMeta = 43; break;
    case G_FFN1_D: nN = 8; break;
    case G_WIN_A: nN = 25; nPre = 8; break;
    case G_WIN_META: nN = 0; nMeta = 65; break;
    case G_WIN_B: nN = 40; pnoff = 25; break;
    case G_MERGE: nN = 8; break;
    case G_OUT: nN = 8; break;
    case G_FFN2_GU: nN = 43; break;
    default: nN = 8; break;
  }
  nMain = 64 * nN;
  const int ntiles = nPre + nMain + nMeta;
  for (int t = blockIdx.x; t < ntiles; t += gridDim.x) {
    int pm, pn, kind = gp;
    bool meta = false;
    if (t < nPre) { pm = 64; pn = t; meta = true; kind = G_FFN1_D; }
    else if (t < nPre + nMain) { main_order(t - nPre, nN, pm, pn); pn += pnoff; }
    else { pm = 64; pn = t - nPre - nMain; meta = true; }
    const int arow0 = meta ? 0 : (pm >> 4) * LP + 64 + (pm & 15) * 256;
    const int nrow0 = pm * 256;
    const bf16_t *A, *B0p, *B1p; int K;
    switch (kind) {
      case G_FFN1_GU: A = (const bf16_t*)(ws + O_ACTB); K = 2048; B0p = (const bf16_t*)(ws + O_WF) + (size_t)DFF * 2048 + (size_t)pn * 128 * 2048; B1p = B0p + (size_t)DFF * 2048; break;
      case G_FFN2_GU: A = (const bf16_t*)(ws + O_ACTB); K = 2048; B0p = (const bf16_t*)(ws + O_WF) + (size_t)DFF * 2048 + (size_t)pn * 128 * 2048; B1p = B0p + (size_t)DFF * 2048; break;
      case G_FFN1_D: case G_FFN2_D: A = (const bf16_t*)(ws + O_HID); K = DFF; B0p = (const bf16_t*)(ws + O_WF) + (size_t)pn * 256 * DFF; B1p = B0p + (size_t)128 * DFF; break;
      case G_WIN_A: case G_WIN_META: case G_WIN_B: A = (const bf16_t*)(ws + O_ACTB); K = 2048; B0p = (const bf16_t*)(ws + O_WIN) + (size_t)pn * 256 * 2048; B1p = B0p + (size_t)128 * 2048; break;
      case G_MERGE: A = (const bf16_t*)(ws + O_GR); K = 2048; B0p = (const bf16_t*)(ws + O_WS) + (size_t)pn * 256 * 2048; B1p = B0p + (size_t)128 * 2048; break;
      default  : A = (const bf16_t*)(ws + O_MRG); K = 2048; B0p = (const bf16_t*)(ws + O_WS) + 2 * (size_t)2048 * 2048 + (size_t)pn * 256 * 2048; B1p = B0p + (size_t)128 * 2048; break;
    }
    f32x4 acc[2][2][4][2];
#pragma unroll
    for (int a = 0; a < 2; ++a)
#pragma unroll
      for (int b = 0; b < 2; ++b)
#pragma unroll
        for (int m = 0; m < 4; ++m)
#pragma unroll
          for (int n = 0; n < 2; ++n) acc[a][b][m][n] = (f32x4){0.f, 0.f, 0.f, 0.f};
    const int nk = (kind == G_MERGE) ? 2 : 1;
    for (int kl = 0; kl < nk; ++kl) {
      if (kl == 1) {
        int fr = fr_, fq = fq_; asm volatile("" : "+v"(fr), "+v"(fq));
        const bf16_t* gA = (const bf16_t*)P.out; const bf16_t* gB = gA + (size_t)TR * 2048;
#pragma unroll
        for (int ai = 0; ai < 2; ++ai)
#pragma unroll
          for (int m = 0; m < 4; ++m) {
            const size_t nrow = (size_t)(nrow0 + ai * 128 + wr * 64 + m * 16 + fr) * 2048;
#pragma unroll
            for (int bj = 0; bj < 2; ++bj)
#pragma unroll
              for (int n = 0; n < 2; ++n) {
                const int col = pn * 256 + bj * 128 + wc * 32 + n * 16 + fq * 4;
                f32x4 a4 = load_bf4(gA + nrow + col), b4 = load_bf4(gB + nrow + col);
#pragma unroll
                for (int j = 0; j < 4; ++j) { float ea = __expf(-fminf(fmaxf(a4[j], -40.f), 40.f)), eb = __expf(-fminf(fmaxf(b4[j], -40.f), 40.f)); acc[ai][bj][m][n][j] *= (1.f + eb) / (1.f + ea); }
              }
            asm volatile("" ::: "memory"); SCHED;
          }
        A = (const bf16_t*)(ws + O_DD); B0p += (size_t)2048 * 2048; B1p += (size_t)2048 * 2048;
        asm volatile("s_waitcnt vmcnt(0)" ::: "memory");
      }
      gemm_mainloop((const char*)(A + (size_t)arow0 * K), (const char*)B0p, (const char*)B1p, K, acc);
    }
    int fr = fr_, fq = fq_; asm volatile("" : "+v"(fr), "+v"(fq));
    if (kind == G_FFN1_GU || kind == G_FFN2_GU || kind == G_WIN_A || kind == G_WIN_META || kind == G_WIN_B) {
      float* rsl = (float*)shm_raw;
      if (tid < 256) {
        const size_t row = (size_t)arow0 + tid; float sum;
        if (kind == G_FFN1_GU) sum = stats[row];
        else { const f32x4* pp = (const f32x4*)((const float*)(ws + (kind == G_FFN2_GU ? O_ST2 : O_ST1)) + row * 32); f32x4 a = pp[0];
#pragma unroll
          for (int i = 1; i < 8; ++i) a += pp[i];
          sum = (a[0] + a[1]) + (a[2] + a[3]); }
        rsl[tid] = rsqrtf(sum * (1.f / 2048.f) + EPS);
      }
      __syncthreads();
    }
    if (kind == G_FFN1_GU || kind == G_FFN2_GU) {
      const float* rsl = (const float*)shm_raw;
      bf16_t* hid = (bf16_t*)(ws + O_HID);
#pragma unroll
      for (int ai = 0; ai < 2; ++ai)
#pragma unroll
        for (int m = 0; m < 4; ++m) {
          const int r = ai * 128 + wr * 64 + m * 16 + fr;
          if (meta && (r < 48 || r >= 64)) continue;
          const int prow = arow0 + r;
          const float rs = rsl[r];
#pragma unroll
          for (int n = 0; n < 2; ++n) {
            f32x4 g = acc[ai][0][m][n] * rs, u = acc[ai][1][m][n] * rs, h;
#pragma unroll
            for (int j = 0; j < 4; ++j) h[j] = g[j] * sigm(g[j]) * u[j];
            store_bf4(hid + (size_t)prow * DFF + pn * 128 + wc * 32 + n * 16 + fq * 4, h);
          }
          asm volatile("" ::: "memory"); SCHED;
        }
    } else if (kind == G_FFN1_D || kind == G_OUT || kind == G_FFN2_D) {
      const float* resA = (kind == G_FFN2_D) ? P.out : P.x;
      const bf16_t* resF = (kind == G_OUT) ? (const bf16_t*)(ws + O_F) : nullptr;
      float* outF32 = (kind == G_FFN1_D) ? nullptr : P.out;
      bf16_t* outB = (kind == G_FFN2_D) ? nullptr : (bf16_t*)(ws + O_ACTB);
      bf16_t* outF = (kind == G_FFN1_D && !meta) ? (bf16_t*)(ws + O_F) : nullptr;
      const float scale = (kind == G_OUT) ? 1.f : 0.5f;
      float* st = (kind == G_FFN1_D) ? (float*)(ws + O_ST1) : (kind == G_OUT ? (float*)(ws + O_ST2) : nullptr);
#pragma unroll
      for (int ai = 0; ai < 2; ++ai)
#pragma unroll
        for (int m = 0; m < 4; ++m) {
          const int r = ai * 128 + wr * 64 + m * 16 + fr;
          if (meta && (r < 48 || r >= 64)) continue;
          const size_t prow = arow0 + r, nrow = nrow0 + r;
          const float* rp = meta ? (P.meta + (size_t)(r - 48) * 2048) : (resA + nrow * 2048);
          float ss = 0.f;
#pragma unroll
          for (int bj = 0; bj < 2; ++bj)
#pragma unroll
            for (int n = 0; n < 2; ++n) {
              const int col = pn * 256 + bj * 128 + wc * 32 + n * 16 + fq * 4;
              f32x4 res = *(const f32x4*)(rp + col);
              if (resF) res += load_bf4(resF + prow * 2048 + col);
              const f32x4 d = acc[ai][bj][m][n] * scale, v = res + d;
              if (outF32) *(f32x4*)(outF32 + nrow * 2048 + col) = v;
              if (outB) store_bf4(outB + prow * 2048 + col, v);
              if (outF) store_bf4(outF + prow * 2048 + col, d);
              ss += v[0] * v[0] + v[1] * v[1] + v[2] * v[2] + v[3] * v[3];
            }
          ss += __shfl_xor(ss, 16); ss += __shfl_xor(ss, 32);
          if (fq == 0 && st) st[prow * 32 + pn * 4 + wc] = ss;
          asm volatile("" ::: "memory"); SCHED;
        }
    } else if (kind == G_MERGE) {
      const bf16_t* gB = (const bf16_t*)P.out + (size_t)TR * 2048;
      bf16_t* mo = (bf16_t*)(ws + O_MRG);
#pragma unroll
      for (int ai = 0; ai < 2; ++ai)
#pragma unroll
        for (int m = 0; m < 4; ++m) {
          const int r = ai * 128 + wr * 64 + m * 16 + fr;
          const size_t prow = arow0 + r, nrow = nrow0 + r;
#pragma unroll
          for (int bj = 0; bj < 2; ++bj)
#pragma unroll
            for (int n = 0; n < 2; ++n) {
              const int col = pn * 256 + bj * 128 + wc * 32 + n * 16 + fq * 4;
              f32x4 b4 = load_bf4(gB + nrow * 2048 + col), v;
#pragma unroll
              for (int j = 0; j < 4; ++j) v[j] = acc[ai][bj][m][n][j] / (1.f + __expf(-fminf(fmaxf(b4[j], -40.f), 40.f)));
              store_bf4(mo + prow * 2048 + col, v);
            }
          asm volatile("" ::: "memory"); SCHED;
        }
    } else {
      const float* rsl = (const float*)shm_raw;
      bf16_t* dst; int ld, c0; bool natural = false, isLow = false;
      if (pn < 4) { dst = (bf16_t*)(ws + O_GQ); ld = 1024; c0 = pn * 256; }
      else if (pn < 8) { dst = (bf16_t*)(ws + O_GK); ld = 1024; c0 = (pn - 4) * 256; }
      else if (pn < 16) { dst = (bf16_t*)(ws + O_GV); ld = 2048; c0 = (pn - 8) * 256; }
      else if (pn < 24) { dst = (bf16_t*)(ws + O_GR); ld = 2048; c0 = (pn - 16) * 256; }
      else if (pn == 24) { dst = nullptr; ld = 32; c0 = 0; isLow = true; }
      else if (pn < 33) { dst = (bf16_t*)(ws + O_DQ); ld = 2048; c0 = (pn - 25) * 256; }
      else if (pn < 41) { dst = (bf16_t*)(ws + O_DK); ld = 2048; c0 = (pn - 33) * 256; }
      else if (pn < 49) { dst = (bf16_t*)(ws + O_DV); ld = 2048; c0 = (pn - 41) * 256; }
      else if (pn < 57) { dst = (bf16_t*)P.out; ld = 2048; c0 = (pn - 49) * 256; natural = true; }
      else { dst = (bf16_t*)P.out + (size_t)TR * 2048; ld = 2048; c0 = (pn - 57) * 256; natural = true; }
      float* low = (float*)(ws + O_LOW);
      bool single = false;
      if (meta && pn >= 25) { single = true; if (pn >= 33 && pn < 41) dst = (bf16_t*)(ws + O_DKM); else if (pn >= 41 && pn < 49) dst = (bf16_t*)(ws + O_DVM); else natural = true; }
      if (!(meta && natural)) {
#pragma unroll
        for (int ai = 0; ai < 2; ++ai)
#pragma unroll
          for (int m = 0; m < 4; ++m) {
            const int r = ai * 128 + wr * 64 + m * 16 + fr;
            if (meta && r >= 64) continue;
            const size_t prow = arow0 + r, nrow = nrow0 + r;
            const float rs = rsl[r];
            const bool zero = meta && r < 48;
#pragma unroll
            for (int bj = 0; bj < 2; ++bj)
#pragma unroll
              for (int n = 0; n < 2; ++n) {
                const int cc = bj * 128 + wc * 32 + n * 16 + fq * 4;
                f32x4 v = acc[ai][bj][m][n] * rs;
                if (zero) v = (f32x4){0.f, 0.f, 0.f, 0.f};
                if (isLow) {
                  if (cc < 32) { if (meta) { for (int b4 = 0; b4 < 4; ++b4) *(f32x4*)(low + (size_t)(b4 * LP + r) * 32 + cc) = v; } else *(f32x4*)(low + prow * 32 + cc) = v; }
                } else if (single) {
                  store_bf4(dst + (size_t)r * ld + c0 + cc, v);
                } else if (meta) {
                  for (int b4 = 0; b4 < 4; ++b4) store_bf4(dst + (size_t)(b4 * LP + r) * ld + c0 + cc, v);
                } else {
                  store_bf4(dst + (natural ? nrow : prow) * ld + c0 + cc, v);
                }
              }
            asm volatile("" ::: "memory"); SCHED;
          }
      }
    }
    asm volatile("s_waitcnt vmcnt(0)" ::: "memory");
    __syncthreads();
  }
}

DEV void transpose_tile(const float* __restrict__ src, int K, int N, bf16_t* __restrict__ dst, const float* __restrict__ gain, bool winmap, int tk, int tn) {
  const int tid = threadIdx.x;
  bf16_t* T = shm;
  const int k0 = tk * 128, n0 = tn * 128;
  __syncthreads();
#pragma unroll
  for (int i = 0; i < 8; ++i) {
    const int kr = i * 16 + (tid >> 5), nc = (tid & 31) * 4;
    f32x4 v = (f32x4){0.f, 0.f, 0.f, 0.f};
    if (n0 + nc < N) v = *(const f32x4*)(src + (size_t)(k0 + kr) * N + n0 + nc);
    if (gain) v = v * gain[k0 + kr];
    unsigned* tp = (unsigned*)(T + kr * 130 + nc);
    tp[0] = pk2(v[0], v[1]); tp[1] = pk2(v[2], v[3]);
  }
  __syncthreads();
  const int nr = tid >> 2, n = n0 + nr;
  if (n < N) {
    const int drow = winmap ? (n < 6176 ? n : n + 224) : n;
#pragma unroll
    for (int q = 0; q < 4; ++q) {
      const int kk = (tid & 3) * 8 + q * 32;
      unsigned short e[8];
#pragma unroll
      for (int i = 0; i < 8; ++i) e[i] = T[(kk + i) * 130 + nr];
      u32x4 w; w.x = e[0] | ((unsigned)e[1] << 16); w.y = e[2] | ((unsigned)e[3] << 16); w.z = e[4] | ((unsigned)e[5] << 16); w.w = e[6] | ((unsigned)e[7] << 16);
      *(u32x4*)(dst + (size_t)drow * K + k0 + kk) = w;
    }
  }
}

DEV void transpose_job(const float* src, int K, int N, bf16_t* dst, const float* gain, bool winmap, int& tbase, int& t) {
  const int ntn = (N + 127) / 128, nt = (K / 128) * ntn;
  while (t < tbase + nt) { const int l = t - tbase; transpose_tile(src, K, N, dst, gain, winmap, l / ntn, l % ntn); t += gridDim.x; }
  tbase += nt;
}

DEV void phase_prologue(const Params& P) {
  unsigned char* ws = P.ws;
  const int tid = threadIdx.x, gtid = blockIdx.x * NTHR + tid, gsz = gridDim.x * NTHR;
  { u32x4* z = (u32x4*)((bf16_t*)(ws + O_WIN) + (size_t)6176 * 2048); const int nz = 224 * 2048 / 8;
    for (int i = gtid; i < nz; i += gsz) z[i] = (u32x4){0u, 0u, 0u, 0u}; }
  { const int gw = (blockIdx.x * NTHR + tid) >> 6, nw = gsz >> 6, lane = tid & 63;
    bf16_t* xb = (bf16_t*)(ws + O_ACTB); float* st0 = (float*)(ws + O_ST);
    for (int r = gw; r < TR + 16; r += nw) {
      const float* src; size_t prow;
      if (r < TR) { src = P.x + (size_t)r * 2048; prow = (size_t)(r >> 12) * LP + 64 + (r & 4095); } else { src = P.meta + (size_t)(r - TR) * 2048; prow = 48 + (r - TR); }
      float ss = 0.f;
#pragma unroll
      for (int i = 0; i < 8; ++i) { const int c = i * 256 + lane * 4; f32x4 v = *(const f32x4*)(src + c); ss += v[0] * v[0] + v[1] * v[1] + v[2] * v[2] + v[3] * v[3]; store_bf4(xb + prow * 2048 + c, v); }
#pragma unroll
      for (int o = 32; o >= 1; o >>= 1) ss += __shfl_xor(ss, o);
      if (lane == 0) st0[prow] = ss;
    } }
  int tbase = 0, t = blockIdx.x;
  bf16_t* wf = (bf16_t*)(ws + O_WF); bf16_t* wsq = (bf16_t*)(ws + O_WS);
  transpose_job(P.w1g, 2048, DFF, wf + (size_t)DFF * 2048, P.n1, false, tbase, t);
  transpose_job(P.w1u, 2048, DFF, wf + (size_t)2 * DFF * 2048, P.n1, false, tbase, t);
  transpose_job(P.w1d, DFF, 2048, wf, nullptr, false, tbase, t);
  transpose_job(P.win, 2048, INW, (bf16_t*)(ws + O_WIN), P.nmix, true, tbase, t);
  transpose_job(P.wbg, 2048, 2048, wsq, nullptr, false, tbase, t);
  transpose_job(P.wbd, 2048, 2048, wsq + (size_t)2048 * 2048, nullptr, false, tbase, t);
  transpose_job(P.wout, 2048, 2048, wsq + (size_t)2 * 2048 * 2048, nullptr, false, tbase, t);
}

DEV f32x4 mfma16(bf16x8 a, bf16x8 b, f32x4 c) { return __builtin_amdgcn_mfma_f32_16x16x32_bf16(a, b, c, 0, 0, 0); }
#define LD8(p) (*reinterpret_cast<const bf16x8*>(p))

DEV void gla_prep_unit(const Params& P, int u) {
  unsigned char* ws = P.ws;
  const int tid = threadIdx.x, w = tid >> 6, lane = tid & 63, fr = lane & 15, fq = lane >> 4;
  const int c = u % 65, bh = u / 65, b = bh >> 2, h = bh & 3;
  bf16_t* QD0 = shm; bf16_t* KI0 = QD0 + 64 * 264; bf16_t* QD1 = KI0 + 64 * 264; bf16_t* KI1 = QD1 + 64 * 264;
  float* LOWs = (float*)(KI1 + 64 * 264);
  bf16_t* gq = (bf16_t*)(ws + O_GQ); bf16_t* gk = (bf16_t*)(ws + O_GK);
  const size_t prow0 = (size_t)b * LP + c * 64;
  __syncthreads();
  { const int idx = tid * 4, row = idx >> 5, col = idx & 31;
    *(f32x4*)(LOWs + idx) = *(const f32x4*)((const float*)(ws + O_LOW) + (prow0 + row) * 32 + col); }
  __syncthreads();
  const int dir = tid >> 8, k = tid & 255, col = h * 256 + k;
  {
    const float* wa2 = dir ? P.wa2b : P.wa2f;
    float wv[16];
#pragma unroll
    for (int r = 0; r < 16; ++r) wv[r] = wa2[r * 1024 + col];
    const float bias = (dir ? P.bab : P.baf)[col];
    bf16_t* QD = dir ? QD1 : QD0; bf16_t* KI = dir ? KI1 : KI0;
    float bc = 0.f;
    for (int tt = 0; tt < 64; ++tt) {
      const int t = dir ? 63 - tt : tt;
      float z = bias;
#pragma unroll
      for (int r = 0; r < 16; ++r) z = fmaf(LOWs[t * 32 + dir * 16 + r], wv[r], z);
      const float ls = fminf(z, 0.f) - __logf(1.f + __expf(-fabsf(z)));
      const bool valid = !(c == 0 && t < 48);
      bc += valid ? ls * 0.0625f : 0.f;
      const float e = __expf(bc), ei = __expf(-bc);
      const float qv = bf2f(gq[(prow0 + t) * 1024 + col]), kv = bf2f(gk[(prow0 + t) * 1024 + col]);
      QD[t * 264 + k] = f2bf(qv * e * 0.0625f);
      KI[t * 264 + k] = f2bf(kv * ei);
    }
    ((float*)(ws + O_DL))[((size_t)(bh * 2 + dir) * 65 + c) * 256 + k] = __expf(bc);
  }
  __syncthreads();
  if (c >= 1) {
    const int d = w >> 2, ti = w & 3;
    const bf16_t* QD = d ? QD1 : QD0; const bf16_t* KI = d ? KI1 : KI0;
    bf16_t* Pg = (bf16_t*)(ws + O_P) + (size_t)u * 4096;
#pragma unroll
    for (int tj = 0; tj < 4; ++tj) {
      f32x4 a4 = (f32x4){0.f, 0.f, 0.f, 0.f};
#pragma unroll
      for (int kk = 0; kk < 8; ++kk) a4 = mfma16(LD8(QD + (ti * 16 + fr) * 264 + kk * 32 + fq * 8), LD8(KI + (tj * 16 + fr) * 264 + kk * 32 + fq * 8), a4);
#pragma unroll
      for (int r = 0; r < 4; ++r) { const int i = ti * 16 + fq * 4 + r, j = tj * 16 + fr; const bool keep = d ? (j > i) : (j <= i); if (keep) Pg[i * 64 + j] = f2bf(a4[r]); }
    }
  }
  bf16_t* qdb = (bf16_t*)(ws + O_QDB); bf16_t* kib = (bf16_t*)(ws + O_KIB);
#pragma unroll
  for (int i = 0; i < 4; ++i) {
    const int p = tid + 512 * i, tok = p >> 5, kc = (p & 31) * 8;
    const size_t g = (prow0 + tok) * 1024 + h * 256 + kc;
    *(u32x4*)(gq + g) = *(const u32x4*)(QD0 + tok * 264 + kc);
    *(u32x4*)(gk + g) = *(const u32x4*)(KI0 + tok * 264 + kc);
    *(u32x4*)(qdb + g) = *(const u32x4*)(QD1 + tok * 264 + kc);
    *(u32x4*)(kib + g) = *(const u32x4*)(KI1 + tok * 264 + kc);
  }
}

DEV void gla_scan_unit(const Params& P, int u) {
  unsigned char* ws = P.ws;
  const int tid = threadIdx.x, w = tid >> 6, lane = tid & 63, fr = lane & 15, fq = lane >> 4;
  const int b = u >> 6, h = (u >> 4) & 3, dir = (u >> 3) & 1, sl = u & 7;
  bf16_t* QDs = shm;
  bf16_t* KIT = QDs + 64 * 264;
  bf16_t* VT = KIT + 256 * 72;
  bf16_t* SBs = VT + 64 * 72;
  const bf16_t* qsrc = (const bf16_t*)(ws + (dir ? O_QDB : O_GQ));
  const bf16_t* ksrc = (const bf16_t*)(ws + (dir ? O_KIB : O_GK));
  const bf16_t* vsrc = (const bf16_t*)(ws + O_GV);
  const float* dlp = (const float*)(ws + O_DL) + (size_t)((b * 4 + h) * 2 + dir) * 65 * 256;
  bf16_t* osrc = (bf16_t*)P.out + (size_t)dir * TR * 2048;
  f32x4 S[4][2];
#pragma unroll
  for (int a = 0; a < 4; ++a) { S[a][0] = (f32x4){0.f, 0.f, 0.f, 0.f}; S[a][1] = (f32x4){0.f, 0.f, 0.f, 0.f}; }
  u32x4 rq[4], rk[4], rv; float rdl0, rdl1;
  const int nsteps = dir ? 64 : 65;
#define SCAN_LOAD(cc) do { const size_t pr0 = (size_t)b * LP + (cc) * 64; \
    _Pragma("unroll") for (int i = 0; i < 4; ++i) { const int p = tid + 512 * i, tok = p >> 5, kc = (p & 31) * 8; const size_t g = (pr0 + tok) * 1024 + h * 256 + kc; \
      rq[i] = *(const u32x4*)(qsrc + g); rk[i] = *(const u32x4*)(ksrc + g); } \
    { const int tok = tid >> 3, vc = (tid & 7) * 8; rv = *(const u32x4*)(vsrc + (pr0 + tok) * 2048 + h * 512 + sl * 64 + vc); } \
    rdl0 = dlp[(cc) * 256 + (2 * w) * 16 + fr]; rdl1 = dlp[(cc) * 256 + (2 * w + 1) * 16 + fr]; } while (0)
  SCAN_LOAD(dir ? 64 : 0);
  for (int s = 0; s < nsteps; ++s) {
    const int c = dir ? 64 - s : s;
    const bool do_o = dir ? true : (c >= 1), do_upd = dir ? (c >= 2) : (c <= 63);
    __syncthreads();
#pragma unroll
    for (int i = 0; i < 4; ++i) {
      const int p = tid + 512 * i, tok = p >> 5, kc = (p & 31) * 8;
      *(u32x4*)(QDs + tok * 264 + kc) = rq[i];
      const unsigned kw[4] = {rk[i].x, rk[i].y, rk[i].z, rk[i].w};
#pragma unroll
      for (int e = 0; e < 4; ++e) { KIT[(kc + 2 * e) * 72 + tok] = (bf16_t)(kw[e] & 0xffffu); KIT[(kc + 2 * e + 1) * 72 + tok] = (bf16_t)(kw[e] >> 16); }
    }
    { const int tok = tid >> 3, vc = (tid & 7) * 8; const unsigned vw[4] = {rv.x, rv.y, rv.z, rv.w};
#pragma unroll
      for (int e = 0; e < 4; ++e) { VT[(vc + 2 * e) * 72 + tok] = (bf16_t)(vw[e] & 0xffffu); VT[(vc + 2 * e + 1) * 72 + tok] = (bf16_t)(vw[e] >> 16); } }
#pragma unroll
    for (int vt = 0; vt < 4; ++vt)
#pragma unroll
      for (int kt = 0; kt < 2; ++kt)
#pragma unroll
        for (int r = 0; r < 4; ++r) SBs[(vt * 16 + fq * 4 + r) * 264 + (2 * w + kt) * 16 + fr] = f2bf(S[vt][kt][r]);
    const float dl0 = rdl0, dl1 = rdl1;
    __syncthreads();
    if (s + 1 < nsteps) SCAN_LOAD(dir ? 64 - (s + 1) : s + 1);
    if (do_o) {
      const int ti = w >> 1;
#pragma unroll
      for (int jj = 0; jj < 2; ++jj) {
        const int tj = (w & 1) * 2 + jj;
        f32x4 a4 = (f32x4){0.f, 0.f, 0.f, 0.f};
#pragma unroll
        for (int kk = 0; kk < 8; ++kk) a4 = mfma16(LD8(SBs + (tj * 16 + fr) * 264 + kk * 32 + fq * 8), LD8(QDs + (ti * 16 + fr) * 264 + kk * 32 + fq * 8), a4);
        const size_t nrow = (size_t)b * SEQ + (c - 1) * 64 + ti * 16 + fr;
        store_bf4(osrc + nrow * 2048 + h * 512 + sl * 64 + tj * 16 + fq * 4, a4);
      }
    }
    if (do_upd) {
#pragma unroll
      for (int vt = 0; vt < 4; ++vt)
#pragma unroll
        for (int kt = 0; kt < 2; ++kt) {
#pragma unroll
          for (int kk = 0; kk < 2; ++kk) S[vt][kt] = mfma16(LD8(VT + (vt * 16 + fr) * 72 + kk * 32 + fq * 8), LD8(KIT + ((2 * w + kt) * 16 + fr) * 72 + kk * 32 + fq * 8), S[vt][kt]);
          S[vt][kt] = S[vt][kt] * (kt ? dl1 : dl0);
        }
    }
  }
#undef SCAN_LOAD
}

DEV void gla_finish_unit(const Params& P, int u) {
  unsigned char* ws = P.ws;
  const int tid = threadIdx.x, w = tid >> 6, lane = tid & 63, fr = lane & 15, fq = lane >> 4;
  const int c = (u & 63) + 1, bh = u >> 6, b = bh >> 2, h = bh & 3;
  bf16_t* VTf = shm;
  bf16_t* Pl = VTf + 512 * 72;
  float* red = (float*)(Pl + 64 * 72);
  const size_t prow0 = (size_t)b * LP + c * 64, nrow0 = (size_t)b * SEQ + (c - 1) * 64;
  const bf16_t* gv = (const bf16_t*)(ws + O_GV);
  __syncthreads();
  { const int i = tid >> 3, j0 = (tid & 7) * 8;
    *(u32x4*)(Pl + i * 72 + j0) = *(const u32x4*)((const bf16_t*)(ws + O_P) + (size_t)(bh * 65 + c) * 4096 + i * 64 + j0); }
#pragma unroll
  for (int q = 0; q < 8; ++q) {
    const int p = tid + 512 * q, tok = p >> 6, vc = (p & 63) * 8;
    const u32x4 v = *(const u32x4*)(gv + (prow0 + tok) * 2048 + h * 512 + vc);
    const unsigned vw[4] = {v.x, v.y, v.z, v.w};
#pragma unroll
    for (int e = 0; e < 4; ++e) { VTf[(vc + 2 * e) * 72 + tok] = (bf16_t)(vw[e] & 0xffffu); VTf[(vc + 2 * e + 1) * 72 + tok] = (bf16_t)(vw[e] >> 16); }
  }
  __syncthreads();
  f32x4 acc[4][4];
  const bf16_t* of = (const bf16_t*)P.out; const bf16_t* ob = of + (size_t)TR * 2048;
  float ss[4] = {0.f, 0.f, 0.f, 0.f};
#pragma unroll
  for (int vt = 0; vt < 4; ++vt)
#pragma unroll
    for (int it = 0; it < 4; ++it) {
      f32x4 a4 = (f32x4){0.f, 0.f, 0.f, 0.f};
#pragma unroll
      for (int kk = 0; kk < 2; ++kk) a4 = mfma16(LD8(VTf + (w * 64 + vt * 16 + fr) * 72 + kk * 32 + fq * 8), LD8(Pl + (it * 16 + fr) * 72 + kk * 32 + fq * 8), a4);
      const size_t g = (nrow0 + it * 16 + fr) * 2048 + h * 512 + w * 64 + vt * 16 + fq * 4;
      a4 = a4 + load_bf4(of + g) + load_bf4(ob + g);
      acc[vt][it] = a4;
      ss[it] += a4[0] * a4[0] + a4[1] * a4[1] + a4[2] * a4[2] + a4[3] * a4[3];
    }
#pragma unroll
  for (int it = 0; it < 4; ++it) { float s = ss[it]; s += __shfl_xor(s, 16); s += __shfl_xor(s, 32); if (fq == 0) red[w * 64 + it * 16 + fr] = s; }
  __syncthreads();
  bf16_t* gr = (bf16_t*)(ws + O_GR);
#pragma unroll
  for (int it = 0; it < 4; ++it) {
    float tot = 0.f;
#pragma unroll
    for (int ww = 0; ww < 8; ++ww) tot += red[ww * 64 + it * 16 + fr];
    const float rs = rsqrtf(tot * (1.f / 512.f) + EPS);
#pragma unroll
    for (int vt = 0; vt < 4; ++vt) {
      const int vcol = w * 64 + vt * 16 + fq * 4;
      bf16_t* gp = gr + (prow0 + it * 16 + fr) * 2048 + h * 512 + vcol;
      const f32x4 g4 = load_bf4(gp), nw = *(const f32x4*)(P.gnorm + vcol);
      f32x4 y;
#pragma unroll
      for (int j = 0; j < 4; ++j) y[j] = acc[vt][it][j] * rs * nw[j] * (g4[j] * sigm(g4[j]));
      store_bf4(gp, y);
    }
  }
}

constexpr int QBLK = 32, KVBLK = 64;
constexpr float ASCALE = 0.088388347648318440f;
constexpr float ATHR = 8.f;
constexpr int LDA_ = 2048;
constexpr size_t SHM_V = KVBLK * 128 * 2, SHM_K = KVBLK * 128 * 2, SHM_ATTN = 2 * SHM_V + 2 * SHM_K + 8 * 64 * 4;
#define KSWZ(row, colB) ((row) * 256 + ((colB) ^ (((row) & 7) << 4)))
#define SBAR() __builtin_amdgcn_sched_barrier(0)
DEV int crow(int r, int hi) { return (r & 3) + 8 * (r >> 2) + 4 * hi; }

template <int MODE> DEV void alibi(f32x16& p0, f32x16& p1, float base, float nslope) {
#pragma unroll
  for (int r = 0; r < 16; ++r) {
    const float cc = (float)((r & 3) + 8 * (r >> 2));
    p0[r] = fmaf(nslope, fabsf(base - cc), p0[r]);
    p1[r] = fmaf(nslope, fabsf(base - cc - 32.f), p1[r]);
    if (MODE == 1) { p0[r] = -1e30f; if (r < 8) p1[r] = -1e30f; }
    if (MODE == 2) { p0[r] = -1e30f; p1[r] = -1e30f; }
  }
}
DEV void partialSM(f32x16& p0, f32x16& p1, float& m_reg, float& mn, float& alpha) {
  constexpr float C = ASCALE * 1.4426950408889634f;
  float pmax = p0[0];
#pragma unroll
  for (int r = 1; r < 16; ++r) pmax = fmaxf(pmax, p0[r]);
#pragma unroll
  for (int r = 0; r < 16; ++r) pmax = fmaxf(pmax, p1[r]);
  { auto rr = __builtin_amdgcn_permlane32_swap(__float_as_uint(pmax), __float_as_uint(pmax), false, false);
    pmax = fmaxf(__uint_as_float(rr[0]), __uint_as_float(rr[1])); }
  if (__builtin_expect(__all(pmax - m_reg <= ATHR / ASCALE), 1)) { mn = m_reg; alpha = 1.f; }
  else { mn = fmaxf(m_reg, pmax); alpha = __builtin_amdgcn_exp2f((m_reg - mn) * C); m_reg = mn; }
  const float mnC = -mn * C;
#pragma unroll
  for (int r = 0; r < 16; ++r) p0[r] = fmaf(p0[r], C, mnC);
#pragma unroll
  for (int r = 0; r < 16; ++r) p1[r] = fmaf(p1[r], C, mnC);
#pragma unroll
  for (int r = 0; r < 16; ++r) p0[r] = __builtin_amdgcn_exp2f(p0[r]);
}
DEV void finishSM(f32x16& p0, f32x16& p1, float alpha, float& l_reg, bf16x8& pa0, bf16x8& pa1, bf16x8& pa2, bf16x8& pa3) {
#pragma unroll
  for (int r = 0; r < 16; ++r) p1[r] = __builtin_amdgcn_exp2f(p1[r]);
  float ps = 0;
#pragma unroll
  for (int r = 0; r < 16; ++r) ps += p0[r];
#pragma unroll
  for (int r = 0; r < 16; ++r) ps += p1[r];
  { auto rr = __builtin_amdgcn_permlane32_swap(__float_as_uint(ps), __float_as_uint(ps), false, false);
    ps = __uint_as_float(rr[0]) + __uint_as_float(rr[1]); }
  l_reg = l_reg * alpha + ps;
#define PK4(P_, BASE, OUT) do { unsigned a0 = pk2(P_[BASE + 0], P_[BASE + 1]), a1 = pk2(P_[BASE + 2], P_[BASE + 3]);   \
    unsigned b0 = pk2(P_[BASE + 4], P_[BASE + 5]), b1 = pk2(P_[BASE + 6], P_[BASE + 7]);                              \
    auto r0 = __builtin_amdgcn_permlane32_swap(a0, b0, false, false); auto r1 = __builtin_amdgcn_permlane32_swap(a1, b1, false, false); \
    u32x4 w_ = {r0[0], r1[0], r0[1], r1[1]}; OUT = *reinterpret_cast<bf16x8*>(&w_); } while (0)
  PK4(p0, 0, pa0); PK4(p0, 8, pa1); PK4(p1, 0, pa2); PK4(p1, 8, pa3);
#undef PK4
}
DEV void qkt(f32x16& p0, f32x16& p1, const bf16_t* Ks, const bf16x8* qr, int r32, int hi) {
  p0 = f32x16{}; p1 = f32x16{};
#pragma unroll
  for (int d0 = 0; d0 < 8; ++d0) { const int cb = (d0 * 16 + hi * 8) * 2;
    bf16x8 b0 = *reinterpret_cast<const bf16x8*>((const char*)Ks + KSWZ(r32, cb));
    bf16x8 b1 = *reinterpret_cast<const bf16x8*>((const char*)Ks + KSWZ(32 + r32, cb));
    p0 = __builtin_amdgcn_mfma_f32_32x32x16_bf16(b0, qr[d0], p0, 0, 0, 0);
    p1 = __builtin_amdgcn_mfma_f32_32x32x16_bf16(b1, qr[d0], p1, 0, 0, 0); }
}
DEV int v_st(int k, int c) { const int kk = (k & ~0xC) | ((k & 4) << 1) | ((k & 8) >> 1); return ((kk >> 3) * 4 + (c >> 5)) * 512 + ((kk & 7) * 32 + (c & 31)) * 2; }
DEV int v_rd_base(int lane) { return ((lane & 3) << 3) | (((lane >> 2) & 3) << 6) | (((lane >> 4) & 1) << 5) | (((lane >> 5) & 1) << 8); }
constexpr int v_rd_off(int d0, int ks, int half) { return d0 * 512 + ks * 4096 + half * 2048; }
template <int OFF> DEV s16x4 tr_read(int vb) { s16x4 r; asm volatile("ds_read_b64_tr_b16 %0, %1 offset:%2" : "=&v"(r) : "v"(vb), "i"(OFF) : "memory"); return r; }
template <int D0> DEV void pv_one(f32x16& od, int vb, bf16x8 pa0, bf16x8 pa1, bf16x8 pa2, bf16x8 pa3) {
  const s16x4 l0 = tr_read<v_rd_off(D0, 0, 0)>(vb), h0 = tr_read<v_rd_off(D0, 0, 1)>(vb), l1 = tr_read<v_rd_off(D0, 1, 0)>(vb), h1 = tr_read<v_rd_off(D0, 1, 1)>(vb);
  const s16x4 l2 = tr_read<v_rd_off(D0, 2, 0)>(vb), h2 = tr_read<v_rd_off(D0, 2, 1)>(vb), l3 = tr_read<v_rd_off(D0, 3, 0)>(vb), h3 = tr_read<v_rd_off(D0, 3, 1)>(vb);
  asm volatile("s_waitcnt lgkmcnt(0)" ::: "memory"); SBAR();
#define PK(L, H) (bf16x8){L[0], L[1], L[2], L[3], H[0], H[1], H[2], H[3]}
  od = __builtin_amdgcn_mfma_f32_32x32x16_bf16(pa0, PK(l0, h0), od, 0, 0, 0);
  od = __builtin_amdgcn_mfma_f32_32x32x16_bf16(pa1, PK(l1, h1), od, 0, 0, 0);
  od = __builtin_amdgcn_mfma_f32_32x32x16_bf16(pa2, PK(l2, h2), od, 0, 0, 0);
  od = __builtin_amdgcn_mfma_f32_32x32x16_bf16(pa3, PK(l3, h3), od, 0, 0, 0);
#undef PK
}
DEV void pv_d0(f32x16* o, int vb, bf16x8 pa0, bf16x8 pa1, bf16x8 pa2, bf16x8 pa3) {
  pv_one<0>(o[0], vb, pa0, pa1, pa2, pa3); pv_one<1>(o[1], vb, pa0, pa1, pa2, pa3); pv_one<2>(o[2], vb, pa0, pa1, pa2, pa3); pv_one<3>(o[3], vb, pa0, pa1, pa2, pa3);
}

DEV void attn_body(const bf16_t* __restrict__ Qb, const bf16_t* __restrict__ Kh, const bf16_t* __restrict__ Vh, const bf16_t* __restrict__ Km, const bf16_t* __restrict__ Vm, int qrel, float nslope, char* lds, f32x16 (&o)[4]) {
  int tid = threadIdx.x; asm volatile("" : "+v"(tid));
  const int wid = __builtin_amdgcn_readfirstlane(tid >> 6), lane = tid & 63, r32 = lane & 31, hi = lane >> 5;
  bf16_t* V_lds = (bf16_t*)lds; bf16_t* K_lds = (bf16_t*)(lds + 2 * SHM_V);
  float* wsl = (float*)(lds + 2 * SHM_V + 2 * SHM_K) + wid * 64; float* li_l = wsl; float* al_l = wsl + 32;
  float m_reg = -1e30f, l_reg = 0;
#pragma unroll
  for (int d = 0; d < 4; ++d) o[d] = f32x16{};
  bf16x8 qr[8];
  const bf16_t* Qw = Qb + (long)(wid * QBLK + r32) * LDA_ + hi * 8;
#pragma unroll
  for (int d0 = 0; d0 < 8; ++d0) qr[d0] = *reinterpret_cast<const bf16x8*>(Qw + d0 * 16);
  const float fbase = (float)(qrel + wid * QBLK + r32 - 4 * hi);
  const int sr = tid >> 4, sc = (tid & 15) * 8, vst0 = v_st(sr, sc), vst1 = v_st(32 + sr, sc);
  const int vb0 = (int)(uintptr_t)V_lds + v_rd_base(lane);
  struct { bf16x8 vs0, vs1, ks0, ks1; } sr_[2];
  constexpr int NT = 66;
#define TCL(j) ((j) < 64 ? (j) : 64)
#define SLOAD(i, jt) do { const long k0_ = (long)TCL(jt) * KVBLK; const bf16_t* Vt_ = (jt) == 0 ? Vm : Vh; const bf16_t* Kt_ = (jt) == 0 ? Km : Kh; \
    sr_[i].vs0 = *reinterpret_cast<const bf16x8*>(&Vt_[(k0_ + sr) * LDA_ + sc]); sr_[i].vs1 = *reinterpret_cast<const bf16x8*>(&Vt_[(k0_ + 32 + sr) * LDA_ + sc]); \
    sr_[i].ks0 = *reinterpret_cast<const bf16x8*>(&Kt_[(k0_ + sr) * LDA_ + sc]); sr_[i].ks1 = *reinterpret_cast<const bf16x8*>(&Kt_[(k0_ + 32 + sr) * LDA_ + sc]); } while (0)
#define SWRITE(b, i) do { *(bf16x8*)((char*)V_lds + (b) * SHM_V + vst0) = sr_[i].vs0;          \
    *(bf16x8*)((char*)V_lds + (b) * SHM_V + vst1) = sr_[i].vs1; const int kc = sc * 2;               \
    *(bf16x8*)((char*)K_lds + (b) * SHM_K + KSWZ(sr, kc)) = sr_[i].ks0;                       \
    *(bf16x8*)((char*)K_lds + (b) * SHM_K + KSWZ(32 + sr, kc)) = sr_[i].ks1; } while (0)
#define SWAIT() asm volatile("s_waitcnt vmcnt(4)" ::: "memory")
#define RESC(a) do { if (__any((a) < 1.f)) { if (hi == 0) al_l[r32] = (a); asm volatile("s_waitcnt lgkmcnt(0)" ::: "memory"); \
    _Pragma("unroll") for (int d = 0; d < 4; ++d) _Pragma("unroll") for (int r = 0; r < 16; ++r) o[d][r] *= al_l[crow(r, hi)]; } } while (0)
  f32x16 pA0, pA1, pB0, pB1; float mnA, mnB, alA, alB; bf16x8 pa0, pa1, pa2, pa3;
  constexpr int SE = 0, SO = 1;
  __syncthreads();
  SLOAD(SE, 0); asm volatile("s_waitcnt vmcnt(0)" ::: "memory"); SWRITE(0, SE); __syncthreads();
  qkt(pA0, pA1, K_lds, qr, r32, hi); alibi<1>(pA0, pA1, fbase, nslope); partialSM(pA0, pA1, m_reg, mnA, alA);
  SLOAD(SO, 1); SLOAD(SE, 2);
  SWAIT(); SWRITE(1, SO); __syncthreads();
  for (int j = 1; j + 1 < NT; j += 2) {
    SBAR(); qkt(pB0, pB1, (bf16_t*)((char*)K_lds + SHM_K), qr, r32, hi); alibi<0>(pB0, pB1, fbase - 64.f * (float)j, nslope);
    finishSM(pA0, pA1, alA, l_reg, pa0, pa1, pa2, pa3); SBAR();
    SLOAD(SO, j + 2); SBAR();
    pv_d0(o, vb0, pa0, pa1, pa2, pa3); partialSM(pB0, pB1, m_reg, mnB, alB);
    __syncthreads(); SWAIT(); SWRITE(0, SE);
    RESC(alB); __syncthreads();
    SBAR(); qkt(pA0, pA1, K_lds, qr, r32, hi); alibi<0>(pA0, pA1, fbase - 64.f * (float)(j + 1), nslope);
    finishSM(pB0, pB1, alB, l_reg, pa0, pa1, pa2, pa3); SBAR();
    if (j + 3 < NT) SLOAD(SE, j + 3); SBAR();
    pv_d0(o, vb0 + (int)SHM_V, pa0, pa1, pa2, pa3); partialSM(pA0, pA1, m_reg, mnA, alA);
    __syncthreads(); SWAIT(); SWRITE(1, SO);
    RESC(alA); __syncthreads();
  }
  SBAR(); qkt(pB0, pB1, (bf16_t*)((char*)K_lds + SHM_K), qr, r32, hi); alibi<2>(pB0, pB1, fbase, nslope);
  finishSM(pA0, pA1, alA, l_reg, pa0, pa1, pa2, pa3); SBAR();
  pv_d0(o, vb0, pa0, pa1, pa2, pa3); partialSM(pB0, pB1, m_reg, mnB, alB);
  __syncthreads(); RESC(alB);
  finishSM(pB0, pB1, alB, l_reg, pa0, pa1, pa2, pa3); SBAR();
  pv_d0(o, vb0 + (int)SHM_V, pa0, pa1, pa2, pa3);
  if (hi == 0) li_l[r32] = l_reg; asm volatile("s_waitcnt lgkmcnt(0)" ::: "memory");
#pragma unroll
  for (int r = 0; r < 16; ++r) { const float rl = __builtin_amdgcn_rcpf(li_l[crow(r, hi)]);
#pragma unroll
    for (int d = 0; d < 4; ++d) o[d][r] *= rl; }
#undef SLOAD
#undef SWRITE
#undef SWAIT
#undef RESC
#undef TCL
}

DEV void attn_unit(const Params& P, int u, float lam) {
  unsigned char* ws = P.ws;
  const int tid_ = threadIdx.x, wid = __builtin_amdgcn_readfirstlane(tid_ >> 6);
  const int qblk = u & 15, vh = (u >> 4) & 1, h = (u >> 5) & 7, b = u >> 8;
  const bf16_t* dq = (const bf16_t*)(ws + O_DQ); const bf16_t* dk = (const bf16_t*)(ws + O_DK); const bf16_t* dv = (const bf16_t*)(ws + O_DV);
  const size_t brow = (size_t)b * LP; const int qrel = 64 + qblk * 256;
  const float slope = __builtin_amdgcn_exp2f(-(float)(h + 1));
  const float nslope = -slope / ASCALE;
  unsigned* stash = (unsigned*)(shm_raw + SHM_ATTN);
  f32x16 o[4];
  for (int mp = 0; mp < 2; ++mp) {
    attn_body(dq + (brow + qrel) * 2048 + h * 256 + mp * 128, dk + brow * 2048 + h * 256 + mp * 128, dv + brow * 2048 + h * 256 + vh * 128,
              (const bf16_t*)(ws + O_DKM) + h * 256 + mp * 128, (const bf16_t*)(ws + O_DVM) + h * 256 + vh * 128, qrel, nslope, (char*)shm_raw, o);
    if (mp == 0) {
      int tid = tid_; asm volatile("" : "+v"(tid));
#pragma unroll
      for (int d = 0; d < 4; ++d)
#pragma unroll
        for (int r = 0; r < 16; r += 2) stash[(d * 8 + (r >> 1)) * 512 + tid] = pk2(o[d][r], o[d][r + 1]);
    }
  }
  int tid = tid_; asm volatile("" : "+v"(tid));
  const int lane = tid & 63, r32 = lane & 31, hi = lane >> 5;
  bf16_t* dd = (bf16_t*)(ws + O_DD); float* dst = (float*)(ws + O_DST);
  const size_t prow = brow + qrel + wid * 32;
  float ss[16];
#pragma unroll
  for (int r = 0; r < 16; ++r) ss[r] = 0.f;
#pragma unroll
  for (int d = 0; d < 4; ++d)
#pragma unroll
    for (int r = 0; r < 16; r += 2) {
      const unsigned s2 = stash[(d * 8 + (r >> 1)) * 512 + tid];
      const float v0 = __uint_as_float(s2 << 16) - lam * o[d][r], v1 = __uint_as_float(s2 & 0xffff0000u) - lam * o[d][r + 1];
      ss[r] += v0 * v0; ss[r + 1] += v1 * v1;
      dd[(prow + crow(r, hi)) * 2048 + h * 256 + vh * 128 + d * 32 + r32] = f2bf(v0);
      dd[(prow + crow(r + 1, hi)) * 2048 + h * 256 + vh * 128 + d * 32 + r32] = f2bf(v1);
    }
#pragma unroll
  for (int r = 0; r < 16; ++r) {
    float s = ss[r];
#pragma unroll
    for (int of = 16; of >= 1; of >>= 1) s += __shfl_xor(s, of);
    if (r32 == 0) dst[(prow + crow(r, hi)) * 16 + h * 2 + vh] = s;
  }
}

DEV void l2_sweep(const Params& P) {
  const f32x4* src = (const f32x4*)P.x + (size_t)(blockIdx.x & 63) * 131072;
  f32x4 a = (f32x4){0.f, 0.f, 0.f, 0.f};
  for (int i = threadIdx.x; i < 131072; i += NTHR) a += src[i];
  if (a[0] + a[1] + a[2] + a[3] == 123456.789f) ((float*)(P.ws + O_DST))[0] = 1.f;
}
DEV void gsync(cg::grid_group& grid) {
  asm volatile("s_waitcnt vmcnt(0) lgkmcnt(0)" ::: "memory");
  __syncthreads();
  __builtin_amdgcn_fence(__ATOMIC_RELEASE, "agent");
  asm volatile("s_waitcnt vmcnt(0)" ::: "memory");
  grid.sync();
  __builtin_amdgcn_fence(__ATOMIC_ACQUIRE, "agent");
  asm volatile("s_waitcnt vmcnt(0)" ::: "memory");
  __syncthreads();
}
#ifndef DBG_STOP
#define DBG_STOP 0
#endif
DEV void dbg_dump(const Params& P, size_t off, int ld = 2048) {
  const int tid = threadIdx.x, lane = tid & 63, gw = (blockIdx.x * NTHR + tid) >> 6, nw = (gridDim.x * NTHR) >> 6;
  const bf16_t* buf = (const bf16_t*)(P.ws + off);
  for (int r = gw; r < TR; r += nw) {
    const size_t prow = (size_t)(r >> 12) * LP + 64 + (r & 4095);
    for (int i = 0; i < 8; ++i) { const int c = i * 256 + lane * 4; f32x4 v = (f32x4){0.f, 0.f, 0.f, 0.f}; if (c < ld) v = load_bf4(buf + prow * ld + c); for (int j = 0; j < 4; ++j) if (!(fabsf(v[j]) < 1e30f)) v[j] = 10000.f; *(f32x4*)(P.out + (size_t)r * 2048 + c) = v; }
  }
}
#define STOP_AT(k, off) if (DBG_STOP == (k)) { dbg_dump(P, off); return; }
#define STOP_AT2(k, off) if (DBG_STOP == (k)) { dbg_dump(P, off, 1024); return; }
#ifndef ONLY
#define PH(n) true
#else
#define PH(n) ((ONLY) == (n))
#endif
__global__ void __launch_bounds__(NTHR, 2) mega(Params P) {
  cg::grid_group grid = cg::this_grid();
  unsigned char* ws = P.ws;
  if (PH(0)) phase_prologue(P);
  gsync(grid);
  if (PH(1)) for (int gp = G_FFN1_GU; gp <= G_WIN_META; ++gp) { gemm_phase(P, gp); gsync(grid); if (gp == G_FFN1_D) { STOP_AT(1, O_ACTB) } if (gp == G_WIN_META) { STOP_AT(6, O_GV) } }
  if (PH(2)) for (int u = blockIdx.x; u < 16 * 65; u += gridDim.x) gla_prep_unit(P, u);
  gsync(grid);
  STOP_AT2(7, O_KIB)
  STOP_AT2(10, O_QDB)
  if (DBG_STOP == 11) {
    const int tid = threadIdx.x, lane = tid & 63, gw = (blockIdx.x * NTHR + tid) >> 6, nw = (gridDim.x * NTHR) >> 6;
    const bf16_t* b0 = (const bf16_t*)(ws + O_GK); const bf16_t* b1 = (const bf16_t*)(ws + O_GV); const float* dl = (const float*)(ws + O_DL);
    for (int r = gw; r < TR; r += nw) { const size_t prow = (size_t)(r >> 6) * LP + (r & 63);
      for (int i = 0; i < 8; ++i) { const int c = i * 256 + lane * 4; f32x4 v = (f32x4){0.f, 0.f, 0.f, 0.f};
        if (r < 256) v = c < 1024 ? load_bf4(b0 + prow * 1024 + c) : load_bf4(b1 + prow * 2048 + c - 1024);
        else if (r < 272 && c < 256) v = *(const f32x4*)(dl + (size_t)((r - 256) * 2) * 65 * 256 + c);
        *(f32x4*)(P.out + (size_t)r * 2048 + c) = v; } }
    return;
  }
  if (DBG_STOP == 9) {
    const int tid = threadIdx.x, lane = tid & 63, gw = (blockIdx.x * NTHR + tid) >> 6, nw = (gridDim.x * NTHR) >> 6;
    const bf16_t* b0 = (const bf16_t*)(ws + O_GQ); const bf16_t* b1 = (const bf16_t*)(ws + O_GK);
    for (int r = gw; r < TR; r += nw) { const size_t prow = (size_t)(r >> 12) * LP + 64 + (r & 4095);
      for (int i = 0; i < 8; ++i) { const int c = i * 256 + lane * 4; *(f32x4*)(P.out + (size_t)r * 2048 + c) = c < 1024 ? load_bf4(b0 + prow * 1024 + c) : load_bf4(b1 + prow * 1024 + c - 1024); } }
    return;
  }
  if (PH(3)) for (int u = blockIdx.x; u < 256; u += gridDim.x) gla_scan_unit(P, u);
  gsync(grid);
  if (DBG_STOP == 8) {
    const int tid = threadIdx.x, lane = tid & 63, gw = (blockIdx.x * NTHR + tid) >> 6, nw = (gridDim.x * NTHR) >> 6;
    const bf16_t* of = (const bf16_t*)P.out; const bf16_t* ob = of + (size_t)TR * 2048; bf16_t* g = (bf16_t*)(ws + O_GR);
    for (int r = gw; r < TR; r += nw) { const size_t prow = (size_t)(r >> 12) * LP + 64 + (r & 4095);
      for (int i = 0; i < 8; ++i) { const int c = i * 256 + lane * 4; store_bf4(g + prow * 2048 + c, load_bf4(of + (size_t)r * 2048 + c) + load_bf4(ob + (size_t)r * 2048 + c)); } }
    gsync(grid);
    dbg_dump(P, O_GR); return;
  }
  if (PH(4)) for (int u = blockIdx.x; u < 1024; u += gridDim.x) gla_finish_unit(P, u);
  gsync(grid);
  STOP_AT(2, O_GR)
  if (PH(1)) gemm_phase(P, G_WIN_B);
  gsync(grid);
  if (PH(5)) {
    float s1 = 0.f, s2 = 0.f;
    for (int i = 0; i < 128; ++i) { s1 = fmaf(P.lq1[i], P.lk1[i], s1); s2 = fmaf(P.lq2[i], P.lk2[i], s2); }
    const float lam = __expf(s1) - __expf(s2) + 0.2f;
    for (int u = blockIdx.x; u < 1024; u += gridDim.x) attn_unit(P, u, lam);
  }
  gsync(grid);
  if (PH(6)) {
    int tid = threadIdx.x; asm volatile("" : "+v"(tid)); const int lane = tid & 63;
    const int gw = (blockIdx.x * NTHR + tid) >> 6, nw = (gridDim.x * NTHR) >> 6;
    bf16_t* dd = (bf16_t*)(ws + O_DD); const float* dst = (const float*)(ws + O_DST);
    for (int r = gw; r < TR; r += nw) {
      const size_t prow = (size_t)(r >> 12) * LP + 64 + (r & 4095);
      const int col = lane * 32, hh = col >> 8;
      const float rs = rsqrtf((dst[prow * 16 + hh * 2] + dst[prow * 16 + hh * 2 + 1]) * (1.f / 256.f) + EPS) * 0.8f;
#pragma unroll
      for (int i = 0; i < 8; ++i) { bf16_t* p = dd + prow * 2048 + col + i * 4; f32x4 v = load_bf4(p); const f32x4 nw4 = *(const f32x4*)(P.dnorm + ((col + i * 4) & 255)); v = v * nw4 * rs; store_bf4(p, v); }
    }
    int tbase = 0, t = blockIdx.x; bf16_t* wf = (bf16_t*)(ws + O_WF);
    transpose_job(P.w2g, 2048, DFF, wf + (size_t)DFF * 2048, P.n2, false, tbase, t);
    transpose_job(P.w2u, 2048, DFF, wf + (size_t)2 * DFF * 2048, P.n2, false, tbase, t);
    transpose_job(P.w2d, DFF, 2048, wf, nullptr, false, tbase, t);
  }
  gsync(grid);
  STOP_AT(3, O_DD)
  if (PH(1)) for (int gp = G_MERGE; gp <= G_FFN2_D; ++gp) { gemm_phase(P, gp); gsync(grid); if (gp == G_MERGE) { STOP_AT(4, O_MRG) } if (gp == G_OUT) { STOP_AT(5, O_ACTB) } }
  if (PH(7)) {
    int tid = threadIdx.x; asm volatile("" : "+v"(tid)); const int lane = tid & 63;
    const int gw = (blockIdx.x * NTHR + tid) >> 6, nw = (gridDim.x * NTHR) >> 6;
    for (int r = gw; r < TR; r += nw) {
      float* p = P.out + (size_t)r * 2048;
      f32x4 v[8]; float ss = 0.f;
#pragma unroll
      for (int i = 0; i < 8; ++i) { v[i] = *(f32x4*)(p + i * 256 + lane * 4); ss += v[i][0] * v[i][0] + v[i][1] * v[i][1] + v[i][2] * v[i][2] + v[i][3] * v[i][3]; }
#pragma unroll
      for (int o = 32; o >= 1; o >>= 1) ss += __shfl_xor(ss, o);
      const float rs = rsqrtf(ss * (1.f / 2048.f) + EPS);
#pragma unroll
      for (int i = 0; i < 8; ++i) { const int c = i * 256 + lane * 4; const f32x4 g = *(const f32x4*)(P.nfin + c); *(f32x4*)(p + c) = v[i] * g * rs; }
    }
  }
}

constexpr size_t DYN_LDS = 4 * 64 * 264 * 2 + 64 * 32 * 4;
static_assert(DYN_LDS >= 8 * HT * 2 && DYN_LDS >= SHM_ATTN + 65536, "lds");

extern "C" void kernel_launch(void* const* d_in, const int* in_sizes, int n_in, void* d_out, int out_size, void* d_ws, size_t ws_size, hipStream_t stream) {
  if (n_in != 26 || ws_size < WS_TOTAL || out_size != TR * 2048) { fprintf(stderr, "kernel_launch: bad shapes n_in %d ws %zu need %zu out %d\n", n_in, ws_size, WS_TOTAL, out_size); return; }
  static int grid_blocks = 0;
  if (!grid_blocks) {
    hipFuncSetAttribute((const void*)mega, hipFuncAttributeMaxDynamicSharedMemorySize, (int)DYN_LDS);
    int dev = 0, cus = 0, per_cu = 0;
    hipGetDevice(&dev);
    hipDeviceGetAttribute(&cus, hipDeviceAttributeMultiprocessorCount, dev);
    hipOccupancyMaxActiveBlocksPerMultiprocessor(&per_cu, mega, NTHR, DYN_LDS);
    if (per_cu < 1) per_cu = 1;
    grid_blocks = cus;
  }
  Params p{};
  const float** pp = (const float**)&p;
  for (int i = 0; i < 26; ++i) pp[i] = (const float*)d_in[i];
  p.out = (float*)d_out; p.ws = (unsigned char*)d_ws;
  void* args[] = {&p};
  hipError_t e = hipLaunchCooperativeKernel((void*)mega, dim3(grid_blocks), dim3(NTHR), args, DYN_LDS, stream);
  if (e != hipSuccess) fprintf(stderr, "cooperative launch failed: %s (grid %d)\n", hipGetErrorString(e), grid_blocks);
}
```

```cpp
#include <hip/hip_runtime.h>
#include <hip/hip_cooperative_groups.h>
#include <stdint.h>
#include <cstdio>
namespace cg = cooperative_groups;

#define DEV __device__ __forceinline__
typedef unsigned short bf16_t;
using bf16x8 = __attribute__((ext_vector_type(8))) short;
using s16x4  = __attribute__((ext_vector_type(4))) short;
using f32x4  = __attribute__((ext_vector_type(4))) float;
using f32x16 = __attribute__((ext_vector_type(16))) float;
using u32x4  = __attribute__((ext_vector_type(4))) unsigned;
using u32x2  = __attribute__((ext_vector_type(2))) unsigned;

constexpr int DM = 2048, DFF = 5504, NB = 4, SEQ = 4096, LP = 4160, RP = NB * LP  , TR = NB * SEQ  ;
constexpr int INW = 16416;
constexpr float EPS = 1e-6f;
constexpr size_t DYN_LDS_MAIN = 4 * 64 * 264 * 2 + 64 * 32 * 4;
constexpr int NTHR = 512;

constexpr size_t SZ_ACT = (size_t)RP * 2048 * 2;
constexpr size_t SZ_HALF = (size_t)RP * 1024 * 2;
constexpr size_t SZ_SQ = (size_t)2048 * 2048 * 2;
constexpr size_t SZ_FW = (size_t)DFF * 2048 * 2;
constexpr size_t SZ_HID = (size_t)RP * DFF * 2;
constexpr size_t O_ACTB = 0;
constexpr size_t O_WIN = O_ACTB + SZ_ACT;
constexpr size_t O_WS = O_WIN + SZ_ACT;
constexpr size_t O_WF = O_WS + 3 * SZ_SQ;
constexpr size_t O_HID = O_WF + 3 * SZ_FW;
constexpr size_t O_R = O_HID + SZ_HID;
constexpr size_t O_F = O_R;
constexpr size_t O_GR = O_F + SZ_ACT;
constexpr size_t O_P = O_GR + SZ_ACT;
constexpr size_t SZ_P = (size_t)16 * 65 * 4096 * 2;
constexpr size_t O_LOW = O_P + SZ_P;
constexpr size_t O_DL = O_LOW + (size_t)RP * 32 * 4;
constexpr size_t O_ST = O_DL + (size_t)16 * 2 * 65 * 256 * 4;
constexpr size_t O_ST1 = O_ST + (size_t)RP * 4, O_ST2 = O_ST1 + (size_t)RP * 32 * 4;
constexpr size_t O_DST = O_ST2 + (size_t)RP * 32 * 4;
constexpr size_t O_DKM = O_DST + (size_t)RP * 16 * 4;
constexpr size_t O_DVM = O_DKM + (size_t)64 * 2048 * 2;
constexpr size_t O_BAR = O_DVM + (size_t)64 * 2048 * 2;
constexpr size_t WS_TOTAL = O_BAR + 16384;
constexpr size_t O_GQ = O_WF + SZ_FW, O_GK = O_HID + (size_t)256 * DFF * 2, O_GV = O_GK + SZ_HALF, O_QDB = O_GV + SZ_ACT, O_KIB = O_QDB + SZ_HALF;
static_assert(O_GQ + SZ_HALF <= O_HID && O_KIB + SZ_HALF <= O_R, "gla overlay 2");
constexpr size_t O_DQ = O_WF, O_DK = O_DQ + SZ_ACT, O_DV = O_DK + SZ_ACT;
constexpr size_t O_MRG = O_DK;
constexpr size_t O_DD = O_WIN;
static_assert(O_DV + SZ_ACT <= O_R, "diff overlay");

struct Params {
  const float *x, *meta, *n1, *w1g, *w1u, *w1d, *nmix, *win, *wa2f, *baf, *wa2b, *bab, *gnorm,
      *lq1, *lk1, *lq2, *lk2, *dnorm, *wbg, *wbd, *wout, *n2, *w2g, *w2u, *w2d, *nfin;
  float* out;
  unsigned char* ws;
};

extern __shared__ __attribute__((aligned(16))) unsigned char shm_raw[];
#define shm ((bf16_t*)shm_raw)

DEV float bf2f(bf16_t v) { return __uint_as_float(((unsigned)v) << 16); }
typedef __bf16 bf16x2_t __attribute__((ext_vector_type(2)));
typedef float f32x2_t __attribute__((ext_vector_type(2)));
DEV unsigned pk2(float lo, float hi) { f32x2_t v = {lo, hi}; bf16x2_t b = __builtin_convertvector(v, bf16x2_t); return __builtin_bit_cast(unsigned, b); }
DEV bf16_t f2bf(float f) { return (bf16_t)(pk2(f, 0.f) & 0xffffu); }
DEV float sigm(float v) { return 1.f / (1.f + __expf(-v)); }

constexpr int BM = 256, BK = 64, HALF = 128, HT = HALF * BK, NXCD = 8, WGM = 8;
DEV int lds_byte(int r, int c) { int st = (r >> 4) * 2 + (c >> 5), rr = r & 15, cc = c & 31, ob = rr * 64 + cc * 2; return st * 1024 + (ob ^ (((ob >> 9) & 1) << 5)); }
DEV void stage_rc(int b, int& R, int& C) { int st = b / 1024, sb = b % 1024, swz = sb ^ (((sb >> 9) & 1) << 5); R = (st >> 1) * 16 + swz / 64; C = (st & 1) * 32 + (swz % 64) / 2; }

#define LAS __attribute__((address_space(3)))
constexpr int HTB = HALF * BK * 2;
#define PG8_SA(b, h) (((b) * 2 + (h)) * HTB)
#define PG8_SB(b, h) ((4 + (b) * 2 + (h)) * HTB)
#define STAGE(bufoff, gbase, voff) do { _Pragma("unroll") for (int _i = 0; _i < 2; ++_i) \
    __builtin_amdgcn_global_load_lds((const unsigned*)((const char*)(gbase) + (voff)[_i]), (LAS unsigned*)(lds + (bufoff) + ldsw + _i * 8192), 16, 0, 0); } while (0)
#define LDA(dst, b, h) do { _Pragma("unroll") for (int m = 0; m < 4; ++m) _Pragma("unroll") for (int k = 0; k < 2; ++k) dst[m][k] = *(const LAS bf16x8*)(lds + PG8_SA(b, h) + aoff + m * 2048 + k * 1024); } while (0)
#define LDB(dst, b, h) do { _Pragma("unroll") for (int n = 0; n < 2; ++n) _Pragma("unroll") for (int k = 0; k < 2; ++k) dst[n][k] = *(const LAS bf16x8*)(lds + PG8_SB(b, h) + boff + n * 2048 + k * 1024); } while (0)
#define MMA(ai, bj, At_, Bt_) do { __builtin_amdgcn_s_setprio(1); \
    _Pragma("unroll") for (int m = 0; m < 4; ++m) _Pragma("unroll") for (int n = 0; n < 2; ++n) _Pragma("unroll") for (int k = 0; k < 2; ++k) \
      acc[ai][bj][m][n] = __builtin_amdgcn_mfma_f32_16x16x32_bf16(Bt_[n][k], At_[m][k], acc[ai][bj][m][n], 0, 0, 0); \
    __builtin_amdgcn_s_setprio(0); } while (0)
#define WAIT_V(n) asm volatile("s_waitcnt vmcnt(" #n ")" ::: "memory")
#define WAIT_L(n) asm volatile("s_waitcnt lgkmcnt(" #n ")" ::: "memory")
#define BAR __builtin_amdgcn_s_barrier()
#define SCHED __builtin_amdgcn_sched_barrier(0)

DEV void gemm_mainloop(const char* __restrict__ cA, const char* __restrict__ cB0, const char* __restrict__ cB1, const int K, f32x4 (&acc)[2][2][4][2]) {
  LAS unsigned char* lds = (LAS unsigned char*)shm_raw;
  int tid = threadIdx.x; asm volatile("" : "+v"(tid));
  const int wid = __builtin_amdgcn_readfirstlane(tid >> 6), lane = tid & 63, wr = wid >> 2, wc = wid & 3, fr = lane & 15, fq = lane >> 4;
  unsigned voff[2];
#pragma unroll
  for (int i = 0; i < 2; ++i) { int R, C; stage_rc(tid * 16 + i * 8192, R, C); voff[i] = (unsigned)(R * K + C) * 2u; }
  const size_t kstep = (size_t)(BK * 2), hstep = (size_t)HALF * K * 2;
  const unsigned ldsw = (unsigned)wid * 1024u;
  const int aoff = lds_byte(wr * 64 + fr, fq * 8), boff = lds_byte(wc * 32 + fr, fq * 8);
  bf16x8 At[4][2], B0[2][2], B1[2][2];
  const int nt = K / BK;
  STAGE(PG8_SB(0, 0), cB0, voff); STAGE(PG8_SA(0, 0), cA, voff); STAGE(PG8_SB(0, 1), cB1, voff); STAGE(PG8_SA(0, 1), cA + hstep, voff);
  if (wr == 1) BAR;
  WAIT_V(4); BAR;
  STAGE(PG8_SB(1, 0), cB0 + kstep, voff); STAGE(PG8_SA(1, 0), cA + kstep, voff); STAGE(PG8_SB(1, 1), cB1 + kstep, voff);
  WAIT_V(6); BAR;
  for (int t = 0; t < nt - 2; t += 2) {
    const char* a1 = cA + (size_t)(t + 1) * kstep;
    const char* a2 = a1 + kstep; const char* a3 = a2 + kstep;
    const char* b02 = cB0 + (size_t)(t + 2) * kstep; const char* b12 = cB1 + (size_t)(t + 2) * kstep;
    LDB(B0, 0, 0); SCHED; LDA(At, 0, 0); STAGE(PG8_SA(1, 1), a1 + hstep, voff);
    WAIT_L(8); BAR; WAIT_L(0); MMA(0, 0, At, B0); BAR; SCHED;
    LDB(B1, 0, 1); STAGE(PG8_SB(0, 0), b02, voff);
    BAR; WAIT_L(0); MMA(0, 1, At, B1); BAR;
    LDA(At, 0, 1); STAGE(PG8_SA(0, 0), a2, voff);
    BAR; WAIT_L(0); MMA(1, 0, At, B0); BAR; SCHED;
    STAGE(PG8_SB(0, 1), b12, voff);
    WAIT_V(6); BAR; MMA(1, 1, At, B1); BAR;
    LDB(B0, 1, 0); SCHED; LDA(At, 1, 0); STAGE(PG8_SA(0, 1), a2 + hstep, voff);
    WAIT_L(8); BAR; WAIT_L(0); MMA(0, 0, At, B0); BAR; SCHED;
    LDB(B1, 1, 1); STAGE(PG8_SB(1, 0), b02 + kstep, voff);
    BAR; WAIT_L(0); MMA(0, 1, At, B1); BAR;
    LDA(At, 1, 1); STAGE(PG8_SA(1, 0), a3, voff);
    BAR; WAIT_L(0); MMA(1, 0, At, B0); BAR; SCHED;
    STAGE(PG8_SB(1, 1), b12 + kstep, voff);
    WAIT_V(6); BAR; MMA(1, 1, At, B1); BAR;
  }
  { LDB(B0, 0, 0); LDA(At, 0, 0); STAGE(PG8_SA(1, 1), cA + (size_t)(nt - 1) * kstep + hstep, voff);
    BAR; WAIT_L(0); MMA(0, 0, At, B0); BAR;
    LDB(B1, 0, 1); BAR; WAIT_L(0); MMA(0, 1, At, B1); BAR;
    LDA(At, 0, 1); WAIT_V(4); BAR; WAIT_L(0); MMA(1, 0, At, B0); MMA(1, 1, At, B1); BAR; }
  { LDB(B0, 1, 0); LDA(At, 1, 0); WAIT_V(2); BAR; WAIT_L(0); MMA(0, 0, At, B0); BAR;
    LDB(B1, 1, 1); WAIT_V(0); BAR; WAIT_L(0); MMA(0, 1, At, B1); BAR;
    LDA(At, 1, 1); BAR; WAIT_L(0); MMA(1, 0, At, B0); MMA(1, 1, At, B1); BAR; }
  if (wr == 0) BAR;
}

enum { G_FFN1_GU = 0, G_FFN1_D, G_WIN_A, G_WIN_META, G_WIN_B, G_MERGE, G_OUT, G_FFN2_GU, G_FFN2_D };

DEV void store_bf4(bf16_t* p, f32x4 v) { u32x2 w; w.x = pk2(v[0], v[1]); w.y = pk2(v[2], v[3]); *(u32x2*)p = w; }
DEV f32x4 load_bf4(const bf16_t* p) { u32x2 w = *(const u32x2*)p; f32x4 v; v[0] = __uint_as_float(w.x << 16); v[1] = __uint_as_float(w.x & 0xffff0000u); v[2] = __uint_as_float(w.y << 16); v[3] = __uint_as_float(w.y & 0xffff0000u); return v; }

DEV void main_order(int L, int nN, int& pm, int& pn) {
  const int nwg = 64 * nN;
  int wgid = L; { const int q = nwg / NXCD, r = nwg % NXCD, xcd = wgid % NXCD, off = wgid / NXCD; wgid = (xcd < r ? xcd * (q + 1) : r * (q + 1) + (xcd - r) * q) + off; }
  const int nig = WGM * nN, gid = wgid / nig, fm = gid * WGM;
  pm = fm + ((wgid % nig) % WGM); pn = (wgid % nig) / WGM;
}

DEV void gemm_phase(const Params& P, const int gp) {
  int tid = threadIdx.x; asm volatile("" : "+v"(tid));
  const int wid = __builtin_amdgcn_readfirstlane(tid >> 6), lane = tid & 63, wr = wid >> 2, wc = wid & 3, fr_ = lane & 15, fq_ = lane >> 4;
  unsigned char* ws = P.ws;
  float* stats = (float*)(ws + O_ST);
  int nN, nPre = 0, nMain, nMeta = 0, pnoff = 0;
  switch (gp) {
    case G_FFN1_GU: nN = 43; nMeta = 43; break;
    case G_FFN1_D: nN = 8; break;
    case G_WIN_A: nN = 25; nPre = 8; break;
    case G_WIN_META: nN = 0; nMeta = 65; break;
    case G_WIN_B: nN = 40; pnoff = 25; break;
    case G_MERGE: nN = 8; break;
    case G_OUT: nN = 8; break;
    case G_FFN2_GU: nN = 43; break;
    default: nN = 8; break;
  }
  nMain = 64 * nN;
  const int ntiles = nPre + nMain + nMeta;
  for (int t = blockIdx.x; t < ntiles; t += gridDim.x) {
    int pm, pn, kind = gp;
    bool meta = false;
    if (t < nPre) { pm = 64; pn = t; meta = true; kind = G_FFN1_D; }
    else if (t < nPre + nMain) { main_order(t - nPre, nN, pm, pn); pn += pnoff; }
    else { pm = 64; pn = t - nPre - nMain; meta = true; }
    const int arow0 = meta ? 0 : (pm >> 4) * LP + 64 + (pm & 15) * 256;
    const int nrow0 = pm * 256;
    const bf16_t *A, *B0p, *B1p; int K;
    switch (kind) {
      case G_FFN1_GU: A = (const bf16_t*)(ws + O_ACTB); K = 2048; B0p = (const bf16_t*)(ws + O_WF) + (size_t)DFF * 2048 + (size_t)pn * 128 * 2048; B1p = B0p + (size_t)DFF * 2048; break;
      case G_FFN2_GU: A = (const bf16_t*)(ws + O_ACTB); K = 2048; B0p = (const bf16_t*)(ws + O_WF) + (size_t)DFF * 2048 + (size_t)pn * 128 * 2048; B1p = B0p + (size_t)DFF * 2048; break;
      case G_FFN1_D: case G_FFN2_D: A = (const bf16_t*)(ws + O_HID); K = DFF; B0p = (const bf16_t*)(ws + O_WF) + (size_t)pn * 256 * DFF; B1p = B0p + (size_t)128 * DFF; break;
      case G_WIN_A: case G_WIN_META: case G_WIN_B: A = (const bf16_t*)(ws + O_ACTB); K = 2048; B0p = (const bf16_t*)(ws + O_WIN) + (size_t)pn * 256 * 2048; B1p = B0p + (size_t)128 * 2048; break;
      case G_MERGE: A = (const bf16_t*)(ws + O_GR); K = 2048; B0p = (const bf16_t*)(ws + O_WS) + (size_t)pn * 256 * 2048; B1p = B0p + (size_t)128 * 2048; break;
      default  : A = (const bf16_t*)(ws + O_MRG); K = 2048; B0p = (const bf16_t*)(ws + O_WS) + 2 * (size_t)2048 * 2048 + (size_t)pn * 256 * 2048; B1p = B0p + (size_t)128 * 2048; break;
    }
    f32x4 acc[2][2][4][2];
#pragma unroll
    for (int a = 0; a < 2; ++a)
#pragma unroll
      for (int b = 0; b < 2; ++b)
#pragma unroll
        for (int m = 0; m < 4; ++m)
#pragma unroll
          for (int n = 0; n < 2; ++n) acc[a][b][m][n] = (f32x4){0.f, 0.f, 0.f, 0.f};
    const int nk = (kind == G_MERGE) ? 2 : 1;
    for (int kl = 0; kl < nk; ++kl) {
      if (kl == 1) {
        int fr = fr_, fq = fq_; asm volatile("" : "+v"(fr), "+v"(fq));
        const bf16_t* gA = (const bf16_t*)P.out; const bf16_t* gB = gA + (size_t)TR * 2048;
#pragma unroll
        for (int ai = 0; ai < 2; ++ai)
#pragma unroll
          for (int m = 0; m < 4; ++m) {
            const size_t nrow = (size_t)(nrow0 + ai * 128 + wr * 64 + m * 16 + fr) * 2048;
#pragma unroll
            for (int bj = 0; bj < 2; ++bj)
#pragma unroll
              for (int n = 0; n < 2; ++n) {
                const int col = pn * 256 + bj * 128 + wc * 32 + n * 16 + fq * 4;
                f32x4 a4 = load_bf4(gA + nrow + col), b4 = load_bf4(gB + nrow + col);
#pragma unroll
                for (int j = 0; j < 4; ++j) { float ea = __expf(-fminf(fmaxf(a4[j], -40.f), 40.f)), eb = __expf(-fminf(fmaxf(b4[j], -40.f), 40.f)); acc[ai][bj][m][n][j] *= (1.f + eb) / (1.f + ea); }
              }
            asm volatile("" ::: "memory"); SCHED;
          }
        A = (const bf16_t*)(ws + O_DD); B0p += (size_t)2048 * 2048; B1p += (size_t)2048 * 2048;
        asm volatile("s_waitcnt vmcnt(0)" ::: "memory");
      }
      gemm_mainloop((const char*)(A + (size_t)arow0 * K), (const char*)B0p, (const char*)B1p, K, acc);
    }
    int fr = fr_, fq = fq_; asm volatile("" : "+v"(fr), "+v"(fq));
    if (kind == G_FFN1_GU || kind == G_FFN2_GU || kind == G_WIN_A || kind == G_WIN_META || kind == G_WIN_B) {
      float* rsl = (float*)shm_raw;
      if (tid < 256) {
        const size_t row = (size_t)arow0 + tid; float sum;
        if (kind == G_FFN1_GU) sum = stats[row];
        else { const f32x4* pp = (const f32x4*)((const float*)(ws + (kind == G_FFN2_GU ? O_ST2 : O_ST1)) + row * 32); f32x4 a = pp[0];
#pragma unroll
          for (int i = 1; i < 8; ++i) a += pp[i];
          sum = (a[0] + a[1]) + (a[2] + a[3]); }
        rsl[tid] = rsqrtf(sum * (1.f / 2048.f) + EPS);
      }
      __syncthreads();
    }
    if (kind == G_FFN1_GU || kind == G_FFN2_GU) {
      const float* rsl = (const float*)shm_raw;
      bf16_t* hid = (bf16_t*)(ws + O_HID);
#pragma unroll
      for (int ai = 0; ai < 2; ++ai)
#pragma unroll
        for (int m = 0; m < 4; ++m) {
          const int r = ai * 128 + wr * 64 + m * 16 + fr;
          if (meta && (r < 48 || r >= 64)) continue;
          const int prow = arow0 + r;
          const float rs = rsl[r];
#pragma unroll
          for (int n = 0; n < 2; ++n) {
            f32x4 g = acc[ai][0][m][n] * rs, u = acc[ai][1][m][n] * rs, h;
#pragma unroll
            for (int j = 0; j < 4; ++j) h[j] = g[j] * sigm(g[j]) * u[j];
            store_bf4(hid + (size_t)prow * DFF + pn * 128 + wc * 32 + n * 16 + fq * 4, h);
          }
          asm volatile("" ::: "memory"); SCHED;
        }
    } else if (kind == G_FFN1_D || kind == G_OUT || kind == G_FFN2_D) {
      const float* resA = (kind == G_FFN2_D) ? P.out : P.x;
      const bf16_t* resF = (kind == G_OUT) ? (const bf16_t*)(ws + O_F) : nullptr;
      float* outF32 = (kind == G_FFN1_D) ? nullptr : P.out;
      bf16_t* outB = (kind == G_FFN2_D) ? nullptr : (bf16_t*)(ws + O_ACTB);
      bf16_t* outF = (kind == G_FFN1_D && !meta) ? (bf16_t*)(ws + O_F) : nullptr;
      const float scale = (kind == G_OUT) ? 1.f : 0.5f;
      float* st = (kind == G_FFN1_D) ? (float*)(ws + O_ST1) : (kind == G_OUT ? (float*)(ws + O_ST2) : nullptr);
#pragma unroll
      for (int ai = 0; ai < 2; ++ai)
#pragma unroll
        for (int m = 0; m < 4; ++m) {
          const int r = ai * 128 + wr * 64 + m * 16 + fr;
          if (meta && (r < 48 || r >= 64)) continue;
          const size_t prow = arow0 + r, nrow = nrow0 + r;
          const float* rp = meta ? (P.meta + (size_t)(r - 48) * 2048) : (resA + nrow * 2048);
          float ss = 0.f;
#pragma unroll
          for (int bj = 0; bj < 2; ++bj)
#pragma unroll
            for (int n = 0; n < 2; ++n) {
              const int col = pn * 256 + bj * 128 + wc * 32 + n * 16 + fq * 4;
              f32x4 res = *(const f32x4*)(rp + col);
              if (resF) res += load_bf4(resF + prow * 2048 + col);
              const f32x4 d = acc[ai][bj][m][n] * scale, v = res + d;
              if (outF32) *(f32x4*)(outF32 + nrow * 2048 + col) = v;
              if (outB) store_bf4(outB + prow * 2048 + col, v);
              if (outF) store_bf4(outF + prow * 2048 + col, d);
              ss += v[0] * v[0] + v[1] * v[1] + v[2] * v[2] + v[3] * v[3];
            }
          ss += __shfl_xor(ss, 16); ss += __shfl_xor(ss, 32);
          if (fq == 0 && st) st[prow * 32 + pn * 4 + wc] = ss;
          asm volatile("" ::: "memory"); SCHED;
        }
    } else if (kind == G_MERGE) {
      const bf16_t* gB = (const bf16_t*)P.out + (size_t)TR * 2048;
      bf16_t* mo = (bf16_t*)(ws + O_MRG);
#pragma unroll
      for (int ai = 0; ai < 2; ++ai)
#pragma unroll
        for (int m = 0; m < 4; ++m) {
          const int r = ai * 128 + wr * 64 + m * 16 + fr;
          const size_t prow = arow0 + r, nrow = nrow0 + r;
#pragma unroll
          for (int bj = 0; bj < 2; ++bj)
#pragma unroll
            for (int n = 0; n < 2; ++n) {
              const int col = pn * 256 + bj * 128 + wc * 32 + n * 16 + fq * 4;
              f32x4 b4 = load_bf4(gB + nrow * 2048 + col), v;
#pragma unroll
              for (int j = 0; j < 4; ++j) v[j] = acc[ai][bj][m][n][j] / (1.f + __expf(-fminf(fmaxf(b4[j], -40.f), 40.f)));
              store_bf4(mo + prow * 2048 + col, v);
            }
          asm volatile("" ::: "memory"); SCHED;
        }
    } else {
      const float* rsl = (const float*)shm_raw;
      bf16_t* dst; int ld, c0; bool natural = false, isLow = false;
      if (pn < 4) { dst = (bf16_t*)(ws + O_GQ); ld = 1024; c0 = pn * 256; }
      else if (pn < 8) { dst = (bf16_t*)(ws + O_GK); ld = 1024; c0 = (pn - 4) * 256; }
      else if (pn < 16) { dst = (bf16_t*)(ws + O_GV); ld = 2048; c0 = (pn - 8) * 256; }
      else if (pn < 24) { dst = (bf16_t*)(ws + O_GR); ld = 2048; c0 = (pn - 16) * 256; }
      else if (pn == 24) { dst = nullptr; ld = 32; c0 = 0; isLow = true; }
      else if (pn < 33) { dst = (bf16_t*)(ws + O_DQ); ld = 2048; c0 = (pn - 25) * 256; }
      else if (pn < 41) { dst = (bf16_t*)(ws + O_DK); ld = 2048; c0 = (pn - 33) * 256; }
      else if (pn < 49) { dst = (bf16_t*)(ws + O_DV); ld = 2048; c0 = (pn - 41) * 256; }
      else if (pn < 57) { dst = (bf16_t*)P.out; ld = 2048; c0 = (pn - 49) * 256; natural = true; }
      else { dst = (bf16_t*)P.out + (size_t)TR * 2048; ld = 2048; c0 = (pn - 57) * 256; natural = true; }
      float* low = (float*)(ws + O_LOW);
      bool single = false;
      if (meta && pn >= 25) { single = true; if (pn >= 33 && pn < 41) dst = (bf16_t*)(ws + O_DKM); else if (pn >= 41 && pn < 49) dst = (bf16_t*)(ws + O_DVM); else natural = true; }
      if (!(meta && natural)) {
#pragma unroll
        for (int ai = 0; ai < 2; ++ai)
#pragma unroll
          for (int m = 0; m < 4; ++m) {
            const int r = ai * 128 + wr * 64 + m * 16 + fr;
            if (meta && r >= 64) continue;
            const size_t prow = arow0 + r, nrow = nrow0 + r;
            const float rs = rsl[r];
            const bool zero = meta && r < 48;
#pragma unroll
            for (int bj = 0; bj < 2; ++bj)
#pragma unroll
              for (int n = 0; n < 2; ++n) {
                const int cc = bj * 128 + wc * 32 + n * 16 + fq * 4;
                f32x4 v = acc[ai][bj][m][n] * rs;
                if (zero) v = (f32x4){0.f, 0.f, 0.f, 0.f};
                if (isLow) {
                  if (cc < 32) { if (meta) { for (int b4 = 0; b4 < 4; ++b4) *(f32x4*)(low + (size_t)(b4 * LP + r) * 32 + cc) = v; } else *(f32x4*)(low + prow * 32 + cc) = v; }
                } else if (single) {
                  store_bf4(dst + (size_t)r * ld + c0 + cc, v);
                } else if (meta) {
                  for (int b4 = 0; b4 < 4; ++b4) store_bf4(dst + (size_t)(b4 * LP + r) * ld + c0 + cc, v);
                } else {
                  store_bf4(dst + (natural ? nrow : prow) * ld + c0 + cc, v);
                }
              }
            asm volatile("" ::: "memory"); SCHED;
          }
      }
    }
    asm volatile("s_waitcnt vmcnt(0)" ::: "memory");
    __syncthreads();
  }
}

DEV void transpose_tile(const float* __restrict__ src, int K, int N, bf16_t* __restrict__ dst, const float* __restrict__ gain, bool winmap, int tk, int tn) {
  const int tid = threadIdx.x;
  bf16_t* T = shm;
  const int k0 = tk * 128, n0 = tn * 128;
  __syncthreads();
#pragma unroll
  for (int i = 0; i < 8; ++i) {
    const int kr = i * 16 + (tid >> 5), nc = (tid & 31) * 4;
    f32x4 v = (f32x4){0.f, 0.f, 0.f, 0.f};
    if (n0 + nc < N) v = *(const f32x4*)(src + (size_t)(k0 + kr) * N + n0 + nc);
    if (gain) v = v * gain[k0 + kr];
    unsigned* tp = (unsigned*)(T + kr * 130 + nc);
    tp[0] = pk2(v[0], v[1]); tp[1] = pk2(v[2], v[3]);
  }
  __syncthreads();
  const int nr = tid >> 2, n = n0 + nr;
  if (n < N) {
    const int drow = winmap ? (n < 6176 ? n : n + 224) : n;
#pragma unroll
    for (int q = 0; q < 4; ++q) {
      const int kk = (tid & 3) * 8 + q * 32;
      unsigned short e[8];
#pragma unroll
      for (int i = 0; i < 8; ++i) e[i] = T[(kk + i) * 130 + nr];
      u32x4 w; w.x = e[0] | ((unsigned)e[1] << 16); w.y = e[2] | ((unsigned)e[3] << 16); w.z = e[4] | ((unsigned)e[5] << 16); w.w = e[6] | ((unsigned)e[7] << 16);
      *(u32x4*)(dst + (size_t)drow * K + k0 + kk) = w;
    }
  }
}

DEV void transpose_job(const float* src, int K, int N, bf16_t* dst, const float* gain, bool winmap, int& tbase, int& t) {
  const int ntn = (N + 127) / 128, nt = (K / 128) * ntn;
  while (t < tbase + nt) { const int l = t - tbase; transpose_tile(src, K, N, dst, gain, winmap, l / ntn, l % ntn); t += gridDim.x; }
  tbase += nt;
}

DEV void phase_prologue(const Params& P) {
  unsigned char* ws = P.ws;
  const int tid = threadIdx.x, gtid = blockIdx.x * NTHR + tid, gsz = gridDim.x * NTHR;
  { u32x4* z = (u32x4*)((bf16_t*)(ws + O_WIN) + (size_t)6176 * 2048); const int nz = 224 * 2048 / 8;
    for (int i = gtid; i < nz; i += gsz) z[i] = (u32x4){0u, 0u, 0u, 0u}; }
  { const int gw = (blockIdx.x * NTHR + tid) >> 6, nw = gsz >> 6, lane = tid & 63;
    bf16_t* xb = (bf16_t*)(ws + O_ACTB); float* st0 = (float*)(ws + O_ST);
    for (int r = gw; r < TR + 16; r += nw) {
      const float* src; size_t prow;
      if (r < TR) { src = P.x + (size_t)r * 2048; prow = (size_t)(r >> 12) * LP + 64 + (r & 4095); } else { src = P.meta + (size_t)(r - TR) * 2048; prow = 48 + (r - TR); }
      float ss = 0.f;
#pragma unroll
      for (int i = 0; i < 8; ++i) { const int c = i * 256 + lane * 4; f32x4 v = *(const f32x4*)(src + c); ss += v[0] * v[0] + v[1] * v[1] + v[2] * v[2] + v[3] * v[3]; store_bf4(xb + prow * 2048 + c, v); }
#pragma unroll
      for (int o = 32; o >= 1; o >>= 1) ss += __shfl_xor(ss, o);
      if (lane == 0) st0[prow] = ss;
    } }
  int tbase = 0, t = blockIdx.x;
  bf16_t* wf = (bf16_t*)(ws + O_WF); bf16_t* wsq = (bf16_t*)(ws + O_WS);
  transpose_job(P.w1g, 2048, DFF, wf + (size_t)DFF * 2048, P.n1, false, tbase, t);
  transpose_job(P.w1u, 2048, DFF, wf + (size_t)2 * DFF * 2048, P.n1, false, tbase, t);
  transpose_job(P.w1d, DFF, 2048, wf, nullptr, false, tbase, t);
  transpose_job(P.win, 2048, INW, (bf16_t*)(ws + O_WIN), P.nmix, true, tbase, t);
  transpose_job(P.wbg, 2048, 2048, wsq, nullptr, false, tbase, t);
  transpose_job(P.wbd, 2048, 2048, wsq + (size_t)2048 * 2048, nullptr, false, tbase, t);
  transpose_job(P.wout, 2048, 2048, wsq + (size_t)2 * 2048 * 2048, nullptr, false, tbase, t);
}

DEV f32x4 mfma16(bf16x8 a, bf16x8 b, f32x4 c) { return __builtin_amdgcn_mfma_f32_16x16x32_bf16(a, b, c, 0, 0, 0); }
#define LD8(p) (*reinterpret_cast<const bf16x8*>(p))

DEV void gla_prep_unit(const Params& P, int u, bool dummy = false) {
  unsigned char* ws = P.ws;
  const bool st_ok = !dummy || (P.ws == nullptr);
  int tid = threadIdx.x; asm volatile("" : "+v"(tid));
  const int w = tid >> 6, lane = tid & 63, fr = lane & 15, fq = lane >> 4;
  const int c = u % 65, bh = u / 65, b = bh >> 2, h = bh & 3;
  bf16_t* QD0 = shm; bf16_t* KI0 = QD0 + 64 * 264; bf16_t* QD1 = KI0 + 64 * 264; bf16_t* KI1 = QD1 + 64 * 264;
  float* LOWs = (float*)(KI1 + 64 * 264);
  bf16_t* gq = (bf16_t*)(ws + O_GQ); bf16_t* gk = (bf16_t*)(ws + O_GK);
  const size_t prow0 = (size_t)b * LP + c * 64;
  const int dir = tid >> 8, k = tid & 255, col = h * 256 + k;
  unsigned qk[64];
#pragma unroll
  for (int tt = 0; tt < 64; ++tt) { const int t = dir ? 63 - tt : tt; qk[tt] = (unsigned)gq[(prow0 + t) * 1024 + col] | ((unsigned)gk[(prow0 + t) * 1024 + col] << 16); }
  __syncthreads();
  { const int idx = tid * 4, row = idx >> 5, cl = idx & 31;
    *(f32x4*)(LOWs + idx) = *(const f32x4*)((const float*)(ws + O_LOW) + (prow0 + row) * 32 + cl); }
  __syncthreads();
  {
    const float* wa2 = dir ? P.wa2b : P.wa2f;
    float wv[16];
#pragma unroll
    for (int r = 0; r < 16; ++r) wv[r] = wa2[r * 1024 + col];
    const float bias = (dir ? P.bab : P.baf)[col];
    bf16_t* QD = dir ? QD1 : QD0; bf16_t* KI = dir ? KI1 : KI0;
    float bc = 0.f;
#pragma unroll
    for (int tt = 0; tt < 64; ++tt) {
      const int t = dir ? 63 - tt : tt;
      const f32x4* lr = (const f32x4*)(LOWs + t * 32 + dir * 16);
      const f32x4 l0 = lr[0], l1 = lr[1], l2 = lr[2], l3 = lr[3];
      float z = bias;
#pragma unroll
      for (int r = 0; r < 4; ++r) { z = fmaf(l0[r], wv[r], z); z = fmaf(l1[r], wv[4 + r], z); z = fmaf(l2[r], wv[8 + r], z); z = fmaf(l3[r], wv[12 + r], z); }
      const float ls = fminf(z, 0.f) - __logf(1.f + __expf(-fabsf(z)));
      const bool valid = !(c == 0 && t < 48);
      bc += valid ? ls * 0.0625f : 0.f;
      const float e = __expf(bc), ei = __expf(-bc);
      QD[t * 264 + k] = f2bf(__uint_as_float(qk[tt] << 16) * e * 0.0625f);
      KI[t * 264 + k] = f2bf(__uint_as_float(qk[tt] & 0xffff0000u) * ei);
    }
    if (st_ok) ((float*)(ws + O_DL))[((size_t)(bh * 2 + dir) * 65 + c) * 256 + k] = __expf(bc);
  }
  __syncthreads();
  if (c >= 1) {
    const int d = w >> 2, ti = w & 3;
    const bf16_t* QD = d ? QD1 : QD0; const bf16_t* KI = d ? KI1 : KI0;
    bf16_t* Pg = (bf16_t*)(ws + O_P) + (size_t)u * 4096;
#pragma unroll
    for (int tj = 0; tj < 4; ++tj) {
      f32x4 a4 = (f32x4){0.f, 0.f, 0.f, 0.f};
#pragma unroll
      for (int kk = 0; kk < 8; ++kk) a4 = mfma16(LD8(QD + (ti * 16 + fr) * 264 + kk * 32 + fq * 8), LD8(KI + (tj * 16 + fr) * 264 + kk * 32 + fq * 8), a4);
#pragma unroll
      for (int r = 0; r < 4; ++r) { const int i = ti * 16 + fq * 4 + r, j = tj * 16 + fr; const bool keep = d ? (j > i) : (j <= i); if (keep && st_ok) Pg[i * 64 + j] = f2bf(a4[r]); }
    }
  }
  bf16_t* qdb = (bf16_t*)(ws + O_QDB); bf16_t* kib = (bf16_t*)(ws + O_KIB);
#pragma unroll
  for (int i = 0; i < 4; ++i) {
    const int p = tid + 512 * i, tok = p >> 5, kc = (p & 31) * 8;
    const size_t g = (prow0 + tok) * 1024 + h * 256 + kc;
    if (st_ok) { *(u32x4*)(gq + g) = *(const u32x4*)(QD0 + tok * 264 + kc);
    *(u32x4*)(qdb + g) = *(const u32x4*)(QD1 + tok * 264 + kc); }
  }
  {
    const bf16_t* KI = dir ? KI1 : KI0;
    bf16_t* dst = (dir ? kib : gk) + (prow0 + (k >> 2)) * 1024 + h * 256 + (k & 3) * 64;
#pragma unroll
    for (int q = 0; q < 8; ++q) {
      unsigned e[8];
#pragma unroll
      for (int i = 0; i < 8; ++i) e[i] = KI[(q * 8 + i) * 264 + k];
      u32x4 wv4; wv4.x = e[0] | (e[1] << 16); wv4.y = e[2] | (e[3] << 16); wv4.z = e[4] | (e[5] << 16); wv4.w = e[6] | (e[7] << 16);
      if (st_ok) *(u32x4*)(dst + q * 8) = wv4;
    }
  }
  __syncthreads();
  bf16_t* gv = (bf16_t*)(ws + O_GV);
  bf16_t* VN = shm;
#pragma unroll
  for (int q = 0; q < 8; ++q) {
    const int p = tid + 512 * q, tok = p >> 6, vc = (p & 63) * 8;
    *(u32x4*)(VN + tok * 520 + vc) = *(const u32x4*)(gv + (prow0 + tok) * 2048 + h * 512 + vc);
  }
  __syncthreads();
  {
    const int v = tid;
    bf16_t* dst = gv + (prow0 + (v >> 3)) * 2048 + h * 512 + (v & 7) * 64;
#pragma unroll
    for (int q = 0; q < 8; ++q) {
      unsigned e[8];
#pragma unroll
      for (int i = 0; i < 8; ++i) e[i] = VN[(q * 8 + i) * 520 + v];
      u32x4 wv4; wv4.x = e[0] | (e[1] << 16); wv4.y = e[2] | (e[3] << 16); wv4.z = e[4] | (e[5] << 16); wv4.w = e[6] | (e[7] << 16);
      if (st_ok) *(u32x4*)(dst + q * 8) = wv4;
    }
  }
}

DEV void gla_scan_unit(const Params& P, int u) {
  unsigned char* ws = P.ws;
  int tid = threadIdx.x; asm volatile("" : "+v"(tid));
  const int w = tid >> 6, lane = tid & 63, fr = lane & 15, fq = lane >> 4;
  const int b = u >> 6, h = (u >> 4) & 3, dir = (u >> 3) & 1, sl = u & 7;
  bf16_t* QDs = shm;
  bf16_t* KIT = QDs + 64 * 264;
  bf16_t* VT = KIT + 256 * 72;
  bf16_t* SBs = VT + 64 * 72;
  const bf16_t* qsrc = (const bf16_t*)(ws + (dir ? O_QDB : O_GQ));
  const bf16_t* ksrc = (const bf16_t*)(ws + (dir ? O_KIB : O_GK));
  const bf16_t* vsrc = (const bf16_t*)(ws + O_GV);
  const float* dlp = (const float*)(ws + O_DL) + (size_t)((b * 4 + h) * 2 + dir) * 65 * 256;
  bf16_t* osrc = (bf16_t*)P.out + (size_t)dir * TR * 2048;
  f32x4 S[2][4];
#pragma unroll
  for (int a = 0; a < 4; ++a) { S[0][a] = (f32x4){0.f, 0.f, 0.f, 0.f}; S[1][a] = (f32x4){0.f, 0.f, 0.f, 0.f}; }
  u32x4 rq[4], rk[4], rv; f32x4 rdl0, rdl1;
  const int nsteps = dir ? 64 : 65;
#define SCAN_LOAD(cc) do { const size_t pr0 = (size_t)b * LP + (cc) * 64; \
    _Pragma("unroll") for (int i = 0; i < 4; ++i) { const int p = tid + 512 * i; \
      { const int tok = p >> 5, kc = (p & 31) * 8; rq[i] = *(const u32x4*)(qsrc + (pr0 + tok) * 1024 + h * 256 + kc); } \
      { const int kr = p >> 3, tc = (p & 7) * 8; rk[i] = *(const u32x4*)(ksrc + (pr0 + (kr >> 2)) * 1024 + h * 256 + (kr & 3) * 64 + tc); } } \
    { const int vv = sl * 64 + (tid >> 3), tc = (tid & 7) * 8; rv = *(const u32x4*)(vsrc + (pr0 + (vv >> 3)) * 2048 + h * 512 + (vv & 7) * 64 + tc); } \
    rdl0 = *(const f32x4*)(dlp + (cc) * 256 + (2 * w) * 16 + fq * 4); rdl1 = *(const f32x4*)(dlp + (cc) * 256 + (2 * w + 1) * 16 + fq * 4); } while (0)
  SCAN_LOAD(dir ? 64 : 0);
  for (int s = 0; s < nsteps; ++s) {
    const int c = dir ? 64 - s : s;
    const bool do_o = dir ? true : (c >= 1), do_upd = dir ? (c >= 2) : (c <= 63);
    __syncthreads();
#pragma unroll
    for (int i = 0; i < 4; ++i) {
      const int p = tid + 512 * i;
      *(u32x4*)(QDs + (p >> 5) * 264 + (p & 31) * 8) = rq[i];
      *(u32x4*)(KIT + (p >> 3) * 72 + (p & 7) * 8) = rk[i];
    }
    *(u32x4*)(VT + (tid >> 3) * 72 + (tid & 7) * 8) = rv;
#pragma unroll
    for (int vt = 0; vt < 4; ++vt)
#pragma unroll
      for (int kt = 0; kt < 2; ++kt) {
        u32x2 pw; pw.x = pk2(S[kt][vt][0], S[kt][vt][1]); pw.y = pk2(S[kt][vt][2], S[kt][vt][3]);
        *(u32x2*)(SBs + (vt * 16 + fr) * 264 + (2 * w + kt) * 16 + fq * 4) = pw;
      }
    const f32x4 dl0 = rdl0, dl1 = rdl1;
    __syncthreads();
    if (s + 1 < nsteps) SCAN_LOAD(dir ? 64 - (s + 1) : s + 1);
    if (do_o) {
      const int ti = w >> 1;
#pragma unroll
      for (int jj = 0; jj < 2; ++jj) {
        const int tj = (w & 1) * 2 + jj;
        f32x4 a4 = (f32x4){0.f, 0.f, 0.f, 0.f};
#pragma unroll
        for (int kk = 0; kk < 8; ++kk) a4 = mfma16(LD8(SBs + (tj * 16 + fr) * 264 + kk * 32 + fq * 8), LD8(QDs + (ti * 16 + fr) * 264 + kk * 32 + fq * 8), a4);
        const size_t nrow = (size_t)b * SEQ + (c - 1) * 64 + ti * 16 + fr;
        store_bf4(osrc + nrow * 2048 + h * 512 + sl * 64 + tj * 16 + fq * 4, a4);
      }
    }
    if (do_upd) {
#pragma unroll
      for (int kt = 0; kt < 2; ++kt)
#pragma unroll
        for (int vt = 0; vt < 4; ++vt) {
#pragma unroll
          for (int kk = 0; kk < 2; ++kk) S[kt][vt] = mfma16(LD8(KIT + ((2 * w + kt) * 16 + fr) * 72 + kk * 32 + fq * 8), LD8(VT + (vt * 16 + fr) * 72 + kk * 32 + fq * 8), S[kt][vt]);
          S[kt][vt] = S[kt][vt] * (kt ? dl1 : dl0);
        }
    }
  }
#undef SCAN_LOAD
}

DEV void gla_finish_unit(const Params& P, int u, bool dummy = false) {
  unsigned char* ws = P.ws;
  const bool st_ok = !dummy || (P.ws == nullptr);
  int tid = threadIdx.x; asm volatile("" : "+v"(tid));
  const int w = tid >> 6, lane = tid & 63, fr = lane & 15, fq = lane >> 4;
  const int c = (u & 63) + 1, bh = u >> 6, b = bh >> 2, h = bh & 3;
  bf16_t* VTf = shm;
  bf16_t* Pl = VTf + 512 * 72;
  float* red = (float*)(Pl + 64 * 72);
  const size_t prow0 = (size_t)b * LP + c * 64, nrow0 = (size_t)b * SEQ + (c - 1) * 64;
  const bf16_t* gv = (const bf16_t*)(ws + O_GV);
  __syncthreads();
  { const int i = tid >> 3, j0 = (tid & 7) * 8;
    *(u32x4*)(Pl + i * 72 + j0) = *(const u32x4*)((const bf16_t*)(ws + O_P) + (size_t)(bh * 65 + c) * 4096 + i * 64 + j0); }
#pragma unroll
  for (int q = 0; q < 8; ++q) {
    const int p = tid + 512 * q, v = p >> 3, tc = (p & 7) * 8;
    *(u32x4*)(VTf + v * 72 + tc) = *(const u32x4*)(gv + (prow0 + (v >> 3)) * 2048 + h * 512 + (v & 7) * 64 + tc);
  }
  __syncthreads();
  f32x4 acc[4][4];
  const bf16_t* of = (const bf16_t*)P.out; const bf16_t* ob = of + (size_t)TR * 2048;
  float ss[4] = {0.f, 0.f, 0.f, 0.f};
#pragma unroll
  for (int vt = 0; vt < 4; ++vt)
#pragma unroll
    for (int it = 0; it < 4; ++it) {
      f32x4 a4 = (f32x4){0.f, 0.f, 0.f, 0.f};
#pragma unroll
      for (int kk = 0; kk < 2; ++kk) a4 = mfma16(LD8(VTf + (w * 64 + vt * 16 + fr) * 72 + kk * 32 + fq * 8), LD8(Pl + (it * 16 + fr) * 72 + kk * 32 + fq * 8), a4);
      const size_t g = (nrow0 + it * 16 + fr) * 2048 + h * 512 + w * 64 + vt * 16 + fq * 4;
      a4 = a4 + load_bf4(of + g) + load_bf4(ob + g);
      acc[vt][it] = a4;
      ss[it] += a4[0] * a4[0] + a4[1] * a4[1] + a4[2] * a4[2] + a4[3] * a4[3];
    }
#pragma unroll
  for (int it = 0; it < 4; ++it) { float s2 = ss[it]; s2 += __shfl_xor(s2, 16); s2 += __shfl_xor(s2, 32); if (fq == 0) red[w * 64 + it * 16 + fr] = s2; }
  __syncthreads();
  bf16_t* gr = (bf16_t*)(ws + O_GR);
#pragma unroll
  for (int it = 0; it < 4; ++it) {
    float tot = 0.f;
#pragma unroll
    for (int ww = 0; ww < 8; ++ww) tot += red[ww * 64 + it * 16 + fr];
    const float rs = rsqrtf(tot * (1.f / 512.f) + EPS);
#pragma unroll
    for (int vt = 0; vt < 4; ++vt) {
      const int vcol = w * 64 + vt * 16 + fq * 4;
      bf16_t* gp = gr + (prow0 + it * 16 + fr) * 2048 + h * 512 + vcol;
      const f32x4 g4 = load_bf4(gp), nw = *(const f32x4*)(P.gnorm + vcol);
      f32x4 y;
#pragma unroll
      for (int j = 0; j < 4; ++j) y[j] = acc[vt][it][j] * rs * nw[j] * (g4[j] * sigm(g4[j]));
      if (st_ok) store_bf4(gp, y);
    }
  }
}

constexpr int QBLK = 32, KVBLK = 64;
constexpr float ASCALE = 0.088388347648318440f;
constexpr float ATHR = 8.f;
constexpr int LDA_ = 2048;
constexpr size_t SHM_V = KVBLK * 128 * 2, SHM_K = KVBLK * 128 * 2, SHM_ATTN = 2 * SHM_V + 2 * SHM_K + 8 * 64 * 4;
#define KSWZ(row, colB) ((row) * 256 + ((colB) ^ (((row) & 7) << 4)))
#define SBAR() __builtin_amdgcn_sched_barrier(0)
DEV int crow(int r, int hi) { return (r & 3) + 8 * (r >> 2) + 4 * hi; }

template <int MODE> DEV void alibi(f32x16& p0, f32x16& p1, float base, float nslope) {
#pragma unroll
  for (int r = 0; r < 16; ++r) {
    const float cc = (float)((r & 3) + 8 * (r >> 2));
    p0[r] = fmaf(nslope, fabsf(base - cc), p0[r]);
    p1[r] = fmaf(nslope, fabsf(base - cc - 32.f), p1[r]);
    if (MODE == 1) { p0[r] = -1e30f; if (r < 8) p1[r] = -1e30f; }
    if (MODE == 2) { p0[r] = -1e30f; p1[r] = -1e30f; }
  }
}
DEV void partialSM(f32x16& p0, f32x16& p1, float& m_reg, float& mn, float& alpha) {
  constexpr float C = ASCALE * 1.4426950408889634f;
  float pmax = p0[0];
#pragma unroll
  for (int r = 1; r < 16; ++r) pmax = fmaxf(pmax, p0[r]);
#pragma unroll
  for (int r = 0; r < 16; ++r) pmax = fmaxf(pmax, p1[r]);
  { auto rr = __builtin_amdgcn_permlane32_swap(__float_as_uint(pmax), __float_as_uint(pmax), false, false);
    pmax = fmaxf(__uint_as_float(rr[0]), __uint_as_float(rr[1])); }
  if (__builtin_expect(__all(pmax - m_reg <= ATHR / ASCALE), 1)) { mn = m_reg; alpha = 1.f; }
  else { mn = fmaxf(m_reg, pmax); alpha = __builtin_amdgcn_exp2f((m_reg - mn) * C); m_reg = mn; }
  const float mnC = -mn * C;
#pragma unroll
  for (int r = 0; r < 16; ++r) p0[r] = fmaf(p0[r], C, mnC);
#pragma unroll
  for (int r = 0; r < 16; ++r) p1[r] = fmaf(p1[r], C, mnC);
#pragma unroll
  for (int r = 0; r < 16; ++r) p0[r] = __builtin_amdgcn_exp2f(p0[r]);
}
DEV void finishSM(f32x16& p0, f32x16& p1, float alpha, float& l_reg, bf16x8& pa0, bf16x8& pa1, bf16x8& pa2, bf16x8& pa3) {
#pragma unroll
  for (int r = 0; r < 16; ++r) p1[r] = __builtin_amdgcn_exp2f(p1[r]);
  float ps = 0;
#pragma unroll
  for (int r = 0; r < 16; ++r) ps += p0[r];
#pragma unroll
  for (int r = 0; r < 16; ++r) ps += p1[r];
  { auto rr = __builtin_amdgcn_permlane32_swap(__float_as_uint(ps), __float_as_uint(ps), false, false);
    ps = __uint_as_float(rr[0]) + __uint_as_float(rr[1]); }
  l_reg = l_reg * alpha + ps;
#define PK4(P_, BASE, OUT) do { unsigned a0 = pk2(P_[BASE + 0], P_[BASE + 1]), a1 = pk2(P_[BASE + 2], P_[BASE + 3]);   \
    unsigned b0 = pk2(P_[BASE + 4], P_[BASE + 5]), b1 = pk2(P_[BASE + 6], P_[BASE + 7]);                              \
    auto r0 = __builtin_amdgcn_permlane32_swap(a0, b0, false, false); auto r1 = __builtin_amdgcn_permlane32_swap(a1, b1, false, false); \
    u32x4 w_ = {r0[0], r1[0], r0[1], r1[1]}; OUT = *reinterpret_cast<bf16x8*>(&w_); } while (0)
  PK4(p0, 0, pa0); PK4(p0, 8, pa1); PK4(p1, 0, pa2); PK4(p1, 8, pa3);
#undef PK4
}
DEV void qkt(f32x16& p0, f32x16& p1, const bf16_t* Ks, const bf16x8* qr, int r32, int hi) {
  p0 = f32x16{}; p1 = f32x16{};
#pragma unroll
  for (int d0 = 0; d0 < 8; ++d0) { const int cb = (d0 * 16 + hi * 8) * 2;
    bf16x8 b0 = *reinterpret_cast<const bf16x8*>((const char*)Ks + KSWZ(r32, cb));
    bf16x8 b1 = *reinterpret_cast<const bf16x8*>((const char*)Ks + KSWZ(32 + r32, cb));
    p0 = __builtin_amdgcn_mfma_f32_32x32x16_bf16(b0, qr[d0], p0, 0, 0, 0);
    p1 = __builtin_amdgcn_mfma_f32_32x32x16_bf16(b1, qr[d0], p1, 0, 0, 0); }
}
DEV int v_st(int k, int c) { const int kk = (k & ~0xC) | ((k & 4) << 1) | ((k & 8) >> 1); return ((kk >> 3) * 4 + (c >> 5)) * 512 + ((kk & 7) * 32 + (c & 31)) * 2; }
DEV int v_rd_base(int lane) { return ((lane & 3) << 3) | (((lane >> 2) & 3) << 6) | (((lane >> 4) & 1) << 5) | (((lane >> 5) & 1) << 8); }
constexpr int v_rd_off(int d0, int ks, int half) { return d0 * 512 + ks * 4096 + half * 2048; }
template <int OFF> DEV s16x4 tr_read(int vb) { s16x4 r; asm volatile("ds_read_b64_tr_b16 %0, %1 offset:%2" : "=&v"(r) : "v"(vb), "i"(OFF) : "memory"); return r; }
template <int D0> DEV void pv_one(f32x16& od, int vb, bf16x8 pa0, bf16x8 pa1, bf16x8 pa2, bf16x8 pa3) {
  const s16x4 l0 = tr_read<v_rd_off(D0, 0, 0)>(vb), h0 = tr_read<v_rd_off(D0, 0, 1)>(vb), l1 = tr_read<v_rd_off(D0, 1, 0)>(vb), h1 = tr_read<v_rd_off(D0, 1, 1)>(vb);
  const s16x4 l2 = tr_read<v_rd_off(D0, 2, 0)>(vb), h2 = tr_read<v_rd_off(D0, 2, 1)>(vb), l3 = tr_read<v_rd_off(D0, 3, 0)>(vb), h3 = tr_read<v_rd_off(D0, 3, 1)>(vb);
  asm volatile("s_waitcnt lgkmcnt(0)" ::: "memory"); SBAR();
#define PK(L, H) (bf16x8){L[0], L[1], L[2], L[3], H[0], H[1], H[2], H[3]}
  od = __builtin_amdgcn_mfma_f32_32x32x16_bf16(pa0, PK(l0, h0), od, 0, 0, 0);
  od = __builtin_amdgcn_mfma_f32_32x32x16_bf16(pa1, PK(l1, h1), od, 0, 0, 0);
  od = __builtin_amdgcn_mfma_f32_32x32x16_bf16(pa2, PK(l2, h2), od, 0, 0, 0);
  od = __builtin_amdgcn_mfma_f32_32x32x16_bf16(pa3, PK(l3, h3), od, 0, 0, 0);
#undef PK
}
DEV void pv_d0(f32x16* o, int vb, bf16x8 pa0, bf16x8 pa1, bf16x8 pa2, bf16x8 pa3) {
  pv_one<0>(o[0], vb, pa0, pa1, pa2, pa3); pv_one<1>(o[1], vb, pa0, pa1, pa2, pa3); pv_one<2>(o[2], vb, pa0, pa1, pa2, pa3); pv_one<3>(o[3], vb, pa0, pa1, pa2, pa3);
}

DEV void attn_body(const bf16_t* __restrict__ Qb, const bf16_t* __restrict__ Kh, const bf16_t* __restrict__ Vh, const bf16_t* __restrict__ Km, const bf16_t* __restrict__ Vm, int qrel, float nslope, char* lds, f32x16 (&o)[4]) {
  int tid = threadIdx.x; asm volatile("" : "+v"(tid));
  const int wid = __builtin_amdgcn_readfirstlane(tid >> 6), lane = tid & 63, r32 = lane & 31, hi = lane >> 5;
  bf16_t* V_lds = (bf16_t*)lds; bf16_t* K_lds = (bf16_t*)(lds + 2 * SHM_V);
  float* wsl = (float*)(lds + 2 * SHM_V + 2 * SHM_K) + wid * 64; float* li_l = wsl; float* al_l = wsl + 32;
  float m_reg = -1e30f, l_reg = 0;
#pragma unroll
  for (int d = 0; d < 4; ++d) o[d] = f32x16{};
  bf16x8 qr[8];
  const bf16_t* Qw = Qb + (long)(wid * QBLK + r32) * LDA_ + hi * 8;
#pragma unroll
  for (int d0 = 0; d0 < 8; ++d0) qr[d0] = *reinterpret_cast<const bf16x8*>(Qw + d0 * 16);
  const float fbase = (float)(qrel + wid * QBLK + r32 - 4 * hi);
  const int sr = tid >> 4, sc = (tid & 15) * 8, vst0 = v_st(sr, sc), vst1 = v_st(32 + sr, sc);
  const int vb0 = (int)(uintptr_t)V_lds + v_rd_base(lane);
  struct { bf16x8 vs0, vs1, ks0, ks1; } sr_[2];
  constexpr int NT = 66;
#define TCL(j) ((j) < 64 ? (j) : 64)
#define SLOAD(i, jt) do { const long k0_ = (long)TCL(jt) * KVBLK; const bf16_t* Vt_ = (jt) == 0 ? Vm : Vh; const bf16_t* Kt_ = (jt) == 0 ? Km : Kh; \
    sr_[i].vs0 = *reinterpret_cast<const bf16x8*>(&Vt_[(k0_ + sr) * LDA_ + sc]); sr_[i].vs1 = *reinterpret_cast<const bf16x8*>(&Vt_[(k0_ + 32 + sr) * LDA_ + sc]); \
    sr_[i].ks0 = *reinterpret_cast<const bf16x8*>(&Kt_[(k0_ + sr) * LDA_ + sc]); sr_[i].ks1 = *reinterpret_cast<const bf16x8*>(&Kt_[(k0_ + 32 + sr) * LDA_ + sc]); } while (0)
#define SWRITE(b, i) do { *(bf16x8*)((char*)V_lds + (b) * SHM_V + vst0) = sr_[i].vs0;          \
    *(bf16x8*)((char*)V_lds + (b) * SHM_V + vst1) = sr_[i].vs1; const int kc = sc * 2;               \
    *(bf16x8*)((char*)K_lds + (b) * SHM_K + KSWZ(sr, kc)) = sr_[i].ks0;                       \
    *(bf16x8*)((char*)K_lds + (b) * SHM_K + KSWZ(32 + sr, kc)) = sr_[i].ks1; } while (0)
#define SWAIT() asm volatile("s_waitcnt vmcnt(4)" ::: "memory")
#define RESC(a) do { if (__any((a) < 1.f)) { if (hi == 0) al_l[r32] = (a); asm volatile("s_waitcnt lgkmcnt(0)" ::: "memory"); \
    _Pragma("unroll") for (int d = 0; d < 4; ++d) _Pragma("unroll") for (int r = 0; r < 16; ++r) o[d][r] *= al_l[crow(r, hi)]; } } while (0)
  f32x16 pA0, pA1, pB0, pB1; float mnA, mnB, alA, alB; bf16x8 pa0, pa1, pa2, pa3;
  constexpr int SE = 0, SO = 1;
  __syncthreads();
  SLOAD(SE, 0); asm volatile("s_waitcnt vmcnt(0)" ::: "memory"); SWRITE(0, SE); __syncthreads();
  qkt(pA0, pA1, K_lds, qr, r32, hi); alibi<1>(pA0, pA1, fbase, nslope); partialSM(pA0, pA1, m_reg, mnA, alA);
  SLOAD(SO, 1); SLOAD(SE, 2);
  SWAIT(); SWRITE(1, SO); __syncthreads();
  for (int j = 1; j + 1 < NT; j += 2) {
    SBAR(); qkt(pB0, pB1, (bf16_t*)((char*)K_lds + SHM_K), qr, r32, hi); alibi<0>(pB0, pB1, fbase - 64.f * (float)j, nslope);
    finishSM(pA0, pA1, alA, l_reg, pa0, pa1, pa2, pa3); SBAR();
    SLOAD(SO, j + 2); SBAR();
    pv_d0(o, vb0, pa0, pa1, pa2, pa3); partialSM(pB0, pB1, m_reg, mnB, alB);
    __syncthreads(); SWAIT(); SWRITE(0, SE);
    RESC(alB); __syncthreads();
    SBAR(); qkt(pA0, pA1, K_lds, qr, r32, hi); alibi<0>(pA0, pA1, fbase - 64.f * (float)(j + 1), nslope);
    finishSM(pB0, pB1, alB, l_reg, pa0, pa1, pa2, pa3); SBAR();
    if (j + 3 < NT) SLOAD(SE, j + 3); SBAR();
    pv_d0(o, vb0 + (int)SHM_V, pa0, pa1, pa2, pa3); partialSM(pA0, pA1, m_reg, mnA, alA);
    __syncthreads(); SWAIT(); SWRITE(1, SO);
    RESC(alA); __syncthreads();
  }
  SBAR(); qkt(pB0, pB1, (bf16_t*)((char*)K_lds + SHM_K), qr, r32, hi); alibi<2>(pB0, pB1, fbase, nslope);
  finishSM(pA0, pA1, alA, l_reg, pa0, pa1, pa2, pa3); SBAR();
  pv_d0(o, vb0, pa0, pa1, pa2, pa3); partialSM(pB0, pB1, m_reg, mnB, alB);
  __syncthreads(); RESC(alB);
  finishSM(pB0, pB1, alB, l_reg, pa0, pa1, pa2, pa3); SBAR();
  pv_d0(o, vb0 + (int)SHM_V, pa0, pa1, pa2, pa3);
  if (hi == 0) li_l[r32] = l_reg; asm volatile("s_waitcnt lgkmcnt(0)" ::: "memory");
#pragma unroll
  for (int r = 0; r < 16; ++r) { const float rl = __builtin_amdgcn_rcpf(li_l[crow(r, hi)]);
#pragma unroll
    for (int d = 0; d < 4; ++d) o[d][r] *= rl; }
#undef SLOAD
#undef SWRITE
#undef SWAIT
#undef RESC
#undef TCL
}

DEV void attn_unit(const Params& P, int u, float lam) {
  unsigned char* ws = P.ws;
  const int tid_ = threadIdx.x, wid = __builtin_amdgcn_readfirstlane(tid_ >> 6);
  const int qblk = u & 15, vh = (u >> 4) & 1, h = (u >> 5) & 7, b = u >> 8;
  const bf16_t* dq = (const bf16_t*)(ws + O_DQ); const bf16_t* dk = (const bf16_t*)(ws + O_DK); const bf16_t* dv = (const bf16_t*)(ws + O_DV);
  const size_t brow = (size_t)b * LP; const int qrel = 64 + qblk * 256;
  const float slope = __builtin_amdgcn_exp2f(-(float)(h + 1));
  const float nslope = -slope / ASCALE;
  unsigned* stash = (unsigned*)(shm_raw + SHM_ATTN);
  f32x16 o[4];
  for (int mp = 0; mp < 2; ++mp) {
    attn_body(dq + (brow + qrel) * 2048 + h * 256 + mp * 128, dk + brow * 2048 + h * 256 + mp * 128, dv + brow * 2048 + h * 256 + vh * 128,
              (const bf16_t*)(ws + O_DKM) + h * 256 + mp * 128, (const bf16_t*)(ws + O_DVM) + h * 256 + vh * 128, qrel, nslope, (char*)shm_raw, o);
    if (mp == 0) {
      int tid = tid_; asm volatile("" : "+v"(tid));
#pragma unroll
      for (int d = 0; d < 4; ++d)
#pragma unroll
        for (int r = 0; r < 16; r += 2) stash[(d * 8 + (r >> 1)) * 512 + tid] = pk2(o[d][r], o[d][r + 1]);
    }
  }
  int tid = tid_; asm volatile("" : "+v"(tid));
  const int lane = tid & 63, r32 = lane & 31, hi = lane >> 5;
  bf16_t* dd = (bf16_t*)(ws + O_DD); float* dst = (float*)(ws + O_DST);
  const size_t prow = brow + qrel + wid * 32;
  float ss[16];
#pragma unroll
  for (int r = 0; r < 16; ++r) ss[r] = 0.f;
#pragma unroll
  for (int d = 0; d < 4; ++d)
#pragma unroll
    for (int r = 0; r < 16; r += 2) {
      const unsigned s2 = stash[(d * 8 + (r >> 1)) * 512 + tid];
      const float v0 = __uint_as_float(s2 << 16) - lam * o[d][r], v1 = __uint_as_float(s2 & 0xffff0000u) - lam * o[d][r + 1];
      ss[r] += v0 * v0; ss[r + 1] += v1 * v1;
      dd[(prow + crow(r, hi)) * 2048 + h * 256 + vh * 128 + d * 32 + r32] = f2bf(v0);
      dd[(prow + crow(r + 1, hi)) * 2048 + h * 256 + vh * 128 + d * 32 + r32] = f2bf(v1);
    }
#pragma unroll
  for (int r = 0; r < 16; ++r) {
    float s = ss[r];
#pragma unroll
    for (int of = 16; of >= 1; of >>= 1) s += __shfl_xor(s, of);
    if (r32 == 0) dst[(prow + crow(r, hi)) * 16 + h * 2 + vh] = s;
  }
}

DEV void l2_sweep(const Params& P) {
  const f32x4* src = (const f32x4*)P.x + (size_t)(blockIdx.x & 63) * 131072;
  f32x4 a = (f32x4){0.f, 0.f, 0.f, 0.f};
  for (int i = threadIdx.x; i < 131072; i += NTHR) a += src[i];
  if (a[0] + a[1] + a[2] + a[3] == 123456.789f) ((float*)(P.ws + O_DST))[0] = 1.f;
}
#define XB_TMO      128
#define XB_XCNT(j)  (256  + 64 * (j))
#define XB_XSUB(j)  (1280 + 64 * (j))
#define XB_XGEN(j)  (2304 + 64 * (j))
#define XB_TOP      3328
#define XB_TOPGEN   3392
#define XCD_BAR_WORDS 3456
#define XB_SPIN_CAP (1u << 22)
DEV unsigned xb_ld(unsigned* p) { return __hip_atomic_load(p, __ATOMIC_RELAXED, __HIP_MEMORY_SCOPE_AGENT); }
DEV unsigned xb_add(unsigned* p, unsigned v) { return __hip_atomic_fetch_add(p, v, __ATOMIC_RELAXED, __HIP_MEMORY_SCOPE_AGENT); }
DEV unsigned xb_xcc_id() { return (unsigned)__builtin_amdgcn_s_getreg((3 << 11) | 20) & 0xFu; }
#define XB_SPIN(cond, bar) do { unsigned _sp = 0; while (cond) { __builtin_amdgcn_s_sleep(1); \
    if ((++_sp & 255u) == 0u) { if (xb_ld(&(bar)[XB_TMO])) break; if (_sp > XB_SPIN_CAP) { atomicAdd(&(bar)[XB_TMO], 1u); break; } } } } while (0)
struct XcdBarrier { unsigned* bar; unsigned x; volatile LAS unsigned* st; };
DEV XcdBarrier xcd_barrier_post(unsigned* bar, volatile LAS unsigned* st) {
  XcdBarrier b; b.bar = bar; b.x = xb_xcc_id(); b.st = st;
  if (threadIdx.x == 0) (void)xb_add(&bar[XB_XCNT(b.x)], 1u);
  return b;
}
DEV void xcd_barrier_complete(unsigned* bar, unsigned x, unsigned& nloc, unsigned& nx) {
  const unsigned G = gridDim.x * gridDim.y * gridDim.z;
  unsigned sum, cnt, mine, sp = 0u;
  for (;;) {
    sum = 0u; cnt = 0u; mine = 0u;
#pragma unroll
    for (unsigned j = 0; j < 16; ++j) { const unsigned c = xb_ld(&bar[XB_XCNT(j)]); sum += c; cnt += (c > 0u) ? 1u : 0u; mine = (j == x) ? c : mine; }
    if (sum == G) break;
    __builtin_amdgcn_s_sleep(1);
    if ((++sp & 255u) == 0u) { if (xb_ld(&bar[XB_TMO])) break; if (sp > XB_SPIN_CAP) { atomicAdd(&bar[XB_TMO], 1u); break; } }
  }
  nloc = mine > 0u ? mine : 1u; nx = cnt > 0u ? cnt : 1u;
}
DEV void xcd_barrier(const XcdBarrier& b) {
  asm volatile("s_waitcnt vmcnt(0) lgkmcnt(0)" ::: "memory");
  __syncthreads();
  if (threadIdx.x == 0) {
    unsigned* bar = b.bar;
    __builtin_amdgcn_s_waitcnt(0);
    unsigned nloc = b.st[0], nx = b.st[1];
    if (nloc == 0u) { xcd_barrier_complete(bar, b.x, nloc, nx); b.st[0] = nloc; b.st[1] = nx; }
    const unsigned old = xb_add(&bar[XB_XSUB(b.x)], 1u);
    const unsigned gen = old / nloc;
    if (old + 1u == (gen + 1u) * nloc) {
      __builtin_amdgcn_fence(__ATOMIC_RELEASE, "agent");
      asm volatile("s_waitcnt vmcnt(0)" ::: "memory");
      const unsigned og = xb_add(&bar[XB_TOP], 1u);
      const unsigned tg = og / nx;
      if (og + 1u == (tg + 1u) * nx) xb_add(&bar[XB_TOPGEN], 1u);
      else XB_SPIN(xb_ld(&bar[XB_TOPGEN]) == tg, bar);
      __builtin_amdgcn_fence(__ATOMIC_ACQUIRE, "agent");
      xb_add(&bar[XB_XGEN(b.x)], 1u);
      asm volatile("s_waitcnt vmcnt(0)" ::: "memory");
    } else {
      XB_SPIN(xb_ld(&bar[XB_XGEN(b.x)]) == gen, bar);
      __builtin_amdgcn_fence(__ATOMIC_ACQUIRE, "agent");
      asm volatile("s_waitcnt vmcnt(0)" ::: "memory");
    }
  }
  __syncthreads();
}
DEV void gsync_now(const Params& P) {
  XcdBarrier b; b.bar = (unsigned*)(P.ws + O_BAR); b.x = xb_xcc_id(); b.st = (volatile LAS unsigned*)((LAS unsigned char*)shm_raw + DYN_LDS_MAIN);
  xcd_barrier(b);
}
#define gsync(g) gsync_now(P)
#ifndef REP
#define REP 0
#endif
#ifndef DBG_STOP
#define DBG_STOP 0
#endif
DEV void dbg_dump(const Params& P, size_t off, int ld = 2048) {
  const int tid = threadIdx.x, lane = tid & 63, gw = (blockIdx.x * NTHR + tid) >> 6, nw = (gridDim.x * NTHR) >> 6;
  const bf16_t* buf = (const bf16_t*)(P.ws + off);
  for (int r = gw; r < TR; r += nw) {
    const size_t prow = (size_t)(r >> 12) * LP + 64 + (r & 4095);
    for (int i = 0; i < 8; ++i) { const int c = i * 256 + lane * 4; f32x4 v = (f32x4){0.f, 0.f, 0.f, 0.f}; if (c < ld) v = load_bf4(buf + prow * ld + c); for (int j = 0; j < 4; ++j) if (!(fabsf(v[j]) < 1e30f)) v[j] = 10000.f; *(f32x4*)(P.out + (size_t)r * 2048 + c) = v; }
  }
}
#define STOP_AT(k, off) if (DBG_STOP == (k)) { dbg_dump(P, off); return; }
#define STOP_AT2(k, off) if (DBG_STOP == (k)) { dbg_dump(P, off, 1024); return; }
#ifndef ONLY
#define PH(n) true
#else
#define PH(n) ((ONLY) == (n))
#endif
__global__ void __launch_bounds__(NTHR, 2) mega(Params P) {
  cg::grid_group grid = cg::this_grid();
  unsigned char* ws = P.ws;
  volatile LAS unsigned* xst = (volatile LAS unsigned*)((LAS unsigned char*)shm_raw + DYN_LDS_MAIN);
  if (threadIdx.x == 0) { xst[0] = 0u; xst[1] = 0u; xst[2] = 0u; xst[3] = 0u; }
  __syncthreads();
  (void)xcd_barrier_post((unsigned*)(ws + O_BAR), xst);
  if (P.ws == nullptr) grid.sync();
  if (PH(0)) phase_prologue(P);
  if (REP & 4) phase_prologue(P);
  gsync(grid);
  if (PH(1)) for (int gp = G_FFN1_GU; gp <= G_WIN_META; ++gp) { gemm_phase(P, gp); if (REP & 1) gemm_phase(P, gp); gsync(grid); if (gp == G_FFN1_D) { STOP_AT(1, O_ACTB) } if (gp == G_WIN_META) { STOP_AT(6, O_GV) } }
  if (PH(2)) for (int u = blockIdx.x; u < 16 * 65; u += gridDim.x) gla_prep_unit(P, u);
  if (REP & 32) for (int u = blockIdx.x; u < 16 * 65; u += gridDim.x) gla_prep_unit(P, u, true);
  gsync(grid);
  STOP_AT2(7, O_KIB)
  STOP_AT2(10, O_QDB)
  if (DBG_STOP == 11) {
    const int tid = threadIdx.x, lane = tid & 63, gw = (blockIdx.x * NTHR + tid) >> 6, nw = (gridDim.x * NTHR) >> 6;
    const bf16_t* b0 = (const bf16_t*)(ws + O_GK); const bf16_t* b1 = (const bf16_t*)(ws + O_GV); const float* dl = (const float*)(ws + O_DL);
    for (int r = gw; r < TR; r += nw) { const size_t prow = (size_t)(r >> 6) * LP + (r & 63);
      for (int i = 0; i < 8; ++i) { const int c = i * 256 + lane * 4; f32x4 v = (f32x4){0.f, 0.f, 0.f, 0.f};
        if (r < 256) v = c < 1024 ? load_bf4(b0 + prow * 1024 + c) : load_bf4(b1 + prow * 2048 + c - 1024);
        else if (r < 272 && c < 256) v = *(const f32x4*)(dl + (size_t)((r - 256) * 2) * 65 * 256 + c);
        *(f32x4*)(P.out + (size_t)r * 2048 + c) = v; } }
    return;
  }
  if (DBG_STOP == 9) {
    const int tid = threadIdx.x, lane = tid & 63, gw = (blockIdx.x * NTHR + tid) >> 6, nw = (gridDim.x * NTHR) >> 6;
    const bf16_t* b0 = (const bf16_t*)(ws + O_GQ); const bf16_t* b1 = (const bf16_t*)(ws + O_GK);
    for (int r = gw; r < TR; r += nw) { const size_t prow = (size_t)(r >> 12) * LP + 64 + (r & 4095);
      for (int i = 0; i < 8; ++i) { const int c = i * 256 + lane * 4; *(f32x4*)(P.out + (size_t)r * 2048 + c) = c < 1024 ? load_bf4(b0 + prow * 1024 + c) : load_bf4(b1 + prow * 1024 + c - 1024); } }
    return;
  }
  if (PH(3)) for (int u = blockIdx.x; u < 256; u += gridDim.x) gla_scan_unit(P, u);
  if (REP & 8) for (int u = blockIdx.x; u < 256; u += gridDim.x) gla_scan_unit(P, u);
  gsync(grid);
  if (DBG_STOP == 8) {
    const int tid = threadIdx.x, lane = tid & 63, gw = (blockIdx.x * NTHR + tid) >> 6, nw = (gridDim.x * NTHR) >> 6;
    const bf16_t* of = (const bf16_t*)P.out; const bf16_t* ob = of + (size_t)TR * 2048; bf16_t* g = (bf16_t*)(ws + O_GR);
    for (int r = gw; r < TR; r += nw) { const size_t prow = (size_t)(r >> 12) * LP + 64 + (r & 4095);
      for (int i = 0; i < 8; ++i) { const int c = i * 256 + lane * 4; store_bf4(g + prow * 2048 + c, load_bf4(of + (size_t)r * 2048 + c) + load_bf4(ob + (size_t)r * 2048 + c)); } }
    gsync(grid);
    dbg_dump(P, O_GR); return;
  }
  if (PH(4)) for (int u = blockIdx.x; u < 1024; u += gridDim.x) gla_finish_unit(P, u);
  if (REP & 16) for (int u = blockIdx.x; u < 1024; u += gridDim.x) gla_finish_unit(P, u, true);
  gsync(grid);
  STOP_AT(2, O_GR)
  if (PH(1)) gemm_phase(P, G_WIN_B);
  if (REP & 1) gemm_phase(P, G_WIN_B);
  gsync(grid);
  if (PH(5)) {
    float s1 = 0.f, s2 = 0.f;
    for (int i = 0; i < 128; ++i) { s1 = fmaf(P.lq1[i], P.lk1[i], s1); s2 = fmaf(P.lq2[i], P.lk2[i], s2); }
    const float lam = __expf(s1) - __expf(s2) + 0.2f;
    for (int u = blockIdx.x; u < 1024; u += gridDim.x) attn_unit(P, u, lam);
    if (REP & 2) for (int u = blockIdx.x; u < 1024; u += gridDim.x) attn_unit(P, u, lam);
  }
  gsync(grid);
  if (PH(6)) {
    int tid = threadIdx.x; asm volatile("" : "+v"(tid)); const int lane = tid & 63;
    const int gw = (blockIdx.x * NTHR + tid) >> 6, nw = (gridDim.x * NTHR) >> 6;
    bf16_t* dd = (bf16_t*)(ws + O_DD); const float* dst = (const float*)(ws + O_DST);
    for (int r = gw; r < TR; r += nw) {
      const size_t prow = (size_t)(r >> 12) * LP + 64 + (r & 4095);
      const int col = lane * 32, hh = col >> 8;
      const float rs = rsqrtf((dst[prow * 16 + hh * 2] + dst[prow * 16 + hh * 2 + 1]) * (1.f / 256.f) + EPS) * 0.8f;
#pragma unroll
      for (int i = 0; i < 8; ++i) { bf16_t* p = dd + prow * 2048 + col + i * 4; f32x4 v = load_bf4(p); const f32x4 nw4 = *(const f32x4*)(P.dnorm + ((col + i * 4) & 255)); v = v * nw4 * rs; store_bf4(p, v); }
    }
    int tbase = 0, t = blockIdx.x; bf16_t* wf = (bf16_t*)(ws + O_WF);
    transpose_job(P.w2g, 2048, DFF, wf + (size_t)DFF * 2048, P.n2, false, tbase, t);
    transpose_job(P.w2u, 2048, DFF, wf + (size_t)2 * DFF * 2048, P.n2, false, tbase, t);
    transpose_job(P.w2d, DFF, 2048, wf, nullptr, false, tbase, t);
  }
  gsync(grid);
  STOP_AT(3, O_DD)
  if (PH(1)) for (int gp = G_MERGE; gp <= G_FFN2_D; ++gp) { gemm_phase(P, gp); if ((REP & 1) && gp != G_FFN2_D) gemm_phase(P, gp); gsync(grid); if (gp == G_MERGE) { STOP_AT(4, O_MRG) } if (gp == G_OUT) { STOP_AT(5, O_ACTB) } }
  if (PH(7)) {
    int tid = threadIdx.x; asm volatile("" : "+v"(tid)); const int lane = tid & 63;
    const int gw = (blockIdx.x * NTHR + tid) >> 6, nw = (gridDim.x * NTHR) >> 6;
    for (int r = gw; r < TR; r += nw) {
      float* p = P.out + (size_t)r * 2048;
      f32x4 v[8]; float ss = 0.f;
#pragma unroll
      for (int i = 0; i < 8; ++i) { v[i] = *(f32x4*)(p + i * 256 + lane * 4); ss += v[i][0] * v[i][0] + v[i][1] * v[i][1] + v[i][2] * v[i][2] + v[i][3] * v[i][3]; }
#pragma unroll
      for (int o = 32; o >= 1; o >>= 1) ss += __shfl_xor(ss, o);
      const float rs = rsqrtf(ss * (1.f / 2048.f) + EPS);
#pragma unroll
      for (int i = 0; i < 8; ++i) { const int c = i * 256 + lane * 4; const f32x4 g = *(const f32x4*)(P.nfin + c); *(f32x4*)(p + c) = v[i] * g * rs; }
    }
  }
}

constexpr size_t DYN_LDS = DYN_LDS_MAIN + 16;
static_assert(DYN_LDS >= 8 * HT * 2 && DYN_LDS >= SHM_ATTN + 65536, "lds");

extern "C" void kernel_launch(void* const* d_in, const int* in_sizes, int n_in, void* d_out, int out_size, void* d_ws, size_t ws_size, hipStream_t stream) {
  if (n_in != 26 || ws_size < WS_TOTAL || out_size != TR * 2048) { fprintf(stderr, "kernel_launch: bad shapes n_in %d ws %zu need %zu out %d\n", n_in, ws_size, WS_TOTAL, out_size); return; }
  static int grid_blocks = 0;
  if (!grid_blocks) {
    hipFuncSetAttribute((const void*)mega, hipFuncAttributeMaxDynamicSharedMemorySize, (int)DYN_LDS);
    int dev = 0, cus = 0, per_cu = 0;
    hipGetDevice(&dev);
    hipDeviceGetAttribute(&cus, hipDeviceAttributeMultiprocessorCount, dev);
    hipOccupancyMaxActiveBlocksPerMultiprocessor(&per_cu, mega, NTHR, DYN_LDS);
    if (per_cu < 1) per_cu = 1;
    grid_blocks = cus;
  }
  Params p{};
  const float** pp = (const float**)&p;
  for (int i = 0; i < 26; ++i) pp[i] = (const float*)d_in[i];
  p.out = (float*)d_out; p.ws = (unsigned char*)d_ws;
  hipMemsetAsync((unsigned char*)d_ws + O_BAR, 0, 16384, stream);
  void* args[] = {&p};
  hipError_t e = hipLaunchCooperativeKernel((void*)mega, dim3(grid_blocks), dim3(NTHR), args, DYN_LDS, stream);
  if (e != hipSuccess) fprintf(stderr, "cooperative launch failed: %s (grid %d)\n", hipGetErrorString(e), grid_blocks);
}
```

```cpp
#include <hip/hip_runtime.h>
#include <hip/hip_cooperative_groups.h>
#include <stdint.h>
#include <cstdio>
namespace cg = cooperative_groups;

#define DEV __device__ __forceinline__
typedef unsigned short bf16_t;
using bf16x8 = __attribute__((ext_vector_type(8))) short;
using s16x4  = __attribute__((ext_vector_type(4))) short;
using f32x4  = __attribute__((ext_vector_type(4))) float;
using f32x16 = __attribute__((ext_vector_type(16))) float;
using u32x4  = __attribute__((ext_vector_type(4))) unsigned;
using u32x2  = __attribute__((ext_vector_type(2))) unsigned;

constexpr int DM = 2048, DFF = 5504, NB = 4, SEQ = 4096, LP = 4160, RP = NB * LP  , TR = NB * SEQ  ;
constexpr int INW = 16416;
constexpr float EPS = 1e-6f;
constexpr size_t DYN_LDS_MAIN = 4 * 64 * 264 * 2 + 64 * 32 * 4;
constexpr int NTHR = 512;

constexpr size_t SZ_ACT = (size_t)RP * 2048 * 2;
constexpr size_t SZ_HALF = (size_t)RP * 1024 * 2;
constexpr size_t SZ_SQ = (size_t)2048 * 2048 * 2;
constexpr size_t SZ_FW = (size_t)DFF * 2048 * 2;
constexpr size_t SZ_HID = (size_t)RP * DFF * 2;
constexpr size_t O_ACTB = 0;
constexpr size_t O_WIN = O_ACTB + SZ_ACT;
constexpr size_t O_WS = O_WIN + SZ_ACT;
constexpr size_t O_WF = O_WS + 3 * SZ_SQ;
constexpr size_t O_HID = O_WF + 3 * SZ_FW;
constexpr size_t O_R = O_HID + SZ_HID;
constexpr size_t O_F = O_R;
constexpr size_t O_GR = O_F + SZ_ACT;
constexpr size_t O_P = O_GR + SZ_ACT;
constexpr size_t SZ_P = (size_t)16 * 65 * 4096 * 2;
constexpr size_t O_LOW = O_P + SZ_P;
constexpr size_t O_DL = O_LOW + (size_t)RP * 32 * 4;
constexpr size_t O_ST = O_DL + (size_t)16 * 2 * 65 * 256 * 4;
constexpr size_t O_ST1 = O_ST + (size_t)RP * 4, O_ST2 = O_ST1 + (size_t)RP * 32 * 4;
constexpr size_t O_DST = O_ST2 + (size_t)RP * 32 * 4;
constexpr size_t O_DKM = O_DST + (size_t)RP * 16 * 4;
constexpr size_t O_DVM = O_DKM + (size_t)64 * 2048 * 2;
constexpr size_t O_BAR = O_DVM + (size_t)64 * 2048 * 2;
constexpr size_t O_KMAX = O_BAR + 14336;
constexpr size_t WS_TOTAL = O_BAR + 16384;
constexpr size_t O_GQ = O_WF + SZ_FW, O_GK = O_HID + (size_t)256 * DFF * 2, O_GV = O_GK + SZ_HALF, O_QDB = O_GV + SZ_ACT, O_KIB = O_QDB + SZ_HALF;
static_assert(O_GQ + SZ_HALF <= O_HID && O_KIB + SZ_HALF <= O_R, "gla overlay 2");
constexpr size_t O_DQ = O_WF, O_DK = O_DQ + SZ_ACT, O_DV = O_DK + SZ_ACT;
constexpr size_t O_MRG = O_DK;
constexpr size_t O_DD = O_WIN;
static_assert(O_DV + SZ_ACT <= O_R, "diff overlay");

struct Params {
  const float *x, *meta, *n1, *w1g, *w1u, *w1d, *nmix, *win, *wa2f, *baf, *wa2b, *bab, *gnorm,
      *lq1, *lk1, *lq2, *lk2, *dnorm, *wbg, *wbd, *wout, *n2, *w2g, *w2u, *w2d, *nfin;
  float* out;
  unsigned char* ws;
};

extern __shared__ __attribute__((aligned(16))) unsigned char shm_raw[];
#define shm ((bf16_t*)shm_raw)

DEV float bf2f(bf16_t v) { return __uint_as_float(((unsigned)v) << 16); }
typedef __bf16 bf16x2_t __attribute__((ext_vector_type(2)));
typedef float f32x2_t __attribute__((ext_vector_type(2)));
DEV unsigned pk2(float lo, float hi) { f32x2_t v = {lo, hi}; bf16x2_t b = __builtin_convertvector(v, bf16x2_t); return __builtin_bit_cast(unsigned, b); }
DEV bf16_t f2bf(float f) { return (bf16_t)(pk2(f, 0.f) & 0xffffu); }
DEV float to_sgpr(float v) { float r; asm volatile("v_readfirstlane_b32 %0, %1" : "=s"(r) : "v"(v)); return r; }
DEV float sigm(float v) { return 1.f / (1.f + __expf(-v)); }

constexpr int BM = 256, BK = 64, HALF = 128, HT = HALF * BK, NXCD = 8, WGM = 8;
DEV int lds_byte(int r, int c) { int st = (r >> 4) * 2 + (c >> 5), rr = r & 15, cc = c & 31, ob = rr * 64 + cc * 2; return st * 1024 + (ob ^ (((ob >> 9) & 1) << 5)); }
DEV void stage_rc(int b, int& R, int& C) { int st = b / 1024, sb = b % 1024, swz = sb ^ (((sb >> 9) & 1) << 5); R = (st >> 1) * 16 + swz / 64; C = (st & 1) * 32 + (swz % 64) / 2; }

#define LAS __attribute__((address_space(3)))
constexpr int HTB = HALF * BK * 2;
#define PG8_SA(b, h) (((b) * 2 + (h)) * HTB)
#define PG8_SB(b, h) ((4 + (b) * 2 + (h)) * HTB)
#define STAGE(bufoff, gbase, voff) do { _Pragma("unroll") for (int _i = 0; _i < 2; ++_i) \
    __builtin_amdgcn_global_load_lds((const unsigned*)((const char*)(gbase) + (voff)[_i]), (LAS unsigned*)(lds + (bufoff) + ldsw + _i * 8192), 16, 0, 0); } while (0)
#define LDA(dst, b, h) do { _Pragma("unroll") for (int m = 0; m < 4; ++m) _Pragma("unroll") for (int k = 0; k < 2; ++k) dst[m][k] = *(const LAS bf16x8*)(lds + PG8_SA(b, h) + aoff + m * 2048 + k * 1024); } while (0)
#define LDB(dst, b, h) do { _Pragma("unroll") for (int n = 0; n < 2; ++n) _Pragma("unroll") for (int k = 0; k < 2; ++k) dst[n][k] = *(const LAS bf16x8*)(lds + PG8_SB(b, h) + boff + n * 2048 + k * 1024); } while (0)
#define MMA(ai, bj, At_, Bt_) do { __builtin_amdgcn_s_setprio(1); \
    _Pragma("unroll") for (int m = 0; m < 4; ++m) _Pragma("unroll") for (int n = 0; n < 2; ++n) _Pragma("unroll") for (int k = 0; k < 2; ++k) \
      acc[ai][bj][m][n] = __builtin_amdgcn_mfma_f32_16x16x32_bf16(Bt_[n][k], At_[m][k], acc[ai][bj][m][n], 0, 0, 0); \
    __builtin_amdgcn_s_setprio(0); } while (0)
#define WAIT_V(n) asm volatile("s_waitcnt vmcnt(" #n ")" ::: "memory")
#define WAIT_L(n) asm volatile("s_waitcnt lgkmcnt(" #n ")" ::: "memory")
#define BAR __builtin_amdgcn_s_barrier()
#define SCHED __builtin_amdgcn_sched_barrier(0)

DEV void gemm_mainloop(const char* __restrict__ cA, const char* __restrict__ cB0, const char* __restrict__ cB1, const int K, f32x4 (&acc)[2][2][4][2]) {
  LAS unsigned char* lds = (LAS unsigned char*)shm_raw;
  int tid = threadIdx.x; asm volatile("" : "+v"(tid));
  const int wid = __builtin_amdgcn_readfirstlane(tid >> 6), lane = tid & 63, wr = wid >> 2, wc = wid & 3, fr = lane & 15, fq = lane >> 4;
  unsigned voff[2];
#pragma unroll
  for (int i = 0; i < 2; ++i) { int R, C; stage_rc(tid * 16 + i * 8192, R, C); voff[i] = (unsigned)(R * K + C) * 2u; }
  const size_t kstep = (size_t)(BK * 2), hstep = (size_t)HALF * K * 2;
  const unsigned ldsw = (unsigned)wid * 1024u;
  const int aoff = lds_byte(wr * 64 + fr, fq * 8), boff = lds_byte(wc * 32 + fr, fq * 8);
  bf16x8 At[4][2], B0[2][2], B1[2][2];
  const int nt = K / BK;
  STAGE(PG8_SB(0, 0), cB0, voff); STAGE(PG8_SA(0, 0), cA, voff); STAGE(PG8_SB(0, 1), cB1, voff); STAGE(PG8_SA(0, 1), cA + hstep, voff);
  if (wr == 1) BAR;
  WAIT_V(4); BAR;
  STAGE(PG8_SB(1, 0), cB0 + kstep, voff); STAGE(PG8_SA(1, 0), cA + kstep, voff); STAGE(PG8_SB(1, 1), cB1 + kstep, voff);
  WAIT_V(6); BAR;
  for (int t = 0; t < nt - 2; t += 2) {
    const char* a1 = cA + (size_t)(t + 1) * kstep;
    const char* a2 = a1 + kstep; const char* a3 = a2 + kstep;
    const char* b02 = cB0 + (size_t)(t + 2) * kstep; const char* b12 = cB1 + (size_t)(t + 2) * kstep;
    LDB(B0, 0, 0); SCHED; LDA(At, 0, 0); STAGE(PG8_SA(1, 1), a1 + hstep, voff);
    WAIT_L(8); BAR; WAIT_L(0); MMA(0, 0, At, B0); BAR; SCHED;
    LDB(B1, 0, 1); STAGE(PG8_SB(0, 0), b02, voff);
    BAR; WAIT_L(0); MMA(0, 1, At, B1); BAR;
    LDA(At, 0, 1); STAGE(PG8_SA(0, 0), a2, voff);
    BAR; WAIT_L(0); MMA(1, 0, At, B0); BAR; SCHED;
    STAGE(PG8_SB(0, 1), b12, voff);
    WAIT_V(6); BAR; MMA(1, 1, At, B1); BAR;
    LDB(B0, 1, 0); SCHED; LDA(At, 1, 0); STAGE(PG8_SA(0, 1), a2 + hstep, voff);
    WAIT_L(8); BAR; WAIT_L(0); MMA(0, 0, At, B0); BAR; SCHED;
    LDB(B1, 1, 1); STAGE(PG8_SB(1, 0), b02 + kstep, voff);
    BAR; WAIT_L(0); MMA(0, 1, At, B1); BAR;
    LDA(At, 1, 1); STAGE(PG8_SA(1, 0), a3, voff);
    BAR; WAIT_L(0); MMA(1, 0, At, B0); BAR; SCHED;
    STAGE(PG8_SB(1, 1), b12 + kstep, voff);
    WAIT_V(6); BAR; MMA(1, 1, At, B1); BAR;
  }
  { LDB(B0, 0, 0); LDA(At, 0, 0); STAGE(PG8_SA(1, 1), cA + (size_t)(nt - 1) * kstep + hstep, voff);
    BAR; WAIT_L(0); MMA(0, 0, At, B0); BAR;
    LDB(B1, 0, 1); BAR; WAIT_L(0); MMA(0, 1, At, B1); BAR;
    LDA(At, 0, 1); WAIT_V(4); BAR; WAIT_L(0); MMA(1, 0, At, B0); MMA(1, 1, At, B1); BAR; }
  { LDB(B0, 1, 0); LDA(At, 1, 0); WAIT_V(2); BAR; WAIT_L(0); MMA(0, 0, At, B0); BAR;
    LDB(B1, 1, 1); WAIT_V(0); BAR; WAIT_L(0); MMA(0, 1, At, B1); BAR;
    LDA(At, 1, 1); BAR; WAIT_L(0); MMA(1, 0, At, B0); MMA(1, 1, At, B1); BAR; }
  if (wr == 0) BAR;
}

enum { G_FFN1_GU = 0, G_FFN1_D, G_WIN_A, G_WIN_META, G_WIN_B, G_MERGE, G_OUT, G_FFN2_GU, G_FFN2_D };

DEV void store_bf4(bf16_t* p, f32x4 v) { u32x2 w; w.x = pk2(v[0], v[1]); w.y = pk2(v[2], v[3]); *(u32x2*)p = w; }
DEV f32x4 load_bf4(const bf16_t* p) { u32x2 w = *(const u32x2*)p; f32x4 v; v[0] = __uint_as_float(w.x << 16); v[1] = __uint_as_float(w.x & 0xffff0000u); v[2] = __uint_as_float(w.y << 16); v[3] = __uint_as_float(w.y & 0xffff0000u); return v; }

DEV void main_order(int L, int nN, int& pm, int& pn) {
  const int nwg = 64 * nN;
  int wgid = L; { const int q = nwg / NXCD, r = nwg % NXCD, xcd = wgid % NXCD, off = wgid / NXCD; wgid = (xcd < r ? xcd * (q + 1) : r * (q + 1) + (xcd - r) * q) + off; }
  const int nig = WGM * nN, gid = wgid / nig, fm = gid * WGM;
  pm = fm + ((wgid % nig) % WGM); pn = (wgid % nig) / WGM;
}

DEV void gemm_phase(const Params& P, const int gp) {
  int tid = threadIdx.x; asm volatile("" : "+v"(tid));
  const int wid = __builtin_amdgcn_readfirstlane(tid >> 6), lane = tid & 63, wr = wid >> 2, wc = wid & 3, fr_ = lane & 15, fq_ = lane >> 4;
  unsigned char* ws = P.ws;
  float* stats = (float*)(ws + O_ST);
  int nN, nPre = 0, nMain, nMeta = 0, pnoff = 0;
  switch (gp) {
    case G_FFN1_GU: nN = 43; nMeta = 43; break;
    case G_FFN1_D: nN = 8; break;
    case G_WIN_A: nN = 25; nPre = 8; break;
    case G_WIN_META: nN = 0; nMeta = 65; break;
    case G_WIN_B: nN = 40; pnoff = 25; break;
    case G_MERGE: nN = 8; break;
    case G_OUT: nN = 8; break;
    case G_FFN2_GU: nN = 43; break;
    default: nN = 8; break;
  }
  nMain = 64 * nN;
  const int ntiles = nPre + nMain + nMeta;
  for (int t = blockIdx.x; t < ntiles; t += gridDim.x) {
    int pm, pn, kind = gp;
    bool meta = false;
    if (t < nPre) { pm = 64; pn = t; meta = true; kind = G_FFN1_D; }
    else if (t < nPre + nMain) { main_order(t - nPre, nN, pm, pn); pn += pnoff; }
    else { pm = 64; pn = t - nPre - nMain; meta = true; }
    const int arow0 = meta ? 0 : (pm >> 4) * LP + 64 + (pm & 15) * 256;
    const int nrow0 = pm * 256;
    const bf16_t *A, *B0p, *B1p; int K;
    switch (kind) {
      case G_FFN1_GU: A = (const bf16_t*)(ws + O_ACTB); K = 2048; B0p = (const bf16_t*)(ws + O_WF) + (size_t)DFF * 2048 + (size_t)pn * 128 * 2048; B1p = B0p + (size_t)DFF * 2048; break;
      case G_FFN2_GU: A = (const bf16_t*)(ws + O_ACTB); K = 2048; B0p = (const bf16_t*)(ws + O_WF) + (size_t)DFF * 2048 + (size_t)pn * 128 * 2048; B1p = B0p + (size_t)DFF * 2048; break;
      case G_FFN1_D: case G_FFN2_D: A = (const bf16_t*)(ws + O_HID); K = DFF; B0p = (const bf16_t*)(ws + O_WF) + (size_t)pn * 256 * DFF; B1p = B0p + (size_t)128 * DFF; break;
      case G_WIN_A: case G_WIN_META: case G_WIN_B: A = (const bf16_t*)(ws + O_ACTB); K = 2048; B0p = (const bf16_t*)(ws + O_WIN) + (size_t)pn * 256 * 2048; B1p = B0p + (size_t)128 * 2048; break;
      case G_MERGE: A = (const bf16_t*)(ws + O_GR); K = 2048; B0p = (const bf16_t*)(ws + O_WS) + (size_t)pn * 256 * 2048; B1p = B0p + (size_t)128 * 2048; break;
      default  : A = (const bf16_t*)(ws + O_MRG); K = 2048; B0p = (const bf16_t*)(ws + O_WS) + 2 * (size_t)2048 * 2048 + (size_t)pn * 256 * 2048; B1p = B0p + (size_t)128 * 2048; break;
    }
    f32x4 acc[2][2][4][2];
#pragma unroll
    for (int a = 0; a < 2; ++a)
#pragma unroll
      for (int b = 0; b < 2; ++b)
#pragma unroll
        for (int m = 0; m < 4; ++m)
#pragma unroll
          for (int n = 0; n < 2; ++n) acc[a][b][m][n] = (f32x4){0.f, 0.f, 0.f, 0.f};
    const int nk = (kind == G_MERGE) ? 2 : 1;
    for (int kl = 0; kl < nk; ++kl) {
      if (kl == 1) {
        int fr = fr_, fq = fq_; asm volatile("" : "+v"(fr), "+v"(fq));
        const bf16_t* gA = (const bf16_t*)P.out; const bf16_t* gB = gA + (size_t)TR * 2048;
#pragma unroll
        for (int ai = 0; ai < 2; ++ai)
#pragma unroll
          for (int m = 0; m < 4; ++m) {
            const size_t nrow = (size_t)(nrow0 + ai * 128 + wr * 64 + m * 16 + fr) * 2048;
#pragma unroll
            for (int bj = 0; bj < 2; ++bj)
#pragma unroll
              for (int n = 0; n < 2; ++n) {
                const int col = pn * 256 + bj * 128 + wc * 32 + n * 16 + fq * 4;
                f32x4 a4 = load_bf4(gA + nrow + col), b4 = load_bf4(gB + nrow + col);
#pragma unroll
                for (int j = 0; j < 4; ++j) { float ea = __expf(-fminf(fmaxf(a4[j], -40.f), 40.f)), eb = __expf(-fminf(fmaxf(b4[j], -40.f), 40.f)); acc[ai][bj][m][n][j] *= (1.f + eb) / (1.f + ea); }
              }
            asm volatile("" ::: "memory"); SCHED;
          }
        A = (const bf16_t*)(ws + O_DD); B0p += (size_t)2048 * 2048; B1p += (size_t)2048 * 2048;
        asm volatile("s_waitcnt vmcnt(0)" ::: "memory");
      }
      gemm_mainloop((const char*)(A + (size_t)arow0 * K), (const char*)B0p, (const char*)B1p, K, acc);
    }
    int fr = fr_, fq = fq_; asm volatile("" : "+v"(fr), "+v"(fq));
    if (kind == G_FFN1_GU || kind == G_FFN2_GU || kind == G_WIN_A || kind == G_WIN_META || kind == G_WIN_B) {
      float* rsl = (float*)shm_raw;
      if (tid < 256) {
        const size_t row = (size_t)arow0 + tid; float sum;
        if (kind == G_FFN1_GU) sum = stats[row];
        else { const f32x4* pp = (const f32x4*)((const float*)(ws + (kind == G_FFN2_GU ? O_ST2 : O_ST1)) + row * 32); f32x4 a = pp[0];
#pragma unroll
          for (int i = 1; i < 8; ++i) a += pp[i];
          sum = (a[0] + a[1]) + (a[2] + a[3]); }
        rsl[tid] = rsqrtf(sum * (1.f / 2048.f) + EPS);
      }
      __syncthreads();
    }
    if (kind == G_FFN1_GU || kind == G_FFN2_GU) {
      const float* rsl = (const float*)shm_raw;
      bf16_t* hid = (bf16_t*)(ws + O_HID);
#pragma unroll
      for (int ai = 0; ai < 2; ++ai)
#pragma unroll
        for (int m = 0; m < 4; ++m) {
          const int r = ai * 128 + wr * 64 + m * 16 + fr;
          if (meta && (r < 48 || r >= 64)) continue;
          const int prow = arow0 + r;
          const float rs = rsl[r];
#pragma unroll
          for (int n = 0; n < 2; ++n) {
            f32x4 g = acc[ai][0][m][n] * rs, u = acc[ai][1][m][n] * rs, h;
#pragma unroll
            for (int j = 0; j < 4; ++j) h[j] = g[j] * sigm(g[j]) * u[j];
            store_bf4(hid + (size_t)prow * DFF + pn * 128 + wc * 32 + n * 16 + fq * 4, h);
          }
          asm volatile("" ::: "memory"); SCHED;
        }
    } else if (kind == G_FFN1_D || kind == G_OUT || kind == G_FFN2_D) {
      const float* resA = (kind == G_FFN2_D) ? P.out : P.x;
      const bf16_t* resF = (kind == G_OUT) ? (const bf16_t*)(ws + O_F) : nullptr;
      float* outF32 = (kind == G_FFN1_D) ? nullptr : P.out;
      bf16_t* outB = (kind == G_FFN2_D) ? nullptr : (bf16_t*)(ws + O_ACTB);
      bf16_t* outF = (kind == G_FFN1_D && !meta) ? (bf16_t*)(ws + O_F) : nullptr;
      const float scale = (kind == G_OUT) ? 1.f : 0.5f;
      float* st = (kind == G_FFN1_D) ? (float*)(ws + O_ST1) : (kind == G_OUT ? (float*)(ws + O_ST2) : nullptr);
#pragma unroll
      for (int ai = 0; ai < 2; ++ai)
#pragma unroll
        for (int m = 0; m < 4; ++m) {
          const int r = ai * 128 + wr * 64 + m * 16 + fr;
          if (meta && (r < 48 || r >= 64)) continue;
          const size_t prow = arow0 + r, nrow = nrow0 + r;
          const float* rp = meta ? (P.meta + (size_t)(r - 48) * 2048) : (resA + nrow * 2048);
          float ss = 0.f;
#pragma unroll
          for (int bj = 0; bj < 2; ++bj)
#pragma unroll
            for (int n = 0; n < 2; ++n) {
              const int col = pn * 256 + bj * 128 + wc * 32 + n * 16 + fq * 4;
              f32x4 res = *(const f32x4*)(rp + col);
              if (resF) res += load_bf4(resF + prow * 2048 + col);
              const f32x4 d = acc[ai][bj][m][n] * scale, v = res + d;
              if (outF32) *(f32x4*)(outF32 + nrow * 2048 + col) = v;
              if (outB) store_bf4(outB + prow * 2048 + col, v);
              if (outF) store_bf4(outF + prow * 2048 + col, d);
              ss += v[0] * v[0] + v[1] * v[1] + v[2] * v[2] + v[3] * v[3];
            }
          ss += __shfl_xor(ss, 16); ss += __shfl_xor(ss, 32);
          if (fq == 0 && st) st[prow * 32 + pn * 4 + wc] = ss;
          asm volatile("" ::: "memory"); SCHED;
        }
    } else if (kind == G_MERGE) {
      const bf16_t* gB = (const bf16_t*)P.out + (size_t)TR * 2048;
      bf16_t* mo = (bf16_t*)(ws + O_MRG);
#pragma unroll
      for (int ai = 0; ai < 2; ++ai)
#pragma unroll
        for (int m = 0; m < 4; ++m) {
          const int r = ai * 128 + wr * 64 + m * 16 + fr;
          const size_t prow = arow0 + r, nrow = nrow0 + r;
#pragma unroll
          for (int bj = 0; bj < 2; ++bj)
#pragma unroll
            for (int n = 0; n < 2; ++n) {
              const int col = pn * 256 + bj * 128 + wc * 32 + n * 16 + fq * 4;
              f32x4 b4 = load_bf4(gB + nrow * 2048 + col), v;
#pragma unroll
              for (int j = 0; j < 4; ++j) v[j] = acc[ai][bj][m][n][j] / (1.f + __expf(-fminf(fmaxf(b4[j], -40.f), 40.f)));
              store_bf4(mo + prow * 2048 + col, v);
            }
          asm volatile("" ::: "memory"); SCHED;
        }
    } else {
      const float* rsl = (const float*)shm_raw;
      bf16_t* dst; int ld, c0; bool natural = false, isLow = false;
      if (pn < 4) { dst = (bf16_t*)(ws + O_GQ); ld = 1024; c0 = pn * 256; }
      else if (pn < 8) { dst = (bf16_t*)(ws + O_GK); ld = 1024; c0 = (pn - 4) * 256; }
      else if (pn < 16) { dst = (bf16_t*)(ws + O_GV); ld = 2048; c0 = (pn - 8) * 256; }
      else if (pn < 24) { dst = (bf16_t*)(ws + O_GR); ld = 2048; c0 = (pn - 16) * 256; }
      else if (pn == 24) { dst = nullptr; ld = 32; c0 = 0; isLow = true; }
      else if (pn < 33) { dst = (bf16_t*)(ws + O_DQ); ld = 2048; c0 = (pn - 25) * 256; }
      else if (pn < 41) { dst = (bf16_t*)(ws + O_DK); ld = 2048; c0 = (pn - 33) * 256; }
      else if (pn < 49) { dst = (bf16_t*)(ws + O_DV); ld = 2048; c0 = (pn - 41) * 256; }
      else if (pn < 57) { dst = (bf16_t*)P.out; ld = 2048; c0 = (pn - 49) * 256; natural = true; }
      else { dst = (bf16_t*)P.out + (size_t)TR * 2048; ld = 2048; c0 = (pn - 57) * 256; natural = true; }
      float* low = (float*)(ws + O_LOW);
      bool single = false;
      if (meta && pn >= 25) { single = true; if (pn >= 33 && pn < 41) dst = (bf16_t*)(ws + O_DKM); else if (pn >= 41 && pn < 49) dst = (bf16_t*)(ws + O_DVM); else natural = true; }
      if (!(meta && natural)) {
#pragma unroll
        for (int ai = 0; ai < 2; ++ai)
#pragma unroll
          for (int m = 0; m < 4; ++m) {
            const int r = ai * 128 + wr * 64 + m * 16 + fr;
            if (meta && r >= 64) continue;
            const size_t prow = arow0 + r, nrow = nrow0 + r;
            const float rs = rsl[r];
            const bool zero = meta && r < 48;
#pragma unroll
            for (int bj = 0; bj < 2; ++bj)
#pragma unroll
              for (int n = 0; n < 2; ++n) {
                const int cc = bj * 128 + wc * 32 + n * 16 + fq * 4;
                f32x4 v = acc[ai][bj][m][n] * rs;
                if (zero) v = (f32x4){0.f, 0.f, 0.f, 0.f};
                if (isLow) {
                  if (cc < 32) { if (meta) { for (int b4 = 0; b4 < 4; ++b4) *(f32x4*)(low + (size_t)(b4 * LP + r) * 32 + cc) = v; } else *(f32x4*)(low + prow * 32 + cc) = v; }
                } else if (single) {
                  store_bf4(dst + (size_t)r * ld + c0 + cc, v);
                } else if (meta) {
                  for (int b4 = 0; b4 < 4; ++b4) store_bf4(dst + (size_t)(b4 * LP + r) * ld + c0 + cc, v);
                } else {
                  store_bf4(dst + (natural ? nrow : prow) * ld + c0 + cc, v);
                }
              }
            asm volatile("" ::: "memory"); SCHED;
          }
      }
    }
    asm volatile("s_waitcnt vmcnt(0)" ::: "memory");
    __syncthreads();
  }
}

DEV void transpose_tile(const float* __restrict__ src, int K, int N, bf16_t* __restrict__ dst, const float* __restrict__ gain, bool winmap, int tk, int tn) {
  const int tid = threadIdx.x;
  bf16_t* T = shm;
  const int k0 = tk * 128, n0 = tn * 128;
  __syncthreads();
#pragma unroll
  for (int i = 0; i < 8; ++i) {
    const int kr = i * 16 + (tid >> 5), nc = (tid & 31) * 4;
    f32x4 v = (f32x4){0.f, 0.f, 0.f, 0.f};
    if (n0 + nc < N) v = *(const f32x4*)(src + (size_t)(k0 + kr) * N + n0 + nc);
    if (gain) v = v * gain[k0 + kr];
    unsigned* tp = (unsigned*)(T + kr * 130 + nc);
    tp[0] = pk2(v[0], v[1]); tp[1] = pk2(v[2], v[3]);
  }
  __syncthreads();
  const int nr = tid >> 2, n = n0 + nr;
  if (n < N) {
    const int drow = winmap ? (n < 6176 ? n : n + 224) : n;
#pragma unroll
    for (int q = 0; q < 4; ++q) {
      const int kk = (tid & 3) * 8 + q * 32;
      unsigned short e[8];
#pragma unroll
      for (int i = 0; i < 8; ++i) e[i] = T[(kk + i) * 130 + nr];
      u32x4 w; w.x = e[0] | ((unsigned)e[1] << 16); w.y = e[2] | ((unsigned)e[3] << 16); w.z = e[4] | ((unsigned)e[5] << 16); w.w = e[6] | ((unsigned)e[7] << 16);
      *(u32x4*)(dst + (size_t)drow * K + k0 + kk) = w;
    }
  }
}

DEV void transpose_job(const float* src, int K, int N, bf16_t* dst, const float* gain, bool winmap, int& tbase, int& t) {
  const int ntn = (N + 127) / 128, nt = (K / 128) * ntn;
  while (t < tbase + nt) { const int l = t - tbase; transpose_tile(src, K, N, dst, gain, winmap, l / ntn, l % ntn); t += gridDim.x; }
  tbase += nt;
}

DEV void phase_prologue(const Params& P) {
  unsigned char* ws = P.ws;
  const int tid = threadIdx.x, gtid = blockIdx.x * NTHR + tid, gsz = gridDim.x * NTHR;
  { u32x4* z = (u32x4*)((bf16_t*)(ws + O_WIN) + (size_t)6176 * 2048); const int nz = 224 * 2048 / 8;
    for (int i = gtid; i < nz; i += gsz) z[i] = (u32x4){0u, 0u, 0u, 0u}; }
  { const int gw = (blockIdx.x * NTHR + tid) >> 6, nw = gsz >> 6, lane = tid & 63;
    bf16_t* xb = (bf16_t*)(ws + O_ACTB); float* st0 = (float*)(ws + O_ST);
    for (int r = gw; r < TR + 16; r += nw) {
      const float* src; size_t prow;
      if (r < TR) { src = P.x + (size_t)r * 2048; prow = (size_t)(r >> 12) * LP + 64 + (r & 4095); } else { src = P.meta + (size_t)(r - TR) * 2048; prow = 48 + (r - TR); }
      float ss = 0.f;
#pragma unroll
      for (int i = 0; i < 8; ++i) { const int c = i * 256 + lane * 4; f32x4 v = *(const f32x4*)(src + c); ss += v[0] * v[0] + v[1] * v[1] + v[2] * v[2] + v[3] * v[3]; store_bf4(xb + prow * 2048 + c, v); }
#pragma unroll
      for (int o = 32; o >= 1; o >>= 1) ss += __shfl_xor(ss, o);
      if (lane == 0) st0[prow] = ss;
    } }
  int tbase = 0, t = blockIdx.x;
  bf16_t* wf = (bf16_t*)(ws + O_WF); bf16_t* wsq = (bf16_t*)(ws + O_WS);
  transpose_job(P.w1g, 2048, DFF, wf + (size_t)DFF * 2048, P.n1, false, tbase, t);
  transpose_job(P.w1u, 2048, DFF, wf + (size_t)2 * DFF * 2048, P.n1, false, tbase, t);
  transpose_job(P.w1d, DFF, 2048, wf, nullptr, false, tbase, t);
  transpose_job(P.win, 2048, INW, (bf16_t*)(ws + O_WIN), P.nmix, true, tbase, t);
  transpose_job(P.wbg, 2048, 2048, wsq, nullptr, false, tbase, t);
  transpose_job(P.wbd, 2048, 2048, wsq + (size_t)2048 * 2048, nullptr, false, tbase, t);
  transpose_job(P.wout, 2048, 2048, wsq + (size_t)2 * 2048 * 2048, nullptr, false, tbase, t);
}

DEV f32x4 mfma16(bf16x8 a, bf16x8 b, f32x4 c) { return __builtin_amdgcn_mfma_f32_16x16x32_bf16(a, b, c, 0, 0, 0); }
#define LD8(p) (*reinterpret_cast<const bf16x8*>(p))

DEV void gla_prep_unit(const Params& P, int u, bool dummy = false) {
  unsigned char* ws = P.ws;
  const bool st_ok = !dummy || (P.ws == nullptr);
  int tid = threadIdx.x; asm volatile("" : "+v"(tid));
  const int w = tid >> 6, lane = tid & 63, fr = lane & 15, fq = lane >> 4;
  const int c = u % 65, bh = u / 65, b = bh >> 2, h = bh & 3;
  bf16_t* QD0 = shm; bf16_t* KI0 = QD0 + 64 * 264; bf16_t* QD1 = KI0 + 64 * 264; bf16_t* KI1 = QD1 + 64 * 264;
  float* LOWs = (float*)(KI1 + 64 * 264);
  bf16_t* gq = (bf16_t*)(ws + O_GQ); bf16_t* gk = (bf16_t*)(ws + O_GK);
  const size_t prow0 = (size_t)b * LP + c * 64;
  const int dir = tid >> 8, k = tid & 255, col = h * 256 + k;
  unsigned qk[64];
#pragma unroll
  for (int tt = 0; tt < 64; ++tt) { const int t = dir ? 63 - tt : tt; qk[tt] = (unsigned)gq[(prow0 + t) * 1024 + col] | ((unsigned)gk[(prow0 + t) * 1024 + col] << 16); }
  __syncthreads();
  { const int idx = tid * 4, row = idx >> 5, cl = idx & 31;
    *(f32x4*)(LOWs + idx) = *(const f32x4*)((const float*)(ws + O_LOW) + (prow0 + row) * 32 + cl); }
  __syncthreads();
  {
    const float* wa2 = dir ? P.wa2b : P.wa2f;
    float wv[16];
#pragma unroll
    for (int r = 0; r < 16; ++r) wv[r] = wa2[r * 1024 + col];
    const float bias = (dir ? P.bab : P.baf)[col];
    bf16_t* QD = dir ? QD1 : QD0; bf16_t* KI = dir ? KI1 : KI0;
    float bc = 0.f;
#pragma unroll
    for (int tt = 0; tt < 64; ++tt) {
      const int t = dir ? 63 - tt : tt;
      const f32x4* lr = (const f32x4*)(LOWs + t * 32 + dir * 16);
      const f32x4 l0 = lr[0], l1 = lr[1], l2 = lr[2], l3 = lr[3];
      float z = bias;
#pragma unroll
      for (int r = 0; r < 4; ++r) { z = fmaf(l0[r], wv[r], z); z = fmaf(l1[r], wv[4 + r], z); z = fmaf(l2[r], wv[8 + r], z); z = fmaf(l3[r], wv[12 + r], z); }
      const float ls = fminf(z, 0.f) - __logf(1.f + __expf(-fabsf(z)));
      const bool valid = !(c == 0 && t < 48);
      bc += valid ? ls * 0.0625f : 0.f;
      const float e = __expf(bc), ei = __expf(-bc);
      QD[t * 264 + k] = f2bf(__uint_as_float(qk[tt] << 16) * e * 0.0625f);
      KI[t * 264 + k] = f2bf(__uint_as_float(qk[tt] & 0xffff0000u) * ei);
    }
    if (st_ok) ((float*)(ws + O_DL))[((size_t)(bh * 2 + dir) * 65 + c) * 256 + k] = __expf(bc);
  }
  __syncthreads();
  if (c >= 1) {
    const int d = w >> 2, ti = w & 3;
    const bf16_t* QD = d ? QD1 : QD0; const bf16_t* KI = d ? KI1 : KI0;
    bf16_t* Pg = (bf16_t*)(ws + O_P) + (size_t)u * 4096;
#pragma unroll
    for (int tj = 0; tj < 4; ++tj) {
      f32x4 a4 = (f32x4){0.f, 0.f, 0.f, 0.f};
#pragma unroll
      for (int kk = 0; kk < 8; ++kk) a4 = mfma16(LD8(QD + (ti * 16 + fr) * 264 + kk * 32 + fq * 8), LD8(KI + (tj * 16 + fr) * 264 + kk * 32 + fq * 8), a4);
#pragma unroll
      for (int r = 0; r < 4; ++r) { const int i = ti * 16 + fq * 4 + r, j = tj * 16 + fr; const bool keep = d ? (j > i) : (j <= i); if (keep && st_ok) Pg[i * 64 + j] = f2bf(a4[r]); }
    }
  }
  bf16_t* qdb = (bf16_t*)(ws + O_QDB); bf16_t* kib = (bf16_t*)(ws + O_KIB);
#pragma unroll
  for (int i = 0; i < 4; ++i) {
    const int p = tid + 512 * i, tok = p >> 5, kc = (p & 31) * 8;
    const size_t g = (prow0 + tok) * 1024 + h * 256 + kc;
    if (st_ok) { *(u32x4*)(gq + g) = *(const u32x4*)(QD0 + tok * 264 + kc);
    *(u32x4*)(qdb + g) = *(const u32x4*)(QD1 + tok * 264 + kc); }
  }
  {
    const bf16_t* KI = dir ? KI1 : KI0;
    bf16_t* dst = (dir ? kib : gk) + (prow0 + (k >> 2)) * 1024 + h * 256 + (k & 3) * 64;
#pragma unroll
    for (int q = 0; q < 8; ++q) {
      unsigned e[8];
#pragma unroll
      for (int i = 0; i < 8; ++i) e[i] = KI[(q * 8 + i) * 264 + k];
      u32x4 wv4; wv4.x = e[0] | (e[1] << 16); wv4.y = e[2] | (e[3] << 16); wv4.z = e[4] | (e[5] << 16); wv4.w = e[6] | (e[7] << 16);
      if (st_ok) *(u32x4*)(dst + q * 8) = wv4;
    }
  }
  __syncthreads();
  bf16_t* gv = (bf16_t*)(ws + O_GV);
  bf16_t* VN = shm;
#pragma unroll
  for (int q = 0; q < 8; ++q) {
    const int p = tid + 512 * q, tok = p >> 6, vc = (p & 63) * 8;
    *(u32x4*)(VN + tok * 520 + vc) = *(const u32x4*)(gv + (prow0 + tok) * 2048 + h * 512 + vc);
  }
  __syncthreads();
  {
    const int v = tid;
    bf16_t* dst = gv + (prow0 + (v >> 3)) * 2048 + h * 512 + (v & 7) * 64;
#pragma unroll
    for (int q = 0; q < 8; ++q) {
      unsigned e[8];
#pragma unroll
      for (int i = 0; i < 8; ++i) e[i] = VN[(q * 8 + i) * 520 + v];
      u32x4 wv4; wv4.x = e[0] | (e[1] << 16); wv4.y = e[2] | (e[3] << 16); wv4.z = e[4] | (e[5] << 16); wv4.w = e[6] | (e[7] << 16);
      if (st_ok) *(u32x4*)(dst + q * 8) = wv4;
    }
  }
}

DEV void gla_scan_unit(const Params& P, int u) {
  unsigned char* ws = P.ws;
  int tid = threadIdx.x; asm volatile("" : "+v"(tid));
  const int w = tid >> 6, lane = tid & 63, fr = lane & 15, fq = lane >> 4;
  const int b = u >> 6, h = (u >> 4) & 3, dir = (u >> 3) & 1, sl = u & 7;
  bf16_t* QDs = shm;
  bf16_t* KIT = QDs + 64 * 264;
  bf16_t* VT = KIT + 256 * 72;
  bf16_t* SBs = VT + 64 * 72;
  const bf16_t* qsrc = (const bf16_t*)(ws + (dir ? O_QDB : O_GQ));
  const bf16_t* ksrc = (const bf16_t*)(ws + (dir ? O_KIB : O_GK));
  const bf16_t* vsrc = (const bf16_t*)(ws + O_GV);
  const float* dlp = (const float*)(ws + O_DL) + (size_t)((b * 4 + h) * 2 + dir) * 65 * 256;
  bf16_t* osrc = (bf16_t*)P.out + (size_t)dir * TR * 2048;
  f32x4 S[2][4];
#pragma unroll
  for (int a = 0; a < 4; ++a) { S[0][a] = (f32x4){0.f, 0.f, 0.f, 0.f}; S[1][a] = (f32x4){0.f, 0.f, 0.f, 0.f}; }
  u32x4 rq[4], rk[4], rv; f32x4 rdl0, rdl1;
  const int nsteps = dir ? 64 : 65;
#define SCAN_LOAD(cc) do { const size_t pr0 = (size_t)b * LP + (cc) * 64; \
    _Pragma("unroll") for (int i = 0; i < 4; ++i) { const int p = tid + 512 * i; \
      { const int tok = p >> 5, kc = (p & 31) * 8; rq[i] = *(const u32x4*)(qsrc + (pr0 + tok) * 1024 + h * 256 + kc); } \
      { const int kr = p >> 3, tc = (p & 7) * 8; rk[i] = *(const u32x4*)(ksrc + (pr0 + (kr >> 2)) * 1024 + h * 256 + (kr & 3) * 64 + tc); } } \
    { const int vv = sl * 64 + (tid >> 3), tc = (tid & 7) * 8; rv = *(const u32x4*)(vsrc + (pr0 + (vv >> 3)) * 2048 + h * 512 + (vv & 7) * 64 + tc); } \
    rdl0 = *(const f32x4*)(dlp + (cc) * 256 + (2 * w) * 16 + fq * 4); rdl1 = *(const f32x4*)(dlp + (cc) * 256 + (2 * w + 1) * 16 + fq * 4); } while (0)
  SCAN_LOAD(dir ? 64 : 0);
  for (int s = 0; s < nsteps; ++s) {
    const int c = dir ? 64 - s : s;
    const bool do_o = dir ? true : (c >= 1), do_upd = dir ? (c >= 2) : (c <= 63);
    __syncthreads();
#pragma unroll
    for (int i = 0; i < 4; ++i) {
      const int p = tid + 512 * i;
      *(u32x4*)(QDs + (p >> 5) * 264 + (p & 31) * 8) = rq[i];
      *(u32x4*)(KIT + (p >> 3) * 72 + (p & 7) * 8) = rk[i];
    }
    *(u32x4*)(VT + (tid >> 3) * 72 + (tid & 7) * 8) = rv;
#pragma unroll
    for (int vt = 0; vt < 4; ++vt)
#pragma unroll
      for (int kt = 0; kt < 2; ++kt) {
        u32x2 pw; pw.x = pk2(S[kt][vt][0], S[kt][vt][1]); pw.y = pk2(S[kt][vt][2], S[kt][vt][3]);
        *(u32x2*)(SBs + (vt * 16 + fr) * 264 + (2 * w + kt) * 16 + fq * 4) = pw;
      }
    const f32x4 dl0 = rdl0, dl1 = rdl1;
    __syncthreads();
    if (s + 1 < nsteps) SCAN_LOAD(dir ? 64 - (s + 1) : s + 1);
    if (do_o) {
      const int ti = w >> 1;
#pragma unroll
      for (int jj = 0; jj < 2; ++jj) {
        const int tj = (w & 1) * 2 + jj;
        f32x4 a4 = (f32x4){0.f, 0.f, 0.f, 0.f};
#pragma unroll
        for (int kk = 0; kk < 8; ++kk) a4 = mfma16(LD8(SBs + (tj * 16 + fr) * 264 + kk * 32 + fq * 8), LD8(QDs + (ti * 16 + fr) * 264 + kk * 32 + fq * 8), a4);
        const size_t nrow = (size_t)b * SEQ + (c - 1) * 64 + ti * 16 + fr;
        store_bf4(osrc + nrow * 2048 + h * 512 + sl * 64 + tj * 16 + fq * 4, a4);
      }
    }
    if (do_upd) {
#pragma unroll
      for (int kt = 0; kt < 2; ++kt)
#pragma unroll
        for (int vt = 0; vt < 4; ++vt) {
#pragma unroll
          for (int kk = 0; kk < 2; ++kk) S[kt][vt] = mfma16(LD8(KIT + ((2 * w + kt) * 16 + fr) * 72 + kk * 32 + fq * 8), LD8(VT + (vt * 16 + fr) * 72 + kk * 32 + fq * 8), S[kt][vt]);
          S[kt][vt] = S[kt][vt] * (kt ? dl1 : dl0);
        }
    }
  }
#undef SCAN_LOAD
}

DEV void gla_finish_unit(const Params& P, int u, bool dummy = false) {
  unsigned char* ws = P.ws;
  const bool st_ok = !dummy || (P.ws == nullptr);
  int tid = threadIdx.x; asm volatile("" : "+v"(tid));
  const int w = tid >> 6, lane = tid & 63, fr = lane & 15, fq = lane >> 4;
  const int c = (u & 63) + 1, bh = u >> 6, b = bh >> 2, h = bh & 3;
  bf16_t* VTf = shm;
  bf16_t* Pl = VTf + 512 * 72;
  float* red = (float*)(Pl + 64 * 72);
  const size_t prow0 = (size_t)b * LP + c * 64, nrow0 = (size_t)b * SEQ + (c - 1) * 64;
  const bf16_t* gv = (const bf16_t*)(ws + O_GV);
  __syncthreads();
  { const int i = tid >> 3, j0 = (tid & 7) * 8;
    *(u32x4*)(Pl + i * 72 + j0) = *(const u32x4*)((const bf16_t*)(ws + O_P) + (size_t)(bh * 65 + c) * 4096 + i * 64 + j0); }
#pragma unroll
  for (int q = 0; q < 8; ++q) {
    const int p = tid + 512 * q, v = p >> 3, tc = (p & 7) * 8;
    *(u32x4*)(VTf + v * 72 + tc) = *(const u32x4*)(gv + (prow0 + (v >> 3)) * 2048 + h * 512 + (v & 7) * 64 + tc);
  }
  __syncthreads();
  f32x4 acc[4][4];
  const bf16_t* of = (const bf16_t*)P.out; const bf16_t* ob = of + (size_t)TR * 2048;
  float ss[4] = {0.f, 0.f, 0.f, 0.f};
#pragma unroll
  for (int vt = 0; vt < 4; ++vt)
#pragma unroll
    for (int it = 0; it < 4; ++it) {
      f32x4 a4 = (f32x4){0.f, 0.f, 0.f, 0.f};
#pragma unroll
      for (int kk = 0; kk < 2; ++kk) a4 = mfma16(LD8(VTf + (w * 64 + vt * 16 + fr) * 72 + kk * 32 + fq * 8), LD8(Pl + (it * 16 + fr) * 72 + kk * 32 + fq * 8), a4);
      const size_t g = (nrow0 + it * 16 + fr) * 2048 + h * 512 + w * 64 + vt * 16 + fq * 4;
      a4 = a4 + load_bf4(of + g) + load_bf4(ob + g);
      acc[vt][it] = a4;
      ss[it] += a4[0] * a4[0] + a4[1] * a4[1] + a4[2] * a4[2] + a4[3] * a4[3];
    }
#pragma unroll
  for (int it = 0; it < 4; ++it) { float s2 = ss[it]; s2 += __shfl_xor(s2, 16); s2 += __shfl_xor(s2, 32); if (fq == 0) red[w * 64 + it * 16 + fr] = s2; }
  __syncthreads();
  bf16_t* gr = (bf16_t*)(ws + O_GR);
#pragma unroll
  for (int it = 0; it < 4; ++it) {
    float tot = 0.f;
#pragma unroll
    for (int ww = 0; ww < 8; ++ww) tot += red[ww * 64 + it * 16 + fr];
    const float rs = rsqrtf(tot * (1.f / 512.f) + EPS);
#pragma unroll
    for (int vt = 0; vt < 4; ++vt) {
      const int vcol = w * 64 + vt * 16 + fq * 4;
      bf16_t* gp = gr + (prow0 + it * 16 + fr) * 2048 + h * 512 + vcol;
      const f32x4 g4 = load_bf4(gp), nw = *(const f32x4*)(P.gnorm + vcol);
      f32x4 y;
#pragma unroll
      for (int j = 0; j < 4; ++j) y[j] = acc[vt][it][j] * rs * nw[j] * (g4[j] * sigm(g4[j]));
      if (st_ok) store_bf4(gp, y);
    }
  }
}

constexpr int QBLK = 32, KVBLK = 64;
constexpr float ASCALE = 0.088388347648318440f;
constexpr float ATHR = 8.f;
constexpr int LDA_ = 2048;
constexpr size_t SHM_V = KVBLK * 128 * 2, SHM_K = KVBLK * 128 * 2, SHM_ATTN = 2 * SHM_V + 2 * SHM_K + 8 * 64 * 4;
#define KSWZ(row, colB) ((row) * 256 + ((colB) ^ (((row) & 7) << 4)))
#define SBAR() __builtin_amdgcn_sched_barrier(0)
DEV int crow(int r, int hi) { return (r & 3) + 8 * (r >> 2) + 4 * hi; }

template <int MODE> DEV void alibi(f32x16& p0, f32x16& p1, float base, float nslope) {
#pragma unroll
  for (int r = 0; r < 16; ++r) {
    const float cc = (float)((r & 3) + 8 * (r >> 2));
    p0[r] = fmaf(nslope, fabsf(base - cc), p0[r]);
    p1[r] = fmaf(nslope, fabsf(base - cc - 32.f), p1[r]);
    if (MODE == 1) { p0[r] = -1e30f; if (r < 8) p1[r] = -1e30f; }
    if (MODE == 2) { p0[r] = -1e30f; p1[r] = -1e30f; }
  }
}
DEV void partialSM(f32x16& p0, f32x16& p1, float& m_reg, float& mn, float& alpha) {
  constexpr float C = ASCALE * 1.4426950408889634f;
  float pmax = p0[0];
#pragma unroll
  for (int r = 1; r < 16; ++r) pmax = fmaxf(pmax, p0[r]);
#pragma unroll
  for (int r = 0; r < 16; ++r) pmax = fmaxf(pmax, p1[r]);
  { auto rr = __builtin_amdgcn_permlane32_swap(__float_as_uint(pmax), __float_as_uint(pmax), false, false);
    pmax = fmaxf(__uint_as_float(rr[0]), __uint_as_float(rr[1])); }
  if (__builtin_expect(__all(pmax - m_reg <= ATHR / ASCALE), 1)) { mn = m_reg; alpha = 1.f; }
  else { mn = fmaxf(m_reg, pmax); alpha = __builtin_amdgcn_exp2f((m_reg - mn) * C); m_reg = mn; }
  const float mnC = -mn * C;
#pragma unroll
  for (int r = 0; r < 16; ++r) p0[r] = fmaf(p0[r], C, mnC);
#pragma unroll
  for (int r = 0; r < 16; ++r) p1[r] = fmaf(p1[r], C, mnC);
#pragma unroll
  for (int r = 0; r < 16; ++r) p0[r] = __builtin_amdgcn_exp2f(p0[r]);
}
DEV void finishSM(f32x16& p0, f32x16& p1, float alpha, float& l_reg, bf16x8& pa0, bf16x8& pa1, bf16x8& pa2, bf16x8& pa3) {
#pragma unroll
  for (int r = 0; r < 16; ++r) p1[r] = __builtin_amdgcn_exp2f(p1[r]);
  float ps = 0;
#pragma unroll
  for (int r = 0; r < 16; ++r) ps += p0[r];
#pragma unroll
  for (int r = 0; r < 16; ++r) ps += p1[r];
  { auto rr = __builtin_amdgcn_permlane32_swap(__float_as_uint(ps), __float_as_uint(ps), false, false);
    ps = __uint_as_float(rr[0]) + __uint_as_float(rr[1]); }
  l_reg = l_reg * alpha + ps;
#define PK4(P_, BASE, OUT) do { unsigned a0 = pk2(P_[BASE + 0], P_[BASE + 1]), a1 = pk2(P_[BASE + 2], P_[BASE + 3]);   \
    unsigned b0 = pk2(P_[BASE + 4], P_[BASE + 5]), b1 = pk2(P_[BASE + 6], P_[BASE + 7]);                              \
    auto r0 = __builtin_amdgcn_permlane32_swap(a0, b0, false, false); auto r1 = __builtin_amdgcn_permlane32_swap(a1, b1, false, false); \
    u32x4 w_ = {r0[0], r1[0], r0[1], r1[1]}; OUT = *reinterpret_cast<bf16x8*>(&w_); } while (0)
  PK4(p0, 0, pa0); PK4(p0, 8, pa1); PK4(p1, 0, pa2); PK4(p1, 8, pa3);
#undef PK4
}
DEV void qkt(f32x16& p0, f32x16& p1, const bf16_t* Ks, const bf16x8* qr, int r32, int hi) {
  p0 = f32x16{}; p1 = f32x16{};
#pragma unroll
  for (int d0 = 0; d0 < 8; ++d0) { const int cb = (d0 * 16 + hi * 8) * 2;
    bf16x8 b0 = *reinterpret_cast<const bf16x8*>((const char*)Ks + KSWZ(r32, cb));
    bf16x8 b1 = *reinterpret_cast<const bf16x8*>((const char*)Ks + KSWZ(32 + r32, cb));
    p0 = __builtin_amdgcn_mfma_f32_32x32x16_bf16(b0, qr[d0], p0, 0, 0, 0);
    p1 = __builtin_amdgcn_mfma_f32_32x32x16_bf16(b1, qr[d0], p1, 0, 0, 0); }
}
DEV int v_st(int k, int c) { const int kk = (k & ~0xC) | ((k & 4) << 1) | ((k & 8) >> 1); return ((kk >> 3) * 4 + (c >> 5)) * 512 + ((kk & 7) * 32 + (c & 31)) * 2; }
DEV int v_rd_base(int lane) { return ((lane & 3) << 3) | (((lane >> 2) & 3) << 6) | (((lane >> 4) & 1) << 5) | (((lane >> 5) & 1) << 8); }
constexpr int v_rd_off(int d0, int ks, int half) { return d0 * 512 + ks * 4096 + half * 2048; }
template <int OFF> DEV s16x4 tr_read(int vb) { s16x4 r; asm volatile("ds_read_b64_tr_b16 %0, %1 offset:%2" : "=&v"(r) : "v"(vb), "i"(OFF) : "memory"); return r; }
template <int D0> DEV void pv_one(f32x16& od, int vb, bf16x8 pa0, bf16x8 pa1, bf16x8 pa2, bf16x8 pa3) {
  const s16x4 l0 = tr_read<v_rd_off(D0, 0, 0)>(vb), h0 = tr_read<v_rd_off(D0, 0, 1)>(vb), l1 = tr_read<v_rd_off(D0, 1, 0)>(vb), h1 = tr_read<v_rd_off(D0, 1, 1)>(vb);
  const s16x4 l2 = tr_read<v_rd_off(D0, 2, 0)>(vb), h2 = tr_read<v_rd_off(D0, 2, 1)>(vb), l3 = tr_read<v_rd_off(D0, 3, 0)>(vb), h3 = tr_read<v_rd_off(D0, 3, 1)>(vb);
  asm volatile("s_waitcnt lgkmcnt(0)" ::: "memory"); SBAR();
#define PK(L, H) (bf16x8){L[0], L[1], L[2], L[3], H[0], H[1], H[2], H[3]}
  od = __builtin_amdgcn_mfma_f32_32x32x16_bf16(pa0, PK(l0, h0), od, 0, 0, 0);
  od = __builtin_amdgcn_mfma_f32_32x32x16_bf16(pa1, PK(l1, h1), od, 0, 0, 0);
  od = __builtin_amdgcn_mfma_f32_32x32x16_bf16(pa2, PK(l2, h2), od, 0, 0, 0);
  od = __builtin_amdgcn_mfma_f32_32x32x16_bf16(pa3, PK(l3, h3), od, 0, 0, 0);
#undef PK
}
DEV void pv_d0(f32x16* o, int vb, bf16x8 pa0, bf16x8 pa1, bf16x8 pa2, bf16x8 pa3) {
  pv_one<0>(o[0], vb, pa0, pa1, pa2, pa3); pv_one<1>(o[1], vb, pa0, pa1, pa2, pa3); pv_one<2>(o[2], vb, pa0, pa1, pa2, pa3); pv_one<3>(o[3], vb, pa0, pa1, pa2, pa3);
}

DEV void attn_body(const bf16_t* __restrict__ Qb, const bf16_t* __restrict__ Kh, const bf16_t* __restrict__ Vh, const bf16_t* __restrict__ Km, const bf16_t* __restrict__ Vm, int qrel, float nslope, float slope, float kmax2, char* lds, f32x16 (&o)[4]) {
  int tid = threadIdx.x; asm volatile("" : "+v"(tid));
  const int wid = __builtin_amdgcn_readfirstlane(tid >> 6), lane = tid & 63, r32 = lane & 31, hi = lane >> 5;
  bf16_t* V_lds = (bf16_t*)lds; bf16_t* K_lds = (bf16_t*)(lds + 2 * SHM_V);
  float* wsl = (float*)(lds + 2 * SHM_V + 2 * SHM_K) + wid * 64; float* li_l = wsl; float* al_l = wsl + 32;
  float m_reg = -1e30f, l_reg = 0;
#pragma unroll
  for (int d = 0; d < 4; ++d) o[d] = f32x16{};
  bf16x8 qr[8];
  const bf16_t* Qw = Qb + (long)(wid * QBLK + r32) * LDA_ + hi * 8;
#pragma unroll
  for (int d0 = 0; d0 < 8; ++d0) qr[d0] = *reinterpret_cast<const bf16x8*>(Qw + d0 * 16);
  const float fbase = (float)(qrel + wid * QBLK + r32 - 4 * hi);
  const int sr = tid >> 4, sc = (tid & 15) * 8, vst0 = v_st(sr, sc), vst1 = v_st(32 + sr, sc);
  const int vb0 = (int)(uintptr_t)V_lds + v_rd_base(lane);
  struct { bf16x8 vs0, vs1, ks0, ks1; } sr_[2];
  float qn2 = 0.f;
#pragma unroll
  for (int d0 = 0; d0 < 8; ++d0)
#pragma unroll
    for (int e = 0; e < 8; ++e) { const float qv = __uint_as_float(((unsigned)(unsigned short)qr[d0][e]) << 16); qn2 = fmaf(qv, qv, qn2); }
  qn2 += __shfl_xor(qn2, 32);
#pragma unroll
  for (int of = 16; of >= 1; of >>= 1) qn2 = fmaxf(qn2, __shfl_xor(qn2, of));
  __syncthreads();
  if (lane == 0) wsl[0] = qn2;
  __syncthreads();
  { const float* w0 = (const float*)(lds + 2 * SHM_V + 2 * SHM_K); float mq = w0[0];
#pragma unroll
    for (int ww = 1; ww < 8; ++ww) mq = fmaxf(mq, w0[ww * 64]);
    qn2 = mq; }
  const float bnd = 2.f * ASCALE * sqrtf(qn2 * kmax2) * 1.02f + 1e-3f;
  const float dskip = fminf((104.f + bnd) / slope, 1e6f);
  int jlo = (int)ceilf(((float)(qrel - 63) - dskip) * (1.f / 64.f)); jlo = jlo < 0 ? 0 : jlo;
  int jhi = (int)floorf(((float)(qrel + 255) + dskip) * (1.f / 64.f)); jhi = jhi > 64 ? 64 : jhi;
  jlo = __builtin_amdgcn_readfirstlane(jlo); jhi = __builtin_amdgcn_readfirstlane(jhi);
  const int ntl = jhi - jlo + 1, NT = ntl + (ntl & 1);
#define TIDX(r) ((r) < ntl ? jlo + (r) : 65)
#define TCL(j) ((j) < 64 ? (j) : 64)
#define SLOAD(i, jt) do { const long k0_ = (long)TCL(jt) * KVBLK; const bf16_t* Vt_ = (jt) == 0 ? Vm : Vh; const bf16_t* Kt_ = (jt) == 0 ? Km : Kh; \
    sr_[i].vs0 = *reinterpret_cast<const bf16x8*>(&Vt_[(k0_ + sr) * LDA_ + sc]); sr_[i].vs1 = *reinterpret_cast<const bf16x8*>(&Vt_[(k0_ + 32 + sr) * LDA_ + sc]); \
    sr_[i].ks0 = *reinterpret_cast<const bf16x8*>(&Kt_[(k0_ + sr) * LDA_ + sc]); sr_[i].ks1 = *reinterpret_cast<const bf16x8*>(&Kt_[(k0_ + 32 + sr) * LDA_ + sc]); } while (0)
#define SWRITE(b, i) do { *(bf16x8*)((char*)V_lds + (b) * SHM_V + vst0) = sr_[i].vs0;          \
    *(bf16x8*)((char*)V_lds + (b) * SHM_V + vst1) = sr_[i].vs1; const int kc = sc * 2;               \
    *(bf16x8*)((char*)K_lds + (b) * SHM_K + KSWZ(sr, kc)) = sr_[i].ks0;                       \
    *(bf16x8*)((char*)K_lds + (b) * SHM_K + KSWZ(32 + sr, kc)) = sr_[i].ks1; } while (0)
#define SWAIT() asm volatile("s_waitcnt vmcnt(4)" ::: "memory")
#define RESC(a) do { if (__any((a) < 1.f)) { if (hi == 0) al_l[r32] = (a); asm volatile("s_waitcnt lgkmcnt(0)" ::: "memory"); \
    _Pragma("unroll") for (int d = 0; d < 4; ++d) _Pragma("unroll") for (int r = 0; r < 16; ++r) o[d][r] *= al_l[crow(r, hi)]; } } while (0)
  f32x16 pA0, pA1, pB0, pB1; float mnA, mnB, alA, alB; bf16x8 pa0, pa1, pa2, pa3;
  constexpr int SE = 0, SO = 1;
  __syncthreads();
  SLOAD(SE, jlo); asm volatile("s_waitcnt vmcnt(0)" ::: "memory"); SWRITE(0, SE); __syncthreads();
  qkt(pA0, pA1, K_lds, qr, r32, hi);
  if (jlo == 0) alibi<1>(pA0, pA1, fbase, nslope); else alibi<0>(pA0, pA1, fbase - 64.f * (float)jlo, nslope);
  partialSM(pA0, pA1, m_reg, mnA, alA);
  SLOAD(SO, TIDX(1)); SLOAD(SE, TIDX(2));
  SWAIT(); SWRITE(1, SO); __syncthreads();
  for (int j = 1; j + 1 < NT; j += 2) {
    SBAR(); qkt(pB0, pB1, (bf16_t*)((char*)K_lds + SHM_K), qr, r32, hi); alibi<0>(pB0, pB1, fbase - 64.f * (float)(jlo + j), nslope);
    finishSM(pA0, pA1, alA, l_reg, pa0, pa1, pa2, pa3); SBAR();
    SLOAD(SO, TIDX(j + 2)); SBAR();
    pv_d0(o, vb0, pa0, pa1, pa2, pa3); partialSM(pB0, pB1, m_reg, mnB, alB);
    __syncthreads(); SWAIT(); SWRITE(0, SE);
    RESC(alB); __syncthreads();
    SBAR(); qkt(pA0, pA1, K_lds, qr, r32, hi); alibi<0>(pA0, pA1, fbase - 64.f * (float)(jlo + j + 1), nslope);
    finishSM(pB0, pB1, alB, l_reg, pa0, pa1, pa2, pa3); SBAR();
    if (j + 3 < NT) SLOAD(SE, TIDX(j + 3)); SBAR();
    pv_d0(o, vb0 + (int)SHM_V, pa0, pa1, pa2, pa3); partialSM(pA0, pA1, m_reg, mnA, alA);
    __syncthreads(); SWAIT(); SWRITE(1, SO);
    RESC(alA); __syncthreads();
  }
  SBAR(); qkt(pB0, pB1, (bf16_t*)((char*)K_lds + SHM_K), qr, r32, hi);
  if (ntl & 1) alibi<2>(pB0, pB1, fbase, nslope); else alibi<0>(pB0, pB1, fbase - 64.f * (float)jhi, nslope);
  finishSM(pA0, pA1, alA, l_reg, pa0, pa1, pa2, pa3); SBAR();
  pv_d0(o, vb0, pa0, pa1, pa2, pa3); partialSM(pB0, pB1, m_reg, mnB, alB);
  __syncthreads(); RESC(alB);
  finishSM(pB0, pB1, alB, l_reg, pa0, pa1, pa2, pa3); SBAR();
  pv_d0(o, vb0 + (int)SHM_V, pa0, pa1, pa2, pa3);
  if (hi == 0) li_l[r32] = l_reg; asm volatile("s_waitcnt lgkmcnt(0)" ::: "memory");
#pragma unroll
  for (int r = 0; r < 16; ++r) { const float rl = __builtin_amdgcn_rcpf(li_l[crow(r, hi)]);
#pragma unroll
    for (int d = 0; d < 4; ++d) o[d][r] *= rl; }
#undef SLOAD
#undef SWRITE
#undef SWAIT
#undef RESC
#undef TCL
#undef TIDX
}

DEV void attn_unit(const Params& P, int u) {
  unsigned char* ws = P.ws;
  const int tid_ = threadIdx.x, wid = __builtin_amdgcn_readfirstlane(tid_ >> 6);
  const int cc_ = u & 255, b = u >> 8, qblk = cc_ & 15, vh = (cc_ >> 4) & 1, hg = (cc_ >> 5) & 7;
  const unsigned long long tlo = 0x4712560374216530ull, thi = 0x1247035621743065ull;
  const unsigned trow = (unsigned)((hg < 4 ? tlo >> (16 * hg) : thi >> (16 * (hg - 4))) & 0xffffull);
  const int h = (int)((trow >> (4 * b)) & 7u);
  const bf16_t* dq = (const bf16_t*)(ws + O_DQ); const bf16_t* dk = (const bf16_t*)(ws + O_DK); const bf16_t* dv = (const bf16_t*)(ws + O_DV);
  const size_t brow = (size_t)b * LP; const int qrel = 64 + qblk * 256;
  const float slope = __int_as_float(0x3f800000 - ((h + 1) << 23));
  const float nslope = -slope / ASCALE;
  unsigned* stash = (unsigned*)(shm_raw + SHM_ATTN);
  f32x16 o[4];
  for (int mp = 0; mp < 2; ++mp) {
    attn_body(dq + (brow + qrel) * 2048 + h * 256 + mp * 128, dk + brow * 2048 + h * 256 + mp * 128, dv + brow * 2048 + h * 256 + vh * 128,
              (const bf16_t*)(ws + O_DKM) + h * 256 + mp * 128, (const bf16_t*)(ws + O_DVM) + h * 256 + vh * 128, qrel, nslope, slope,
              __uint_as_float(((const unsigned*)(ws + O_KMAX))[b * 16 + h * 2 + mp]), (char*)shm_raw, o);
    if (mp == 0) {
      int tid = tid_; asm volatile("" : "+v"(tid));
#pragma unroll
      for (int d = 0; d < 4; ++d)
#pragma unroll
        for (int r = 0; r < 16; r += 2) stash[(d * 8 + (r >> 1)) * 512 + tid] = pk2(o[d][r], o[d][r + 1]);
    }
  }
  int tid = tid_; asm volatile("" : "+v"(tid));
  const int lane = tid & 63, r32 = lane & 31, hi = lane >> 5;
  const float lam = ((const float*)(shm_raw + DYN_LDS_MAIN + 8))[0];
  bf16_t* dd = (bf16_t*)(ws + O_DD); float* dst = (float*)(ws + O_DST);
  const size_t prow = brow + qrel + wid * 32;
  float ss[16];
#pragma unroll
  for (int r = 0; r < 16; ++r) ss[r] = 0.f;
#pragma unroll
  for (int d = 0; d < 4; ++d)
#pragma unroll
    for (int r = 0; r < 16; r += 2) {
      const unsigned s2 = stash[(d * 8 + (r >> 1)) * 512 + tid];
      const float v0 = __uint_as_float(s2 << 16) - lam * o[d][r], v1 = __uint_as_float(s2 & 0xffff0000u) - lam * o[d][r + 1];
      ss[r] += v0 * v0; ss[r + 1] += v1 * v1;
      dd[(prow + crow(r, hi)) * 2048 + h * 256 + vh * 128 + d * 32 + r32] = f2bf(v0);
      dd[(prow + crow(r + 1, hi)) * 2048 + h * 256 + vh * 128 + d * 32 + r32] = f2bf(v1);
    }
#pragma unroll
  for (int r = 0; r < 16; ++r) {
    float s = ss[r];
#pragma unroll
    for (int of = 16; of >= 1; of >>= 1) s += __shfl_xor(s, of);
    if (r32 == 0) dst[(prow + crow(r, hi)) * 16 + h * 2 + vh] = s;
  }
}

DEV void l2_sweep(const Params& P) {
  const f32x4* src = (const f32x4*)P.x + (size_t)(blockIdx.x & 63) * 131072;
  f32x4 a = (f32x4){0.f, 0.f, 0.f, 0.f};
  for (int i = threadIdx.x; i < 131072; i += NTHR) a += src[i];
  if (a[0] + a[1] + a[2] + a[3] == 123456.789f) ((float*)(P.ws + O_DST))[0] = 1.f;
}
#define XB_TMO      128
#define XB_XCNT(j)  (256  + 64 * (j))
#define XB_XSUB(j)  (1280 + 64 * (j))
#define XB_XGEN(j)  (2304 + 64 * (j))
#define XB_TOP      3328
#define XB_TOPGEN   3392
#define XCD_BAR_WORDS 3456
#define XB_SPIN_CAP (1u << 22)
DEV unsigned xb_ld(unsigned* p) { return __hip_atomic_load(p, __ATOMIC_RELAXED, __HIP_MEMORY_SCOPE_AGENT); }
DEV unsigned xb_add(unsigned* p, unsigned v) { return __hip_atomic_fetch_add(p, v, __ATOMIC_RELAXED, __HIP_MEMORY_SCOPE_AGENT); }
DEV unsigned xb_xcc_id() { return (unsigned)__builtin_amdgcn_s_getreg((3 << 11) | 20) & 0xFu; }
#define XB_SPIN(cond, bar) do { unsigned _sp = 0; while (cond) { __builtin_amdgcn_s_sleep(1); \
    if ((++_sp & 255u) == 0u) { if (xb_ld(&(bar)[XB_TMO])) break; if (_sp > XB_SPIN_CAP) { atomicAdd(&(bar)[XB_TMO], 1u); break; } } } } while (0)
struct XcdBarrier { unsigned* bar; unsigned x; volatile LAS unsigned* st; };
DEV XcdBarrier xcd_barrier_post(unsigned* bar, volatile LAS unsigned* st) {
  XcdBarrier b; b.bar = bar; b.x = xb_xcc_id(); b.st = st;
  if (threadIdx.x == 0) (void)xb_add(&bar[XB_XCNT(b.x)], 1u);
  return b;
}
DEV void xcd_barrier_complete(unsigned* bar, unsigned x, unsigned& nloc, unsigned& nx) {
  const unsigned G = gridDim.x * gridDim.y * gridDim.z;
  unsigned sum, cnt, mine, sp = 0u;
  for (;;) {
    sum = 0u; cnt = 0u; mine = 0u;
#pragma unroll
    for (unsigned j = 0; j < 16; ++j) { const unsigned c = xb_ld(&bar[XB_XCNT(j)]); sum += c; cnt += (c > 0u) ? 1u : 0u; mine = (j == x) ? c : mine; }
    if (sum == G) break;
    __builtin_amdgcn_s_sleep(1);
    if ((++sp & 255u) == 0u) { if (xb_ld(&bar[XB_TMO])) break; if (sp > XB_SPIN_CAP) { atomicAdd(&bar[XB_TMO], 1u); break; } }
  }
  nloc = mine > 0u ? mine : 1u; nx = cnt > 0u ? cnt : 1u;
}
DEV void xcd_barrier(const XcdBarrier& b) {
  asm volatile("s_waitcnt vmcnt(0) lgkmcnt(0)" ::: "memory");
  __syncthreads();
  if (threadIdx.x == 0) {
    unsigned* bar = b.bar;
    __builtin_amdgcn_s_waitcnt(0);
    unsigned nloc = b.st[0], nx = b.st[1];
    if (nloc == 0u) { xcd_barrier_complete(bar, b.x, nloc, nx); b.st[0] = nloc; b.st[1] = nx; }
    const unsigned old = xb_add(&bar[XB_XSUB(b.x)], 1u);
    const unsigned gen = old / nloc;
    if (old + 1u == (gen + 1u) * nloc) {
      __builtin_amdgcn_fence(__ATOMIC_RELEASE, "agent");
      asm volatile("s_waitcnt vmcnt(0)" ::: "memory");
      const unsigned og = xb_add(&bar[XB_TOP], 1u);
      const unsigned tg = og / nx;
      if (og + 1u == (tg + 1u) * nx) xb_add(&bar[XB_TOPGEN], 1u);
      else XB_SPIN(xb_ld(&bar[XB_TOPGEN]) == tg, bar);
      __builtin_amdgcn_fence(__ATOMIC_ACQUIRE, "agent");
      xb_add(&bar[XB_XGEN(b.x)], 1u);
      asm volatile("s_waitcnt vmcnt(0)" ::: "memory");
    } else {
      XB_SPIN(xb_ld(&bar[XB_XGEN(b.x)]) == gen, bar);
      __builtin_amdgcn_fence(__ATOMIC_ACQUIRE, "agent");
      asm volatile("s_waitcnt vmcnt(0)" ::: "memory");
    }
  }
  __syncthreads();
}
DEV void gsync_now(const Params& P) {
  XcdBarrier b; b.bar = (unsigned*)(P.ws + O_BAR); b.x = xb_xcc_id(); b.st = (volatile LAS unsigned*)((LAS unsigned char*)shm_raw + DYN_LDS_MAIN);
  xcd_barrier(b);
}
#define gsync(g) gsync_now(P)
#ifndef REP
#define REP 0
#endif
#ifndef DBG_STOP
#define DBG_STOP 0
#endif
DEV void dbg_dump(const Params& P, size_t off, int ld = 2048) {
  const int tid = threadIdx.x, lane = tid & 63, gw = (blockIdx.x * NTHR + tid) >> 6, nw = (gridDim.x * NTHR) >> 6;
  const bf16_t* buf = (const bf16_t*)(P.ws + off);
  for (int r = gw; r < TR; r += nw) {
    const size_t prow = (size_t)(r >> 12) * LP + 64 + (r & 4095);
    for (int i = 0; i < 8; ++i) { const int c = i * 256 + lane * 4; f32x4 v = (f32x4){0.f, 0.f, 0.f, 0.f}; if (c < ld) v = load_bf4(buf + prow * ld + c); for (int j = 0; j < 4; ++j) if (!(fabsf(v[j]) < 1e30f)) v[j] = 10000.f; *(f32x4*)(P.out + (size_t)r * 2048 + c) = v; }
  }
}
#define STOP_AT(k, off) if (DBG_STOP == (k)) { dbg_dump(P, off); return; }
#define STOP_AT2(k, off) if (DBG_STOP == (k)) { dbg_dump(P, off, 1024); return; }
#ifndef ONLY
#define PH(n) true
#else
#define PH(n) ((ONLY) == (n))
#endif
__global__ void __launch_bounds__(NTHR, 2) mega(Params P) {
  cg::grid_group grid = cg::this_grid();
  unsigned char* ws = P.ws;
  volatile LAS unsigned* xst = (volatile LAS unsigned*)((LAS unsigned char*)shm_raw + DYN_LDS_MAIN);
  if (threadIdx.x == 0) { xst[0] = 0u; xst[1] = 0u; xst[2] = 0u; xst[3] = 0u; }
  __syncthreads();
  (void)xcd_barrier_post((unsigned*)(ws + O_BAR), xst);
  if (P.ws == nullptr) grid.sync();
  if (PH(0)) phase_prologue(P);
  if (REP & 4) phase_prologue(P);
  gsync(grid);
  if (PH(1)) for (int gp = G_FFN1_GU; gp <= G_WIN_META; ++gp) { gemm_phase(P, gp); if (REP & 1) gemm_phase(P, gp); gsync(grid); if (gp == G_FFN1_D) { STOP_AT(1, O_ACTB) } if (gp == G_WIN_META) { STOP_AT(6, O_GV) } }
  if (PH(2)) for (int u = blockIdx.x; u < 16 * 65; u += gridDim.x) gla_prep_unit(P, u);
  if (REP & 32) for (int u = blockIdx.x; u < 16 * 65; u += gridDim.x) gla_prep_unit(P, u, true);
  gsync(grid);
  STOP_AT2(7, O_KIB)
  STOP_AT2(10, O_QDB)
  if (DBG_STOP == 11) {
    const int tid = threadIdx.x, lane = tid & 63, gw = (blockIdx.x * NTHR + tid) >> 6, nw = (gridDim.x * NTHR) >> 6;
    const bf16_t* b0 = (const bf16_t*)(ws + O_GK); const bf16_t* b1 = (const bf16_t*)(ws + O_GV); const float* dl = (const float*)(ws + O_DL);
    for (int r = gw; r < TR; r += nw) { const size_t prow = (size_t)(r >> 6) * LP + (r & 63);
      for (int i = 0; i < 8; ++i) { const int c = i * 256 + lane * 4; f32x4 v = (f32x4){0.f, 0.f, 0.f, 0.f};
        if (r < 256) v = c < 1024 ? load_bf4(b0 + prow * 1024 + c) : load_bf4(b1 + prow * 2048 + c - 1024);
        else if (r < 272 && c < 256) v = *(const f32x4*)(dl + (size_t)((r - 256) * 2) * 65 * 256 + c);
        *(f32x4*)(P.out + (size_t)r * 2048 + c) = v; } }
    return;
  }
  if (DBG_STOP == 9) {
    const int tid = threadIdx.x, lane = tid & 63, gw = (blockIdx.x * NTHR + tid) >> 6, nw = (gridDim.x * NTHR) >> 6;
    const bf16_t* b0 = (const bf16_t*)(ws + O_GQ); const bf16_t* b1 = (const bf16_t*)(ws + O_GK);
    for (int r = gw; r < TR; r += nw) { const size_t prow = (size_t)(r >> 12) * LP + 64 + (r & 4095);
      for (int i = 0; i < 8; ++i) { const int c = i * 256 + lane * 4; *(f32x4*)(P.out + (size_t)r * 2048 + c) = c < 1024 ? load_bf4(b0 + prow * 1024 + c) : load_bf4(b1 + prow * 1024 + c - 1024); } }
    return;
  }
  if (PH(3)) for (int u = blockIdx.x; u < 256; u += gridDim.x) gla_scan_unit(P, u);
  if (REP & 8) for (int u = blockIdx.x; u < 256; u += gridDim.x) gla_scan_unit(P, u);
  gsync(grid);
  if (DBG_STOP == 8) {
    const int tid = threadIdx.x, lane = tid & 63, gw = (blockIdx.x * NTHR + tid) >> 6, nw = (gridDim.x * NTHR) >> 6;
    const bf16_t* of = (const bf16_t*)P.out; const bf16_t* ob = of + (size_t)TR * 2048; bf16_t* g = (bf16_t*)(ws + O_GR);
    for (int r = gw; r < TR; r += nw) { const size_t prow = (size_t)(r >> 12) * LP + 64 + (r & 4095);
      for (int i = 0; i < 8; ++i) { const int c = i * 256 + lane * 4; store_bf4(g + prow * 2048 + c, load_bf4(of + (size_t)r * 2048 + c) + load_bf4(ob + (size_t)r * 2048 + c)); } }
    gsync(grid);
    dbg_dump(P, O_GR); return;
  }
  if (PH(4)) for (int u = blockIdx.x; u < 1024; u += gridDim.x) gla_finish_unit(P, u);
  if (REP & 16) for (int u = blockIdx.x; u < 1024; u += gridDim.x) gla_finish_unit(P, u, true);
  gsync(grid);
  STOP_AT(2, O_GR)
  if (PH(1)) gemm_phase(P, G_WIN_B);
  if (REP & 1) gemm_phase(P, G_WIN_B);
  gsync(grid);
  if (PH(5)) {
    int tid = threadIdx.x; asm volatile("" : "+v"(tid)); const int lane = tid & 63;
    const int gw = (blockIdx.x * NTHR + tid) >> 6, nw = (gridDim.x * NTHR) >> 6;
    const int kb = gw & 3; const bf16_t* dk = (const bf16_t*)(ws + O_DK); const bf16_t* dkm = (const bf16_t*)(ws + O_DKM);
    unsigned* km = (unsigned*)(ws + O_KMAX);
    float mx = 0.f;
    for (int r = gw >> 2; r < SEQ + 16; r += nw >> 2) {
      const bf16_t* rowp = r < SEQ ? dk + ((size_t)kb * LP + 64 + r) * 2048 : dkm + (size_t)(48 + r - SEQ) * 2048;
      float ssq = 0.f;
#pragma unroll
      for (int i = 0; i < 8; ++i) { const f32x4 v = load_bf4(rowp + lane * 32 + i * 4); ssq += v[0] * v[0] + v[1] * v[1] + v[2] * v[2] + v[3] * v[3]; }
      ssq += __shfl_xor(ssq, 1); ssq += __shfl_xor(ssq, 2);
      mx = fmaxf(mx, ssq);
    }
    if ((lane & 3) == 0) atomicMax(km + kb * 16 + (lane >> 2), __float_as_uint(mx));
  }
  gsync(grid);
  if (PH(5)) {
    float s1 = 0.f, s2 = 0.f;
    for (int i = 0; i < 128; ++i) { s1 = fmaf(P.lq1[i], P.lk1[i], s1); s2 = fmaf(P.lq2[i], P.lk2[i], s2); }
    const float lam = __expf(s1) - __expf(s2) + 0.2f;
    { float* lw = (float*)(shm_raw + DYN_LDS_MAIN + 8); if (threadIdx.x == 0) lw[0] = lam; }
    __syncthreads();
    for (int u = blockIdx.x; u < 1024; u += gridDim.x) attn_unit(P, u);
    if (REP & 2) for (int u = blockIdx.x; u < 1024; u += gridDim.x) attn_unit(P, u);
  }
  gsync(grid);
  if (PH(6)) {
    int tid = threadIdx.x; asm volatile("" : "+v"(tid)); const int lane = tid & 63;
    const int gw = (blockIdx.x * NTHR + tid) >> 6, nw = (gridDim.x * NTHR) >> 6;
    bf16_t* dd = (bf16_t*)(ws + O_DD); const float* dst = (const float*)(ws + O_DST);
    for (int r = gw; r < TR; r += nw) {
      const size_t prow = (size_t)(r >> 12) * LP + 64 + (r & 4095);
      const int col = lane * 32, hh = col >> 8;
      const float rs = rsqrtf((dst[prow * 16 + hh * 2] + dst[prow * 16 + hh * 2 + 1]) * (1.f / 256.f) + EPS) * 0.8f;
#pragma unroll
      for (int i = 0; i < 8; ++i) { bf16_t* p = dd + prow * 2048 + col + i * 4; f32x4 v = load_bf4(p); const f32x4 nw4 = *(const f32x4*)(P.dnorm + ((col + i * 4) & 255)); v = v * nw4 * rs; store_bf4(p, v); }
    }
    int tbase = 0, t = blockIdx.x; bf16_t* wf = (bf16_t*)(ws + O_WF);
    transpose_job(P.w2g, 2048, DFF, wf + (size_t)DFF * 2048, P.n2, false, tbase, t);
    transpose_job(P.w2u, 2048, DFF, wf + (size_t)2 * DFF * 2048, P.n2, false, tbase, t);
    transpose_job(P.w2d, DFF, 2048, wf, nullptr, false, tbase, t);
  }
  gsync(grid);
  STOP_AT(3, O_DD)
  if (PH(1)) for (int gp = G_MERGE; gp <= G_FFN2_D; ++gp) { gemm_phase(P, gp); if ((REP & 1) && gp != G_FFN2_D) gemm_phase(P, gp); gsync(grid); if (gp == G_MERGE) { STOP_AT(4, O_MRG) } if (gp == G_OUT) { STOP_AT(5, O_ACTB) } }
  if (PH(7)) {
    int tid = threadIdx.x; asm volatile("" : "+v"(tid)); const int lane = tid & 63;
    const int gw = (blockIdx.x * NTHR + tid) >> 6, nw = (gridDim.x * NTHR) >> 6;
    for (int r = gw; r < TR; r += nw) {
      float* p = P.out + (size_t)r * 2048;
      f32x4 v[8]; float ss = 0.f;
#pragma unroll
      for (int i = 0; i < 8; ++i) { v[i] = *(f32x4*)(p + i * 256 + lane * 4); ss += v[i][0] * v[i][0] + v[i][1] * v[i][1] + v[i][2] * v[i][2] + v[i][3] * v[i][3]; }
#pragma unroll
      for (int o = 32; o >= 1; o >>= 1) ss += __shfl_xor(ss, o);
      const float rs = rsqrtf(ss * (1.f / 2048.f) + EPS);
#pragma unroll
      for (int i = 0; i < 8; ++i) { const int c = i * 256 + lane * 4; const f32x4 g = *(const f32x4*)(P.nfin + c); *(f32x4*)(p + c) = v[i] * g * rs; }
    }
  }
}

constexpr size_t DYN_LDS = DYN_LDS_MAIN + 16;
static_assert(DYN_LDS >= 8 * HT * 2 && DYN_LDS >= SHM_ATTN + 65536, "lds");

extern "C" void kernel_launch(void* const* d_in, const int* in_sizes, int n_in, void* d_out, int out_size, void* d_ws, size_t ws_size, hipStream_t stream) {
  if (n_in != 26 || ws_size < WS_TOTAL || out_size != TR * 2048) { fprintf(stderr, "kernel_launch: bad shapes n_in %d ws %zu need %zu out %d\n", n_in, ws_size, WS_TOTAL, out_size); return; }
  static int grid_blocks = 0;
  if (!grid_blocks) {
    hipFuncSetAttribute((const void*)mega, hipFuncAttributeMaxDynamicSharedMemorySize, (int)DYN_LDS);
    int dev = 0, cus = 0, per_cu = 0;
    hipGetDevice(&dev);
    hipDeviceGetAttribute(&cus, hipDeviceAttributeMultiprocessorCount, dev);
    hipOccupancyMaxActiveBlocksPerMultiprocessor(&per_cu, mega, NTHR, DYN_LDS);
    if (per_cu < 1) per_cu = 1;
    grid_blocks = cus;
  }
  Params p{};
  const float** pp = (const float**)&p;
  for (int i = 0; i < 26; ++i) pp[i] = (const float*)d_in[i];
  p.out = (float*)d_out; p.ws = (unsigned char*)d_ws;
  hipMemsetAsync((unsigned char*)d_ws + O_BAR, 0, 16384, stream);
  void* args[] = {&p};
  hipError_t e = hipLaunchCooperativeKernel((void*)mega, dim3(grid_blocks), dim3(NTHR), args, DYN_LDS, stream);
  if (e != hipSuccess) fprintf(stderr, "cooperative launch failed: %s (grid %d)\n", hipGetErrorString(e), grid_blocks);
}
```

```cpp
#include <hip/hip_runtime.h>
#include <hip/hip_cooperative_groups.h>
#include <stdint.h>
#include <cstdio>
namespace cg = cooperative_groups;

#define DEV __device__ __forceinline__
typedef unsigned short bf16_t;
using bf16x8 = __attribute__((ext_vector_type(8))) short;
using s16x4  = __attribute__((ext_vector_type(4))) short;
using f32x4  = __attribute__((ext_vector_type(4))) float;
using f32x16 = __attribute__((ext_vector_type(16))) float;
using u32x4  = __attribute__((ext_vector_type(4))) unsigned;
using u32x2  = __attribute__((ext_vector_type(2))) unsigned;

constexpr int DM = 2048, DFF = 5504, NB = 4, SEQ = 4096, LP = 4160, RP = NB * LP  , TR = NB * SEQ  ;
constexpr int INW = 16416;
constexpr float EPS = 1e-6f;
constexpr size_t DYN_LDS_MAIN = 4 * 64 * 264 * 2 + 64 * 32 * 4;
constexpr int NTHR = 512;

constexpr size_t SZ_ACT = (size_t)RP * 2048 * 2;
constexpr size_t SZ_HALF = (size_t)RP * 1024 * 2;
constexpr size_t SZ_SQ = (size_t)2048 * 2048 * 2;
constexpr size_t SZ_FW = (size_t)DFF * 2048 * 2;
constexpr size_t SZ_HID = (size_t)RP * DFF * 2;
constexpr size_t O_ACTB = 0;
constexpr size_t O_WIN = O_ACTB + SZ_ACT;
constexpr size_t O_WS = O_WIN + SZ_ACT;
constexpr size_t O_WF = O_WS + 3 * SZ_SQ;
constexpr size_t O_HID = O_WF + 3 * SZ_FW;
constexpr size_t O_R = O_HID + SZ_HID;
constexpr size_t O_F = O_R;
constexpr size_t O_GR = O_F + SZ_ACT;
constexpr size_t O_P = O_GR + SZ_ACT;
constexpr size_t SZ_P = (size_t)16 * 65 * 4096 * 2;
constexpr size_t O_LOW = O_P + SZ_P;
constexpr size_t O_DL = O_LOW + (size_t)RP * 32 * 4;
constexpr size_t O_ST = O_DL + (size_t)16 * 2 * 65 * 256 * 4;
constexpr size_t O_ST1 = O_ST + (size_t)RP * 4, O_ST2 = O_ST1 + (size_t)RP * 32 * 4;
constexpr size_t O_DST = O_ST2 + (size_t)RP * 32 * 4;
constexpr size_t O_DKM = O_DST + (size_t)RP * 16 * 4;
constexpr size_t O_DVM = O_DKM + (size_t)64 * 2048 * 2;
constexpr size_t O_BAR = O_DVM + (size_t)64 * 2048 * 2;
constexpr size_t O_KMAX = O_BAR + 14336;
constexpr size_t WS_TOTAL = O_BAR + 16384;
constexpr size_t O_GQ = O_WF + SZ_FW, O_GK = O_HID + (size_t)256 * DFF * 2, O_GV = O_GK + SZ_HALF, O_QDB = O_GV + SZ_ACT, O_KIB = O_QDB + SZ_HALF;
static_assert(O_GQ + SZ_HALF <= O_HID && O_KIB + SZ_HALF <= O_R, "gla overlay 2");
constexpr size_t O_DQ = O_WF, O_DK = O_DQ + SZ_ACT, O_DV = O_DK + SZ_ACT;
constexpr size_t O_MRG = O_DK;
constexpr size_t O_DD = O_WIN;
static_assert(O_DV + SZ_ACT <= O_R, "diff overlay");

struct Params {
  const float *x, *meta, *n1, *w1g, *w1u, *w1d, *nmix, *win, *wa2f, *baf, *wa2b, *bab, *gnorm,
      *lq1, *lk1, *lq2, *lk2, *dnorm, *wbg, *wbd, *wout, *n2, *w2g, *w2u, *w2d, *nfin;
  float* out;
  unsigned char* ws;
};

extern __shared__ __attribute__((aligned(16))) unsigned char shm_raw[];
#define shm ((bf16_t*)shm_raw)

DEV float bf2f(bf16_t v) { return __uint_as_float(((unsigned)v) << 16); }
typedef __bf16 bf16x2_t __attribute__((ext_vector_type(2)));
typedef float f32x2_t __attribute__((ext_vector_type(2)));
DEV unsigned pk2(float lo, float hi) { f32x2_t v = {lo, hi}; bf16x2_t b = __builtin_convertvector(v, bf16x2_t); return __builtin_bit_cast(unsigned, b); }
DEV bf16_t f2bf(float f) { return (bf16_t)(pk2(f, 0.f) & 0xffffu); }
DEV float to_sgpr(float v) { float r; asm volatile("v_readfirstlane_b32 %0, %1" : "=s"(r) : "v"(v)); return r; }
DEV float sigm(float v) { return 1.f / (1.f + __expf(-v)); }

constexpr int BM = 256, BK = 64, HALF = 128, HT = HALF * BK, NXCD = 8, WGM = 8;
DEV int lds_byte(int r, int c) { int st = (r >> 4) * 2 + (c >> 5), rr = r & 15, cc = c & 31, ob = rr * 64 + cc * 2; return st * 1024 + (ob ^ (((ob >> 9) & 1) << 5)); }
DEV void stage_rc(int b, int& R, int& C) { int st = b / 1024, sb = b % 1024, swz = sb ^ (((sb >> 9) & 1) << 5); R = (st >> 1) * 16 + swz / 64; C = (st & 1) * 32 + (swz % 64) / 2; }

#define LAS __attribute__((address_space(3)))
constexpr int HTB = HALF * BK * 2;
#define PG8_SA(b, h) (((b) * 2 + (h)) * HTB)
#define PG8_SB(b, h) ((4 + (b) * 2 + (h)) * HTB)
#define STAGE(bufoff, gbase, voff) do { _Pragma("unroll") for (int _i = 0; _i < 2; ++_i) \
    __builtin_amdgcn_global_load_lds((const unsigned*)((const char*)(gbase) + (voff)[_i]), (LAS unsigned*)(lds + (bufoff) + ldsw + _i * 8192), 16, 0, 0); } while (0)
#define LDA(dst, b, h) do { _Pragma("unroll") for (int m = 0; m < 4; ++m) _Pragma("unroll") for (int k = 0; k < 2; ++k) dst[m][k] = *(const LAS bf16x8*)(lds + PG8_SA(b, h) + aoff + m * 2048 + k * 1024); } while (0)
#define LDB(dst, b, h) do { _Pragma("unroll") for (int n = 0; n < 2; ++n) _Pragma("unroll") for (int k = 0; k < 2; ++k) dst[n][k] = *(const LAS bf16x8*)(lds + PG8_SB(b, h) + boff + n * 2048 + k * 1024); } while (0)
#define MMA(ai, bj, At_, Bt_) do { __builtin_amdgcn_s_setprio(1); \
    _Pragma("unroll") for (int m = 0; m < 4; ++m) _Pragma("unroll") for (int n = 0; n < 2; ++n) _Pragma("unroll") for (int k = 0; k < 2; ++k) \
      acc[ai][bj][m][n] = __builtin_amdgcn_mfma_f32_16x16x32_bf16(Bt_[n][k], At_[m][k], acc[ai][bj][m][n], 0, 0, 0); \
    __builtin_amdgcn_s_setprio(0); } while (0)
#define WAIT_V(n) asm volatile("s_waitcnt vmcnt(" #n ")" ::: "memory")
#define WAIT_L(n) asm volatile("s_waitcnt lgkmcnt(" #n ")" ::: "memory")
#define BAR __builtin_amdgcn_s_barrier()
#define SCHED __builtin_amdgcn_sched_barrier(0)

DEV void gemm_mainloop(const char* __restrict__ cA, const char* __restrict__ cB0, const char* __restrict__ cB1, const int K, f32x4 (&acc)[2][2][4][2]) {
  LAS unsigned char* lds = (LAS unsigned char*)shm_raw;
  int tid = threadIdx.x; asm volatile("" : "+v"(tid));
  const int wid = __builtin_amdgcn_readfirstlane(tid >> 6), lane = tid & 63, wr = wid >> 2, wc = wid & 3, fr = lane & 15, fq = lane >> 4;
  unsigned voff[2];
#pragma unroll
  for (int i = 0; i < 2; ++i) { int R, C; stage_rc(tid * 16 + i * 8192, R, C); voff[i] = (unsigned)(R * K + C) * 2u; }
  const size_t kstep = (size_t)(BK * 2), hstep = (size_t)HALF * K * 2;
  const unsigned ldsw = (unsigned)wid * 1024u;
  const int aoff = lds_byte(wr * 64 + fr, fq * 8), boff = lds_byte(wc * 32 + fr, fq * 8);
  bf16x8 At[4][2], B0[2][2], B1[2][2];
  const int nt = K / BK;
  STAGE(PG8_SB(0, 0), cB0, voff); STAGE(PG8_SB(0, 1), cB1, voff); STAGE(PG8_SA(0, 0), cA, voff); STAGE(PG8_SA(0, 1), cA + hstep, voff);
  if (wr == 1) BAR;
  WAIT_V(2); BAR;
  STAGE(PG8_SB(1, 0), cB0 + kstep, voff); STAGE(PG8_SA(1, 0), cA + kstep, voff); STAGE(PG8_SB(1, 1), cB1 + kstep, voff);
  WAIT_V(6); BAR;
  for (int t = 0; t < nt; t += 2) {
    const int t2 = (t == nt - 2) ? 0 : t + 2;
    const char* a1 = cA + (size_t)(t + 1) * kstep + hstep;
    const char* a2 = cA + (size_t)t2 * kstep; const char* b02 = cB0 + (size_t)t2 * kstep; const char* b12 = cB1 + (size_t)t2 * kstep;
    LDB(B0, 0, 0); LDB(B1, 0, 1); SCHED; LDA(At, 0, 0); STAGE(PG8_SA(1, 1), a1, voff);
    WAIT_V(8); WAIT_L(0); BAR; MMA(0, 0, At, B0); MMA(0, 1, At, B1); BAR; SCHED;
    LDA(At, 0, 1); STAGE(PG8_SB(0, 0), b02, voff); STAGE(PG8_SB(0, 1), b12, voff); STAGE(PG8_SA(0, 0), a2, voff);
    WAIT_V(8); WAIT_L(0); BAR; MMA(1, 0, At, B0); MMA(1, 1, At, B1); BAR; SCHED;
    LDB(B0, 1, 0); LDB(B1, 1, 1); SCHED; LDA(At, 1, 0); STAGE(PG8_SA(0, 1), a2 + hstep, voff);
    WAIT_V(8); WAIT_L(0); BAR; MMA(0, 0, At, B0); MMA(0, 1, At, B1); BAR; SCHED;
    LDA(At, 1, 1); STAGE(PG8_SB(1, 0), b02 + kstep, voff); STAGE(PG8_SB(1, 1), b12 + kstep, voff); STAGE(PG8_SA(1, 0), a2 + kstep, voff);
    WAIT_V(8); WAIT_L(0); BAR; MMA(1, 0, At, B0); MMA(1, 1, At, B1); BAR; SCHED;
  }
  WAIT_V(0);
  if (wr == 0) BAR;
  BAR;
}

enum { G_FFN1_GU = 0, G_FFN1_D, G_WIN_A, G_WIN_META, G_WIN_B, G_MERGE, G_OUT, G_FFN2_GU, G_FFN2_D };

DEV void store_bf4(bf16_t* p, f32x4 v) { u32x2 w; w.x = pk2(v[0], v[1]); w.y = pk2(v[2], v[3]); *(u32x2*)p = w; }
DEV f32x4 load_bf4(const bf16_t* p) { u32x2 w = *(const u32x2*)p; f32x4 v; v[0] = __uint_as_float(w.x << 16); v[1] = __uint_as_float(w.x & 0xffff0000u); v[2] = __uint_as_float(w.y << 16); v[3] = __uint_as_float(w.y & 0xffff0000u); return v; }

DEV void main_order(int L, int nN, int& pm, int& pn) {
  const int nwg = 64 * nN;
  int wgid = L; { const int q = nwg / NXCD, r = nwg % NXCD, xcd = wgid % NXCD, off = wgid / NXCD; wgid = (xcd < r ? xcd * (q + 1) : r * (q + 1) + (xcd - r) * q) + off; }
  const int nig = WGM * nN, gid = wgid / nig, fm = gid * WGM;
  pm = fm + ((wgid % nig) % WGM); pn = (wgid % nig) / WGM;
}

DEV void gemm_phase(const Params& P, const int gp) {
  int tid = threadIdx.x; asm volatile("" : "+v"(tid));
  const int wid = __builtin_amdgcn_readfirstlane(tid >> 6), lane = tid & 63, wr = wid >> 2, wc = wid & 3, fr_ = lane & 15, fq_ = lane >> 4;
  unsigned char* ws = P.ws;
  float* stats = (float*)(ws + O_ST);
  int nN, nPre = 0, nMain, nMeta = 0, pnoff = 0;
  switch (gp) {
    case G_FFN1_GU: nN = 43; nMeta = 43; break;
    case G_FFN1_D: nN = 8; break;
    case G_WIN_A: nN = 25; nPre = 8; break;
    case G_WIN_META: nN = 0; nMeta = 65; break;
    case G_WIN_B: nN = 40; pnoff = 25; break;
    case G_MERGE: nN = 8; break;
    case G_OUT: nN = 8; break;
    case G_FFN2_GU: nN = 43; break;
    default: nN = 8; break;
  }
  nMain = 64 * nN;
  const int ntiles = nPre + nMain + nMeta;
  for (int t = blockIdx.x; t < ntiles; t += gridDim.x) {
    int pm, pn, kind = gp;
    bool meta = false;
    if (t < nPre) { pm = 64; pn = t; meta = true; kind = G_FFN1_D; }
    else if (t < nPre + nMain) { main_order(t - nPre, nN, pm, pn); pn += pnoff; }
    else { pm = 64; pn = t - nPre - nMain; meta = true; }
    const int arow0 = meta ? 0 : (pm >> 4) * LP + 64 + (pm & 15) * 256;
    const int nrow0 = pm * 256;
    const bf16_t *A, *B0p, *B1p; int K;
    switch (kind) {
      case G_FFN1_GU: A = (const bf16_t*)(ws + O_ACTB); K = 2048; B0p = (const bf16_t*)(ws + O_WF) + (size_t)DFF * 2048 + (size_t)pn * 128 * 2048; B1p = B0p + (size_t)DFF * 2048; break;
      case G_FFN2_GU: A = (const bf16_t*)(ws + O_ACTB); K = 2048; B0p = (const bf16_t*)(ws + O_WF) + (size_t)DFF * 2048 + (size_t)pn * 128 * 2048; B1p = B0p + (size_t)DFF * 2048; break;
      case G_FFN1_D: case G_FFN2_D: A = (const bf16_t*)(ws + O_HID); K = DFF; B0p = (const bf16_t*)(ws + O_WF) + (size_t)pn * 256 * DFF; B1p = B0p + (size_t)128 * DFF; break;
      case G_WIN_A: case G_WIN_META: case G_WIN_B: A = (const bf16_t*)(ws + O_ACTB); K = 2048; B0p = (const bf16_t*)(ws + O_WIN) + (size_t)pn * 256 * 2048; B1p = B0p + (size_t)128 * 2048; break;
      case G_MERGE: A = (const bf16_t*)(ws + O_GR); K = 2048; B0p = (const bf16_t*)(ws + O_WS) + (size_t)pn * 256 * 2048; B1p = B0p + (size_t)128 * 2048; break;
      default  : A = (const bf16_t*)(ws + O_MRG); K = 2048; B0p = (const bf16_t*)(ws + O_WS) + 2 * (size_t)2048 * 2048 + (size_t)pn * 256 * 2048; B1p = B0p + (size_t)128 * 2048; break;
    }
    f32x4 acc[2][2][4][2];
#pragma unroll
    for (int a = 0; a < 2; ++a)
#pragma unroll
      for (int b = 0; b < 2; ++b)
#pragma unroll
        for (int m = 0; m < 4; ++m)
#pragma unroll
          for (int n = 0; n < 2; ++n) acc[a][b][m][n] = (f32x4){0.f, 0.f, 0.f, 0.f};
    const int nk = (kind == G_MERGE) ? 2 : 1;
    for (int kl = 0; kl < nk; ++kl) {
      if (kl == 1) {
        int fr = fr_, fq = fq_; asm volatile("" : "+v"(fr), "+v"(fq));
        const bf16_t* gA = (const bf16_t*)P.out; const bf16_t* gB = gA + (size_t)TR * 2048;
#pragma unroll
      for (int aim = 0; aim < 4; ++aim) {
          const int ai = aim >> 1, m0 = (aim & 1) * 2;
          u32x2 ga[2][2][2], gb[2][2][2];
#pragma unroll
          for (int mm = 0; mm < 2; ++mm) {
            const int m = m0 + mm;
            const size_t nrow = (size_t)(nrow0 + ai * 128 + wr * 64 + m * 16 + fr) * 2048;
#pragma unroll
            for (int bj = 0; bj < 2; ++bj)
#pragma unroll
              for (int n = 0; n < 2; ++n) { const int col = pn * 256 + bj * 128 + wc * 32 + n * 16 + fq * 4; ga[mm][bj][n] = *(const u32x2*)(gA + nrow + col); gb[mm][bj][n] = *(const u32x2*)(gB + nrow + col); }
          }
          asm volatile("" ::: "memory"); SCHED;
#pragma unroll
          for (int mm = 0; mm < 2; ++mm)
#pragma unroll
            for (int bj = 0; bj < 2; ++bj)
#pragma unroll
              for (int n = 0; n < 2; ++n) {
                const int m = m0 + mm;
                const u32x2 wa = ga[mm][bj][n], wb = gb[mm][bj][n];
                const float a4[4] = {__uint_as_float(wa.x << 16), __uint_as_float(wa.x & 0xffff0000u), __uint_as_float(wa.y << 16), __uint_as_float(wa.y & 0xffff0000u)};
                const float b4[4] = {__uint_as_float(wb.x << 16), __uint_as_float(wb.x & 0xffff0000u), __uint_as_float(wb.y << 16), __uint_as_float(wb.y & 0xffff0000u)};
#pragma unroll
                for (int j = 0; j < 4; ++j) { float ea = __expf(-fminf(fmaxf(a4[j], -40.f), 40.f)), eb = __expf(-fminf(fmaxf(b4[j], -40.f), 40.f)); acc[ai][bj][m][n][j] *= (1.f + eb) / (1.f + ea); }
              }
          asm volatile("" ::: "memory"); SCHED;
        }
        A = (const bf16_t*)(ws + O_DD); B0p += (size_t)2048 * 2048; B1p += (size_t)2048 * 2048;
        asm volatile("s_waitcnt vmcnt(0)" ::: "memory");
      }
      gemm_mainloop((const char*)(A + (size_t)arow0 * K), (const char*)B0p, (const char*)B1p, K, acc);
    }
    int fr = fr_, fq = fq_; asm volatile("" : "+v"(fr), "+v"(fq));
    if (kind == G_FFN1_GU || kind == G_FFN2_GU || kind == G_WIN_A || kind == G_WIN_META || kind == G_WIN_B) {
      float* rsl = (float*)shm_raw;
      const int tid2 = wid * 64 + (int)__builtin_amdgcn_mbcnt_hi(~0u, __builtin_amdgcn_mbcnt_lo(~0u, 0u));
      if (tid2 < 256) {
        const size_t row = (size_t)(arow0 + tid2); float sum;
        if (kind == G_FFN1_GU) sum = stats[row];
        else { const f32x4* pp = (const f32x4*)((const float*)(ws + (kind == G_FFN2_GU ? O_ST2 : O_ST1)) + row * 32); f32x4 a = pp[0];
#pragma unroll
          for (int i = 1; i < 8; ++i) a += pp[i];
          sum = (a[0] + a[1]) + (a[2] + a[3]); }
        rsl[tid2] = rsqrtf(sum * (1.f / 2048.f) + EPS);
      }
      __syncthreads();
    }
    if (kind == G_FFN1_GU || kind == G_FFN2_GU) {
      const float* rsl = (const float*)shm_raw;
      bf16_t* hid = (bf16_t*)(ws + O_HID);
#pragma unroll
      for (int ai = 0; ai < 2; ++ai)
#pragma unroll
        for (int m = 0; m < 4; ++m) {
          const int r = ai * 128 + wr * 64 + m * 16 + fr;
          if (meta && (r < 48 || r >= 64)) continue;
          const int prow = arow0 + r;
          const float rs = rsl[r];
#pragma unroll
          for (int n = 0; n < 2; ++n) {
            f32x4 g = acc[ai][0][m][n] * rs, u = acc[ai][1][m][n] * rs, h;
#pragma unroll
            for (int j = 0; j < 4; ++j) h[j] = g[j] * sigm(g[j]) * u[j];
            store_bf4(hid + (size_t)prow * DFF + pn * 128 + wc * 32 + n * 16 + fq * 4, h);
          }
          asm volatile("" ::: "memory"); SCHED;
        }
    } else if (kind == G_FFN1_D || kind == G_OUT || kind == G_FFN2_D) {
      const float* resA = (kind == G_FFN2_D) ? P.out : P.x;
      const bf16_t* resF = (kind == G_OUT) ? (const bf16_t*)(ws + O_F) : nullptr;
      float* outF32 = (kind == G_FFN1_D) ? nullptr : P.out;
      bf16_t* outB = (kind == G_FFN2_D) ? nullptr : (bf16_t*)(ws + O_ACTB);
      bf16_t* outF = (kind == G_FFN1_D && !meta) ? (bf16_t*)(ws + O_F) : nullptr;
      const float scale = (kind == G_OUT) ? 1.f : 0.5f;
      float* st = (kind == G_FFN1_D) ? (float*)(ws + O_ST1) : (kind == G_OUT ? (float*)(ws + O_ST2) : nullptr);
#pragma unroll
      for (int aim = 0; aim < 4; ++aim) {
        const int ai = aim >> 1, m0 = (aim & 1) * 2;
        f32x4 rres[2][2][2];
#pragma unroll
        for (int mm = 0; mm < 2; ++mm) {
          const int m = m0 + mm;
          const int r = ai * 128 + wr * 64 + m * 16 + fr;
          const bool rowok = !(meta && (r < 48 || r >= 64));
          const size_t prow = arow0 + r, nrow = nrow0 + r;
          const float* rp = meta ? (P.meta + (size_t)(rowok ? r - 48 : 0) * 2048) : (resA + nrow * 2048);
#pragma unroll
          for (int bj = 0; bj < 2; ++bj)
#pragma unroll
            for (int n = 0; n < 2; ++n) {
              const int col = pn * 256 + bj * 128 + wc * 32 + n * 16 + fq * 4;
              rres[mm][bj][n] = *(const f32x4*)(rp + col);
            }
        }
        asm volatile("" ::: "memory"); SCHED;
#pragma unroll
        for (int mm = 0; mm < 2; ++mm) {
          const int m = m0 + mm;
          const int r = ai * 128 + wr * 64 + m * 16 + fr;
          const bool rowok = !(meta && (r < 48 || r >= 64));
          const size_t prow = arow0 + r, nrow = nrow0 + r;
          float ss = 0.f;
#pragma unroll
          for (int bj = 0; bj < 2; ++bj)
#pragma unroll
            for (int n = 0; n < 2; ++n) {
              const int col = pn * 256 + bj * 128 + wc * 32 + n * 16 + fq * 4;
              f32x4 res = rres[mm][bj][n];
              if (resF) { const u32x2 w = *(const u32x2*)(resF + prow * 2048 + col); res[0] += __uint_as_float(w.x << 16); res[1] += __uint_as_float(w.x & 0xffff0000u); res[2] += __uint_as_float(w.y << 16); res[3] += __uint_as_float(w.y & 0xffff0000u); }
              const f32x4 d = acc[ai][bj][m][n] * scale, v = res + d;
              if (rowok) {
                if (outF32) *(f32x4*)(outF32 + nrow * 2048 + col) = v;
                if (outB) store_bf4(outB + prow * 2048 + col, v);
                if (outF) store_bf4(outF + prow * 2048 + col, d);
              }
              ss += v[0] * v[0] + v[1] * v[1] + v[2] * v[2] + v[3] * v[3];
            }
          ss += __shfl_xor(ss, 16); ss += __shfl_xor(ss, 32);
          if (fq == 0 && st && rowok) st[prow * 32 + pn * 4 + wc] = ss;
        }
        asm volatile("" ::: "memory"); SCHED;
      }
    } else if (kind == G_MERGE) {
      const bf16_t* gB = (const bf16_t*)P.out + (size_t)TR * 2048;
      bf16_t* mo = (bf16_t*)(ws + O_MRG);
#pragma unroll
      for (int ai = 0; ai < 2; ++ai) {
        u32x2 gw[4][2][2];
#pragma unroll
        for (int m = 0; m < 4; ++m) {
          const size_t nrow = nrow0 + ai * 128 + wr * 64 + m * 16 + fr;
#pragma unroll
          for (int bj = 0; bj < 2; ++bj)
#pragma unroll
            for (int n = 0; n < 2; ++n) gw[m][bj][n] = *(const u32x2*)(gB + nrow * 2048 + pn * 256 + bj * 128 + wc * 32 + n * 16 + fq * 4);
        }
        asm volatile("" ::: "memory"); SCHED;
#pragma unroll
        for (int m = 0; m < 4; ++m) {
          const size_t prow = arow0 + ai * 128 + wr * 64 + m * 16 + fr;
#pragma unroll
          for (int bj = 0; bj < 2; ++bj)
#pragma unroll
            for (int n = 0; n < 2; ++n) {
              const int col = pn * 256 + bj * 128 + wc * 32 + n * 16 + fq * 4;
              const u32x2 w = gw[m][bj][n];
              const float b4[4] = {__uint_as_float(w.x << 16), __uint_as_float(w.x & 0xffff0000u), __uint_as_float(w.y << 16), __uint_as_float(w.y & 0xffff0000u)};
              f32x4 v;
#pragma unroll
              for (int j = 0; j < 4; ++j) v[j] = acc[ai][bj][m][n][j] / (1.f + __expf(-fminf(fmaxf(b4[j], -40.f), 40.f)));
              store_bf4(mo + prow * 2048 + col, v);
            }
        }
        asm volatile("" ::: "memory"); SCHED;
      }
    } else {
      const float* rsl = (const float*)shm_raw;
      bf16_t* dst; int ld, c0; bool natural = false, isLow = false;
      if (pn < 4) { dst = (bf16_t*)(ws + O_GQ); ld = 1024; c0 = pn * 256; }
      else if (pn < 8) { dst = (bf16_t*)(ws + O_GK); ld = 1024; c0 = (pn - 4) * 256; }
      else if (pn < 16) { dst = (bf16_t*)(ws + O_GV); ld = 2048; c0 = (pn - 8) * 256; }
      else if (pn < 24) { dst = (bf16_t*)(ws + O_GR); ld = 2048; c0 = (pn - 16) * 256; }
      else if (pn == 24) { dst = nullptr; ld = 32; c0 = 0; isLow = true; }
      else if (pn < 33) { dst = (bf16_t*)(ws + O_DQ); ld = 2048; c0 = (pn - 25) * 256; }
      else if (pn < 41) { dst = (bf16_t*)(ws + O_DK); ld = 2048; c0 = (pn - 33) * 256; }
      else if (pn < 49) { dst = (bf16_t*)(ws + O_DV); ld = 2048; c0 = (pn - 41) * 256; }
      else if (pn < 57) { dst = (bf16_t*)P.out; ld = 2048; c0 = (pn - 49) * 256; natural = true; }
      else { dst = (bf16_t*)P.out + (size_t)TR * 2048; ld = 2048; c0 = (pn - 57) * 256; natural = true; }
      float* low = (float*)(ws + O_LOW);
      bool single = false;
      if (meta && pn >= 25) { single = true; if (pn >= 33 && pn < 41) dst = (bf16_t*)(ws + O_DKM); else if (pn >= 41 && pn < 49) dst = (bf16_t*)(ws + O_DVM); else natural = true; }
      if (!(meta && natural)) {
#pragma unroll
        for (int ai = 0; ai < 2; ++ai)
#pragma unroll
          for (int m = 0; m < 4; ++m) {
            const int r = ai * 128 + wr * 64 + m * 16 + fr;
            if (meta && r >= 64) continue;
            const size_t prow = arow0 + r, nrow = nrow0 + r;
            const float rs = rsl[r];
            const bool zero = meta && r < 48;
#pragma unroll
            for (int bj = 0; bj < 2; ++bj)
#pragma unroll
              for (int n = 0; n < 2; ++n) {
                const int cc = bj * 128 + wc * 32 + n * 16 + fq * 4;
                f32x4 v = acc[ai][bj][m][n] * rs;
                if (zero) v = (f32x4){0.f, 0.f, 0.f, 0.f};
                if (isLow) {
                  if (cc < 32) { if (meta) { for (int b4 = 0; b4 < 4; ++b4) *(f32x4*)(low + (size_t)(b4 * LP + r) * 32 + cc) = v; } else *(f32x4*)(low + prow * 32 + cc) = v; }
                } else if (single) {
                  store_bf4(dst + (size_t)r * ld + c0 + cc, v);
                } else if (meta) {
                  for (int b4 = 0; b4 < 4; ++b4) store_bf4(dst + (size_t)(b4 * LP + r) * ld + c0 + cc, v);
                } else {
                  store_bf4(dst + (natural ? nrow : prow) * ld + c0 + cc, v);
                }
              }
            asm volatile("" ::: "memory"); SCHED;
          }
      }
    }
    asm volatile("s_waitcnt vmcnt(0)" ::: "memory");
    __syncthreads();
  }
}

struct TReg { f32x4 v[8]; };
DEV void tt_load(const float* __restrict__ src, int K, int N, const float* __restrict__ gain, int tk, int tn, TReg& r) {
  const int tid = threadIdx.x, k0 = tk * 128, n0 = tn * 128;
#pragma unroll
  for (int i = 0; i < 8; ++i) {
    const int kr = i * 16 + (tid >> 5), nc = (tid & 31) * 4;
    f32x4 v = (f32x4){0.f, 0.f, 0.f, 0.f};
    if (n0 + nc < N) v = *(const f32x4*)(src + (size_t)(k0 + kr) * N + n0 + nc);
    if (gain) v = v * gain[k0 + kr];
    r.v[i] = v;
  }
}
DEV void tt_store(int K, int N, bf16_t* __restrict__ dst, bool winmap, int tk, int tn, const TReg& r) {
  const int tid = threadIdx.x;
  bf16_t* T = shm;
  const int k0 = tk * 128, n0 = tn * 128;
  __syncthreads();
#pragma unroll
  for (int i = 0; i < 8; ++i) {
    const int kr = i * 16 + (tid >> 5), nc = (tid & 31) * 4;
    unsigned* tp = (unsigned*)(T + kr * 130 + nc);
    tp[0] = pk2(r.v[i][0], r.v[i][1]); tp[1] = pk2(r.v[i][2], r.v[i][3]);
  }
  __syncthreads();
  const int nr = tid >> 2, n = n0 + nr;
  if (n < N) {
    const int drow = winmap ? (n < 6176 ? n : n + 224) : n;
#pragma unroll
    for (int q = 0; q < 4; ++q) {
      const int kk = (tid & 3) * 8 + q * 32;
      unsigned short e[8];
#pragma unroll
      for (int i = 0; i < 8; ++i) e[i] = T[(kk + i) * 130 + nr];
      u32x4 w; w.x = e[0] | ((unsigned)e[1] << 16); w.y = e[2] | ((unsigned)e[3] << 16); w.z = e[4] | ((unsigned)e[5] << 16); w.w = e[6] | ((unsigned)e[7] << 16);
      *(u32x4*)(dst + (size_t)drow * K + k0 + kk) = w;
    }
  }
}

DEV void transpose_job(const float* src, int K, int N, bf16_t* dst, const float* gain, bool winmap, int& tbase, int& t) {
  const int ntn = (N + 127) / 128, nt = (K / 128) * ntn, tend = tbase + nt;
  TReg cur, nxt;
  if (t < tend) { const int l = t - tbase; tt_load(src, K, N, gain, l / ntn, l % ntn, cur); }
  while (t < tend) {
    const int l = t - tbase, t2 = t + gridDim.x;
    if (t2 < tend) { const int l2 = t2 - tbase; tt_load(src, K, N, gain, l2 / ntn, l2 % ntn, nxt); }
    tt_store(K, N, dst, winmap, l / ntn, l % ntn, cur);
    cur = nxt; t = t2;
  }
  tbase += nt;
}

DEV void phase_prologue(const Params& P) {
  unsigned char* ws = P.ws;
  const int tid = threadIdx.x, gtid = blockIdx.x * NTHR + tid, gsz = gridDim.x * NTHR;
  { u32x4* z = (u32x4*)((bf16_t*)(ws + O_WIN) + (size_t)6176 * 2048); const int nz = 224 * 2048 / 8;
    for (int i = gtid; i < nz; i += gsz) z[i] = (u32x4){0u, 0u, 0u, 0u}; }
  { const int gw = (blockIdx.x * NTHR + tid) >> 6, nw = gsz >> 6, lane = tid & 63;
    bf16_t* xb = (bf16_t*)(ws + O_ACTB); float* st0 = (float*)(ws + O_ST);
    for (int r = gw; r < TR + 16; r += nw) {
      const float* src; size_t prow;
      if (r < TR) { src = P.x + (size_t)r * 2048; prow = (size_t)(r >> 12) * LP + 64 + (r & 4095); } else { src = P.meta + (size_t)(r - TR) * 2048; prow = 48 + (r - TR); }
      float ss = 0.f;
#pragma unroll
      for (int i = 0; i < 8; ++i) { const int c = i * 256 + lane * 4; f32x4 v = *(const f32x4*)(src + c); ss += v[0] * v[0] + v[1] * v[1] + v[2] * v[2] + v[3] * v[3]; store_bf4(xb + prow * 2048 + c, v); }
#pragma unroll
      for (int o = 32; o >= 1; o >>= 1) ss += __shfl_xor(ss, o);
      if (lane == 0) st0[prow] = ss;
    } }
  int tbase = 0, t = blockIdx.x;
  bf16_t* wf = (bf16_t*)(ws + O_WF); bf16_t* wsq = (bf16_t*)(ws + O_WS);
  transpose_job(P.w1g, 2048, DFF, wf + (size_t)DFF * 2048, P.n1, false, tbase, t);
  transpose_job(P.w1u, 2048, DFF, wf + (size_t)2 * DFF * 2048, P.n1, false, tbase, t);
  transpose_job(P.w1d, DFF, 2048, wf, nullptr, false, tbase, t);
  transpose_job(P.win, 2048, INW, (bf16_t*)(ws + O_WIN), P.nmix, true, tbase, t);
  transpose_job(P.wbg, 2048, 2048, wsq, nullptr, false, tbase, t);
  transpose_job(P.wbd, 2048, 2048, wsq + (size_t)2048 * 2048, nullptr, false, tbase, t);
  transpose_job(P.wout, 2048, 2048, wsq + (size_t)2 * 2048 * 2048, nullptr, false, tbase, t);
}

DEV f32x4 mfma16(bf16x8 a, bf16x8 b, f32x4 c) { return __builtin_amdgcn_mfma_f32_16x16x32_bf16(a, b, c, 0, 0, 0); }
#define LD8(p) (*reinterpret_cast<const bf16x8*>(p))

DEV void gla_prep_unit(const Params& P, int u, bool dummy = false) {
  unsigned char* ws = P.ws;
  const bool st_ok = !dummy || (P.ws == nullptr);
  int tid = threadIdx.x; asm volatile("" : "+v"(tid));
  const int w = tid >> 6, lane = tid & 63, fr = lane & 15, fq = lane >> 4;
  const int c = u % 65, bh = u / 65, b = bh >> 2, h = bh & 3;
  bf16_t* QD0 = shm; bf16_t* KI0 = QD0 + 64 * 264; bf16_t* QD1 = KI0 + 64 * 264; bf16_t* KI1 = QD1 + 64 * 264;
  float* LOWs = (float*)(KI1 + 64 * 264);
  bf16_t* gq = (bf16_t*)(ws + O_GQ); bf16_t* gk = (bf16_t*)(ws + O_GK);
  const size_t prow0 = (size_t)b * LP + c * 64;
  const int dir = tid >> 8, k = tid & 255, col = h * 256 + k;
  unsigned qk[64];
#pragma unroll
  for (int tt = 0; tt < 64; ++tt) { const int t = dir ? 63 - tt : tt; qk[tt] = (unsigned)gq[(prow0 + t) * 1024 + col] | ((unsigned)gk[(prow0 + t) * 1024 + col] << 16); }
  __syncthreads();
  { const int idx = tid * 4, row = idx >> 5, cl = idx & 31;
    *(f32x4*)(LOWs + idx) = *(const f32x4*)((const float*)(ws + O_LOW) + (prow0 + row) * 32 + cl); }
  __syncthreads();
  {
    const float* wa2 = dir ? P.wa2b : P.wa2f;
    float wv[16];
#pragma unroll
    for (int r = 0; r < 16; ++r) wv[r] = wa2[r * 1024 + col];
    const float bias = (dir ? P.bab : P.baf)[col];
    bf16_t* QD = dir ? QD1 : QD0; bf16_t* KI = dir ? KI1 : KI0;
    float bc = 0.f;
#pragma unroll
    for (int tt = 0; tt < 64; ++tt) {
      const int t = dir ? 63 - tt : tt;
      const f32x4* lr = (const f32x4*)(LOWs + t * 32 + dir * 16);
      const f32x4 l0 = lr[0], l1 = lr[1], l2 = lr[2], l3 = lr[3];
      float z = bias;
#pragma unroll
      for (int r = 0; r < 4; ++r) { z = fmaf(l0[r], wv[r], z); z = fmaf(l1[r], wv[4 + r], z); z = fmaf(l2[r], wv[8 + r], z); z = fmaf(l3[r], wv[12 + r], z); }
      const float ls = fminf(z, 0.f) - __logf(1.f + __expf(-fabsf(z)));
      const bool valid = !(c == 0 && t < 48);
      bc += valid ? ls * 0.0625f : 0.f;
      const float e = __expf(bc), ei = __expf(-bc);
      QD[t * 264 + k] = f2bf(__uint_as_float(qk[tt] << 16) * e * 0.0625f);
      KI[t * 264 + k] = f2bf(__uint_as_float(qk[tt] & 0xffff0000u) * ei);
    }
    if (st_ok) ((float*)(ws + O_DL))[((size_t)(bh * 2 + dir) * 65 + c) * 256 + k] = __expf(bc);
  }
  __syncthreads();
  if (c >= 1) {
    const int d = w >> 2, ti = w & 3;
    const bf16_t* QD = d ? QD1 : QD0; const bf16_t* KI = d ? KI1 : KI0;
    bf16_t* Pg = (bf16_t*)(ws + O_P) + (size_t)u * 4096;
#pragma unroll
    for (int tj = 0; tj < 4; ++tj) {
      f32x4 a4 = (f32x4){0.f, 0.f, 0.f, 0.f};
#pragma unroll
      for (int kk = 0; kk < 8; ++kk) a4 = mfma16(LD8(QD + (ti * 16 + fr) * 264 + kk * 32 + fq * 8), LD8(KI + (tj * 16 + fr) * 264 + kk * 32 + fq * 8), a4);
#pragma unroll
      for (int r = 0; r < 4; ++r) { const int i = ti * 16 + fq * 4 + r, j = tj * 16 + fr; const bool keep = d ? (j > i) : (j <= i); if (keep && st_ok) Pg[i * 64 + j] = f2bf(a4[r]); }
    }
  }
  bf16_t* qdb = (bf16_t*)(ws + O_QDB); bf16_t* kib = (bf16_t*)(ws + O_KIB);
#pragma unroll
  for (int i = 0; i < 4; ++i) {
    const int p = tid + 512 * i, tok = p >> 5, kc = (p & 31) * 8;
    const size_t g = (prow0 + tok) * 1024 + h * 256 + kc;
    if (st_ok) { *(u32x4*)(gq + g) = *(const u32x4*)(QD0 + tok * 264 + kc);
    *(u32x4*)(qdb + g) = *(const u32x4*)(QD1 + tok * 264 + kc); }
  }
  {
    const bf16_t* KI = dir ? KI1 : KI0;
    bf16_t* dst = (dir ? kib : gk) + (prow0 + (k >> 2)) * 1024 + h * 256 + (k & 3) * 64;
#pragma unroll
    for (int q = 0; q < 8; ++q) {
      unsigned e[8];
#pragma unroll
      for (int i = 0; i < 8; ++i) e[i] = KI[(q * 8 + i) * 264 + k];
      u32x4 wv4; wv4.x = e[0] | (e[1] << 16); wv4.y = e[2] | (e[3] << 16); wv4.z = e[4] | (e[5] << 16); wv4.w = e[6] | (e[7] << 16);
      if (st_ok) *(u32x4*)(dst + q * 8) = wv4;
    }
  }
  __syncthreads();
  bf16_t* gv = (bf16_t*)(ws + O_GV);
  bf16_t* VN = shm;
#pragma unroll
  for (int q = 0; q < 8; ++q) {
    const int p = tid + 512 * q, tok = p >> 6, vc = (p & 63) * 8;
    *(u32x4*)(VN + tok * 520 + vc) = *(const u32x4*)(gv + (prow0 + tok) * 2048 + h * 512 + vc);
  }
  __syncthreads();
  {
    const int v = tid;
    bf16_t* dst = gv + (prow0 + (v >> 3)) * 2048 + h * 512 + (v & 7) * 64;
#pragma unroll
    for (int q = 0; q < 8; ++q) {
      unsigned e[8];
#pragma unroll
      for (int i = 0; i < 8; ++i) e[i] = VN[(q * 8 + i) * 520 + v];
      u32x4 wv4; wv4.x = e[0] | (e[1] << 16); wv4.y = e[2] | (e[3] << 16); wv4.z = e[4] | (e[5] << 16); wv4.w = e[6] | (e[7] << 16);
      if (st_ok) *(u32x4*)(dst + q * 8) = wv4;
    }
  }
}

DEV void gla_scan_unit(const Params& P, int u) {
  unsigned char* ws = P.ws;
  int tid = threadIdx.x; asm volatile("" : "+v"(tid));
  const int w = tid >> 6, lane = tid & 63, fr = lane & 15, fq = lane >> 4;
  const int xj = u >> 3, sl = xj & 7, grp = (xj >> 3) * 8 + (u & 7);
  const int b = grp >> 3, h = (grp >> 1) & 3, dir = grp & 1;
  bf16_t* QDs = shm;
  bf16_t* KIT = QDs + 64 * 264;
  bf16_t* VT = KIT + 256 * 72;
  bf16_t* SBs = VT + 64 * 72;
  const bf16_t* qsrc = (const bf16_t*)(ws + (dir ? O_QDB : O_GQ));
  const bf16_t* ksrc = (const bf16_t*)(ws + (dir ? O_KIB : O_GK));
  const bf16_t* vsrc = (const bf16_t*)(ws + O_GV);
  const float* dlp = (const float*)(ws + O_DL) + (size_t)((b * 4 + h) * 2 + dir) * 65 * 256;
  bf16_t* osrc = (bf16_t*)P.out + (size_t)dir * TR * 2048;
  f32x4 S[2][4];
#pragma unroll
  for (int a = 0; a < 4; ++a) { S[0][a] = (f32x4){0.f, 0.f, 0.f, 0.f}; S[1][a] = (f32x4){0.f, 0.f, 0.f, 0.f}; }
  u32x4 rqA[4], rkA[4], rvA, rqB[4], rkB[4], rvB; f32x4 rdA0, rdA1, rdB0, rdB1;
  const int nsteps = dir ? 64 : 65;
#define SCAN_LOAD(RQ, RK, RV, RD0, RD1, cc) do { const size_t pr0 = (size_t)b * LP + (cc) * 64; \
    _Pragma("unroll") for (int i = 0; i < 4; ++i) { const int p = tid + 512 * i; \
      { const int tok = p >> 5, kc = (p & 31) * 8; RQ[i] = *(const u32x4*)(qsrc + (pr0 + tok) * 1024 + h * 256 + kc); } \
      { const int kr = p >> 3, tc = (p & 7) * 8; RK[i] = *(const u32x4*)(ksrc + (pr0 + (kr >> 2)) * 1024 + h * 256 + (kr & 3) * 64 + tc); } } \
    { const int vv = sl * 64 + (tid >> 3), tc = (tid & 7) * 8; RV = *(const u32x4*)(vsrc + (pr0 + (vv >> 3)) * 2048 + h * 512 + (vv & 7) * 64 + tc); } \
    RD0 = *(const f32x4*)(dlp + (cc) * 256 + (2 * w) * 16 + fq * 4); RD1 = *(const f32x4*)(dlp + (cc) * 256 + (2 * w + 1) * 16 + fq * 4); } while (0)
#define SCAN_STEP(RQ, RK, RV, RD0, RD1, s_) do { \
    const int c = dir ? 64 - (s_) : (s_); \
    const bool do_o = dir ? true : (c >= 1), do_upd = dir ? (c >= 2) : (c <= 63); \
    __syncthreads(); \
    _Pragma("unroll") for (int i = 0; i < 4; ++i) { const int p = tid + 512 * i; \
      *(u32x4*)(QDs + (p >> 5) * 264 + (p & 31) * 8) = RQ[i]; \
      *(u32x4*)(KIT + (p >> 3) * 72 + (p & 7) * 8) = RK[i]; } \
    *(u32x4*)(VT + (tid >> 3) * 72 + (tid & 7) * 8) = RV; \
    _Pragma("unroll") for (int vt = 0; vt < 4; ++vt) _Pragma("unroll") for (int kt = 0; kt < 2; ++kt) { \
        u32x2 pw; pw.x = pk2(S[kt][vt][0], S[kt][vt][1]); pw.y = pk2(S[kt][vt][2], S[kt][vt][3]); \
        *(u32x2*)(SBs + (vt * 16 + fr) * 264 + (2 * w + kt) * 16 + fq * 4) = pw; } \
    const f32x4 dl0 = RD0, dl1 = RD1; \
    __syncthreads(); \
    if ((s_) + 2 < nsteps) SCAN_LOAD(RQ, RK, RV, RD0, RD1, dir ? 64 - ((s_) + 2) : (s_) + 2); \
    if (do_o) { \
      const int ti = w >> 1; \
      _Pragma("unroll") for (int jj = 0; jj < 2; ++jj) { \
        const int tj = (w & 1) * 2 + jj; \
        f32x4 a4 = (f32x4){0.f, 0.f, 0.f, 0.f}; \
        _Pragma("unroll") for (int kk = 0; kk < 8; ++kk) a4 = mfma16(LD8(SBs + (tj * 16 + fr) * 264 + kk * 32 + fq * 8), LD8(QDs + (ti * 16 + fr) * 264 + kk * 32 + fq * 8), a4); \
        const size_t nrow = (size_t)b * SEQ + (c - 1) * 64 + ti * 16 + fr; \
        store_bf4(osrc + nrow * 2048 + h * 512 + sl * 64 + tj * 16 + fq * 4, a4); } } \
    if (do_upd) { \
      _Pragma("unroll") for (int kt = 0; kt < 2; ++kt) _Pragma("unroll") for (int vt = 0; vt < 4; ++vt) { \
          _Pragma("unroll") for (int kk = 0; kk < 2; ++kk) S[kt][vt] = mfma16(LD8(KIT + ((2 * w + kt) * 16 + fr) * 72 + kk * 32 + fq * 8), LD8(VT + (vt * 16 + fr) * 72 + kk * 32 + fq * 8), S[kt][vt]); \
          S[kt][vt] = S[kt][vt] * (kt ? dl1 : dl0); } } \
  } while (0)
  SCAN_LOAD(rqA, rkA, rvA, rdA0, rdA1, dir ? 64 : 0);
  SCAN_LOAD(rqB, rkB, rvB, rdB0, rdB1, dir ? 63 : 1);
  for (int s = 0; s < nsteps; s += 2) {
    SCAN_STEP(rqA, rkA, rvA, rdA0, rdA1, s);
    if (s + 1 < nsteps) SCAN_STEP(rqB, rkB, rvB, rdB0, rdB1, s + 1);
  }
#undef SCAN_STEP
#undef SCAN_LOAD
}

DEV void gla_finish_unit(const Params& P, int u, bool dummy = false) {
  unsigned char* ws = P.ws;
  const bool st_ok = !dummy || (P.ws == nullptr);
  int tid = threadIdx.x; asm volatile("" : "+v"(tid));
  const int w = tid >> 6, lane = tid & 63, fr = lane & 15, fq = lane >> 4;
  const int c = (u & 63) + 1, bh = u >> 6, b = bh >> 2, h = bh & 3;
  bf16_t* VTf = shm;
  bf16_t* Pl = VTf + 512 * 72;
  float* red = (float*)(Pl + 64 * 72);
  const size_t prow0 = (size_t)b * LP + c * 64, nrow0 = (size_t)b * SEQ + (c - 1) * 64;
  const bf16_t* gv = (const bf16_t*)(ws + O_GV);
  __syncthreads();
  { const int i = tid >> 3, j0 = (tid & 7) * 8;
    *(u32x4*)(Pl + i * 72 + j0) = *(const u32x4*)((const bf16_t*)(ws + O_P) + (size_t)(bh * 65 + c) * 4096 + i * 64 + j0); }
#pragma unroll
  for (int q = 0; q < 8; ++q) {
    const int p = tid + 512 * q, v = p >> 3, tc = (p & 7) * 8;
    *(u32x4*)(VTf + v * 72 + tc) = *(const u32x4*)(gv + (prow0 + (v >> 3)) * 2048 + h * 512 + (v & 7) * 64 + tc);
  }
  __syncthreads();
  f32x4 acc[4][4];
  const bf16_t* of = (const bf16_t*)P.out; const bf16_t* ob = of + (size_t)TR * 2048;
  float ss[4] = {0.f, 0.f, 0.f, 0.f};
#pragma unroll
  for (int vt = 0; vt < 4; ++vt)
#pragma unroll
    for (int it = 0; it < 4; ++it) {
      f32x4 a4 = (f32x4){0.f, 0.f, 0.f, 0.f};
#pragma unroll
      for (int kk = 0; kk < 2; ++kk) a4 = mfma16(LD8(VTf + (w * 64 + vt * 16 + fr) * 72 + kk * 32 + fq * 8), LD8(Pl + (it * 16 + fr) * 72 + kk * 32 + fq * 8), a4);
      const size_t g = (nrow0 + it * 16 + fr) * 2048 + h * 512 + w * 64 + vt * 16 + fq * 4;
      a4 = a4 + load_bf4(of + g) + load_bf4(ob + g);
      acc[vt][it] = a4;
      ss[it] += a4[0] * a4[0] + a4[1] * a4[1] + a4[2] * a4[2] + a4[3] * a4[3];
    }
#pragma unroll
  for (int it = 0; it < 4; ++it) { float s2 = ss[it]; s2 += __shfl_xor(s2, 16); s2 += __shfl_xor(s2, 32); if (fq == 0) red[w * 64 + it * 16 + fr] = s2; }
  __syncthreads();
  bf16_t* gr = (bf16_t*)(ws + O_GR);
#pragma unroll
  for (int it = 0; it < 4; ++it) {
    float tot = 0.f;
#pragma unroll
    for (int ww = 0; ww < 8; ++ww) tot += red[ww * 64 + it * 16 + fr];
    const float rs = rsqrtf(tot * (1.f / 512.f) + EPS);
#pragma unroll
    for (int vt = 0; vt < 4; ++vt) {
      const int vcol = w * 64 + vt * 16 + fq * 4;
      bf16_t* gp = gr + (prow0 + it * 16 + fr) * 2048 + h * 512 + vcol;
      const f32x4 g4 = load_bf4(gp), nw = *(const f32x4*)(P.gnorm + vcol);
      f32x4 y;
#pragma unroll
      for (int j = 0; j < 4; ++j) y[j] = acc[vt][it][j] * rs * nw[j] * (g4[j] * sigm(g4[j]));
      if (st_ok) store_bf4(gp, y);
    }
  }
}

constexpr int QBLK = 32, KVBLK = 64;
constexpr float ASCALE = 0.088388347648318440f;
constexpr float ATHR = 8.f;
constexpr int LDA_ = 2048;
constexpr size_t SHM_V = KVBLK * 128 * 2, SHM_K = KVBLK * 128 * 2, SHM_ATTN = 2 * SHM_V + 2 * SHM_K + 8 * 64 * 4;
#define KSWZ(row, colB) ((row) * 256 + ((colB) ^ (((row) & 7) << 4)))
#define SBAR() __builtin_amdgcn_sched_barrier(0)
DEV int crow(int r, int hi) { return (r & 3) + 8 * (r >> 2) + 4 * hi; }

template <int MODE> DEV void alibi(f32x16& p0, f32x16& p1, float base, float nslope) {
#pragma unroll
  for (int r = 0; r < 16; ++r) {
    const float cc = (float)((r & 3) + 8 * (r >> 2));
    p0[r] = fmaf(nslope, fabsf(base - cc), p0[r]);
    p1[r] = fmaf(nslope, fabsf(base - cc - 32.f), p1[r]);
    if (MODE == 1) { p0[r] = -1e30f; if (r < 8) p1[r] = -1e30f; }
    if (MODE == 2) { p0[r] = -1e30f; p1[r] = -1e30f; }
  }
}
DEV void partialSM(f32x16& p0, f32x16& p1, float& m_reg, float& mn, float& alpha) {
  constexpr float C = ASCALE * 1.4426950408889634f;
  float pmax = p0[0];
#pragma unroll
  for (int r = 1; r < 16; ++r) pmax = fmaxf(pmax, p0[r]);
#pragma unroll
  for (int r = 0; r < 16; ++r) pmax = fmaxf(pmax, p1[r]);
  { auto rr = __builtin_amdgcn_permlane32_swap(__float_as_uint(pmax), __float_as_uint(pmax), false, false);
    pmax = fmaxf(__uint_as_float(rr[0]), __uint_as_float(rr[1])); }
  if (__builtin_expect(__all(pmax - m_reg <= ATHR / ASCALE), 1)) { mn = m_reg; alpha = 1.f; }
  else { mn = fmaxf(m_reg, pmax); alpha = __builtin_amdgcn_exp2f((m_reg - mn) * C); m_reg = mn; }
  const float mnC = -mn * C;
#pragma unroll
  for (int r = 0; r < 16; ++r) p0[r] = fmaf(p0[r], C, mnC);
#pragma unroll
  for (int r = 0; r < 16; ++r) p1[r] = fmaf(p1[r], C, mnC);
#pragma unroll
  for (int r = 0; r < 16; ++r) p0[r] = __builtin_amdgcn_exp2f(p0[r]);
}
DEV void finishSM(f32x16& p0, f32x16& p1, float alpha, float& l_reg, bf16x8& pa0, bf16x8& pa1, bf16x8& pa2, bf16x8& pa3) {
#pragma unroll
  for (int r = 0; r < 16; ++r) p1[r] = __builtin_amdgcn_exp2f(p1[r]);
  float ps = 0;
#pragma unroll
  for (int r = 0; r < 16; ++r) ps += p0[r];
#pragma unroll
  for (int r = 0; r < 16; ++r) ps += p1[r];
  { auto rr = __builtin_amdgcn_permlane32_swap(__float_as_uint(ps), __float_as_uint(ps), false, false);
    ps = __uint_as_float(rr[0]) + __uint_as_float(rr[1]); }
  l_reg = l_reg * alpha + ps;
#define PK4(P_, BASE, OUT) do { unsigned a0 = pk2(P_[BASE + 0], P_[BASE + 1]), a1 = pk2(P_[BASE + 2], P_[BASE + 3]);   \
    unsigned b0 = pk2(P_[BASE + 4], P_[BASE + 5]), b1 = pk2(P_[BASE + 6], P_[BASE + 7]);                              \
    auto r0 = __builtin_amdgcn_permlane32_swap(a0, b0, false, false); auto r1 = __builtin_amdgcn_permlane32_swap(a1, b1, false, false); \
    u32x4 w_ = {r0[0], r1[0], r0[1], r1[1]}; OUT = *reinterpret_cast<bf16x8*>(&w_); } while (0)
  PK4(p0, 0, pa0); PK4(p0, 8, pa1); PK4(p1, 0, pa2); PK4(p1, 8, pa3);
#undef PK4
}
DEV void qkt(f32x16& p0, f32x16& p1, const bf16_t* Ks, const bf16x8* qr, int r32, int hi) {
  p0 = f32x16{}; p1 = f32x16{};
#pragma unroll
  for (int d0 = 0; d0 < 8; ++d0) { const int cb = (d0 * 16 + hi * 8) * 2;
    bf16x8 b0 = *reinterpret_cast<const bf16x8*>((const char*)Ks + KSWZ(r32, cb));
    bf16x8 b1 = *reinterpret_cast<const bf16x8*>((const char*)Ks + KSWZ(32 + r32, cb));
    p0 = __builtin_amdgcn_mfma_f32_32x32x16_bf16(b0, qr[d0], p0, 0, 0, 0);
    p1 = __builtin_amdgcn_mfma_f32_32x32x16_bf16(b1, qr[d0], p1, 0, 0, 0); }
}
DEV int v_st(int k, int c) { const int kk = (k & ~0xC) | ((k & 4) << 1) | ((k & 8) >> 1); return ((kk >> 3) * 4 + (c >> 5)) * 512 + ((kk & 7) * 32 + (c & 31)) * 2; }
DEV int v_rd_base(int lane) { return ((lane & 3) << 3) | (((lane >> 2) & 3) << 6) | (((lane >> 4) & 1) << 5) | (((lane >> 5) & 1) << 8); }
constexpr int v_rd_off(int d0, int ks, int half) { return d0 * 512 + ks * 4096 + half * 2048; }
template <int OFF> DEV s16x4 tr_read(int vb) { s16x4 r; asm volatile("ds_read_b64_tr_b16 %0, %1 offset:%2" : "=&v"(r) : "v"(vb), "i"(OFF) : "memory"); return r; }
template <int D0> DEV void pv_one(f32x16& od, int vb, bf16x8 pa0, bf16x8 pa1, bf16x8 pa2, bf16x8 pa3) {
  const s16x4 l0 = tr_read<v_rd_off(D0, 0, 0)>(vb), h0 = tr_read<v_rd_off(D0, 0, 1)>(vb), l1 = tr_read<v_rd_off(D0, 1, 0)>(vb), h1 = tr_read<v_rd_off(D0, 1, 1)>(vb);
  const s16x4 l2 = tr_read<v_rd_off(D0, 2, 0)>(vb), h2 = tr_read<v_rd_off(D0, 2, 1)>(vb), l3 = tr_read<v_rd_off(D0, 3, 0)>(vb), h3 = tr_read<v_rd_off(D0, 3, 1)>(vb);
  asm volatile("s_waitcnt lgkmcnt(0)" ::: "memory"); SBAR();
#define PK(L, H) (bf16x8){L[0], L[1], L[2], L[3], H[0], H[1], H[2], H[3]}
  od = __builtin_amdgcn_mfma_f32_32x32x16_bf16(pa0, PK(l0, h0), od, 0, 0, 0);
  od = __builtin_amdgcn_mfma_f32_32x32x16_bf16(pa1, PK(l1, h1), od, 0, 0, 0);
  od = __builtin_amdgcn_mfma_f32_32x32x16_bf16(pa2, PK(l2, h2), od, 0, 0, 0);
  od = __builtin_amdgcn_mfma_f32_32x32x16_bf16(pa3, PK(l3, h3), od, 0, 0, 0);
#undef PK
}
DEV void pv_d0(f32x16* o, int vb, bf16x8 pa0, bf16x8 pa1, bf16x8 pa2, bf16x8 pa3) {
  pv_one<0>(o[0], vb, pa0, pa1, pa2, pa3); pv_one<1>(o[1], vb, pa0, pa1, pa2, pa3); pv_one<2>(o[2], vb, pa0, pa1, pa2, pa3); pv_one<3>(o[3], vb, pa0, pa1, pa2, pa3);
}

DEV void attn_body(const bf16_t* __restrict__ Qb, const bf16_t* __restrict__ Kh, const bf16_t* __restrict__ Vh, const bf16_t* __restrict__ Km, const bf16_t* __restrict__ Vm, int qrel, float nslope, float slope, float kmax2, char* lds, f32x16 (&o)[4]) {
  int tid = threadIdx.x; asm volatile("" : "+v"(tid));
  const int wid = __builtin_amdgcn_readfirstlane(tid >> 6), lane = tid & 63, r32 = lane & 31, hi = lane >> 5;
  bf16_t* V_lds = (bf16_t*)lds; bf16_t* K_lds = (bf16_t*)(lds + 2 * SHM_V);
  float* wsl = (float*)(lds + 2 * SHM_V + 2 * SHM_K) + wid * 64; float* li_l = wsl; float* al_l = wsl + 32;
  float m_reg = -1e30f, l_reg = 0;
#pragma unroll
  for (int d = 0; d < 4; ++d) o[d] = f32x16{};
  bf16x8 qr[8];
  const bf16_t* Qw = Qb + (long)(wid * QBLK + r32) * LDA_ + hi * 8;
#pragma unroll
  for (int d0 = 0; d0 < 8; ++d0) qr[d0] = *reinterpret_cast<const bf16x8*>(Qw + d0 * 16);
  const float fbase = (float)(qrel + wid * QBLK + r32 - 4 * hi);
  const int sr = tid >> 4, sc = (tid & 15) * 8, vst0 = v_st(sr, sc), vst1 = v_st(32 + sr, sc);
  const int vb0 = (int)(uintptr_t)V_lds + v_rd_base(lane);
  struct { bf16x8 vs0, vs1, ks0, ks1; } sr_[2];
  float qn2 = 0.f;
#pragma unroll
  for (int d0 = 0; d0 < 8; ++d0)
#pragma unroll
    for (int e = 0; e < 8; ++e) { const float qv = __uint_as_float(((unsigned)(unsigned short)qr[d0][e]) << 16); qn2 = fmaf(qv, qv, qn2); }
  qn2 += __shfl_xor(qn2, 32);
#pragma unroll
  for (int of = 16; of >= 1; of >>= 1) qn2 = fmaxf(qn2, __shfl_xor(qn2, of));
  __syncthreads();
  if (lane == 0) wsl[0] = qn2;
  __syncthreads();
  { const float* w0 = (const float*)(lds + 2 * SHM_V + 2 * SHM_K); float mq = w0[0];
#pragma unroll
    for (int ww = 1; ww < 8; ++ww) mq = fmaxf(mq, w0[ww * 64]);
    qn2 = mq; }
  const float bnd = 2.f * ASCALE * sqrtf(qn2 * kmax2) * 1.02f + 1e-3f;
  const float dskip = fminf((104.f + bnd) / slope, 1e6f);
  int jlo = (int)ceilf(((float)(qrel - 63) - dskip) * (1.f / 64.f)); jlo = jlo < 0 ? 0 : jlo;
  int jhi = (int)floorf(((float)(qrel + 255) + dskip) * (1.f / 64.f)); jhi = jhi > 64 ? 64 : jhi;
  jlo = __builtin_amdgcn_readfirstlane(jlo); jhi = __builtin_amdgcn_readfirstlane(jhi);
  const int ntl = jhi - jlo + 1, NT = ntl + (ntl & 1);
#define TIDX(r) ((r) < ntl ? jlo + (r) : 65)
#define TCL(j) ((j) < 64 ? (j) : 64)
#define SLOAD(i, jt) do { const long k0_ = (long)TCL(jt) * KVBLK; const bf16_t* Vt_ = (jt) == 0 ? Vm : Vh; const bf16_t* Kt_ = (jt) == 0 ? Km : Kh; \
    sr_[i].vs0 = *reinterpret_cast<const bf16x8*>(&Vt_[(k0_ + sr) * LDA_ + sc]); sr_[i].vs1 = *reinterpret_cast<const bf16x8*>(&Vt_[(k0_ + 32 + sr) * LDA_ + sc]); \
    sr_[i].ks0 = *reinterpret_cast<const bf16x8*>(&Kt_[(k0_ + sr) * LDA_ + sc]); sr_[i].ks1 = *reinterpret_cast<const bf16x8*>(&Kt_[(k0_ + 32 + sr) * LDA_ + sc]); } while (0)
#define SWRITE(b, i) do { *(bf16x8*)((char*)V_lds + (b) * SHM_V + vst0) = sr_[i].vs0;          \
    *(bf16x8*)((char*)V_lds + (b) * SHM_V + vst1) = sr_[i].vs1; const int kc = sc * 2;               \
    *(bf16x8*)((char*)K_lds + (b) * SHM_K + KSWZ(sr, kc)) = sr_[i].ks0;                       \
    *(bf16x8*)((char*)K_lds + (b) * SHM_K + KSWZ(32 + sr, kc)) = sr_[i].ks1; } while (0)
#define SWAIT() asm volatile("s_waitcnt vmcnt(4)" ::: "memory")
#define RESC(a) do { if (__any((a) < 1.f)) { if (hi == 0) al_l[r32] = (a); asm volatile("s_waitcnt lgkmcnt(0)" ::: "memory"); \
    _Pragma("unroll") for (int d = 0; d < 4; ++d) _Pragma("unroll") for (int r = 0; r < 16; ++r) o[d][r] *= al_l[crow(r, hi)]; } } while (0)
  f32x16 pA0, pA1, pB0, pB1; float mnA, mnB, alA, alB; bf16x8 pa0, pa1, pa2, pa3;
  constexpr int SE = 0, SO = 1;
  __syncthreads();
  SLOAD(SE, jlo); asm volatile("s_waitcnt vmcnt(0)" ::: "memory"); SWRITE(0, SE); __syncthreads();
  qkt(pA0, pA1, K_lds, qr, r32, hi);
  if (jlo == 0) alibi<1>(pA0, pA1, fbase, nslope); else alibi<0>(pA0, pA1, fbase - 64.f * (float)jlo, nslope);
  partialSM(pA0, pA1, m_reg, mnA, alA);
  SLOAD(SO, TIDX(1)); SLOAD(SE, TIDX(2));
  SWAIT(); SWRITE(1, SO); __syncthreads();
  for (int j = 1; j + 1 < NT; j += 2) {
    SBAR(); qkt(pB0, pB1, (bf16_t*)((char*)K_lds + SHM_K), qr, r32, hi); alibi<0>(pB0, pB1, fbase - 64.f * (float)(jlo + j), nslope);
    finishSM(pA0, pA1, alA, l_reg, pa0, pa1, pa2, pa3); SBAR();
    SLOAD(SO, TIDX(j + 2)); SBAR();
    pv_d0(o, vb0, pa0, pa1, pa2, pa3); partialSM(pB0, pB1, m_reg, mnB, alB);
    __syncthreads(); SWAIT(); SWRITE(0, SE);
    RESC(alB); __syncthreads();
    SBAR(); qkt(pA0, pA1, K_lds, qr, r32, hi); alibi<0>(pA0, pA1, fbase - 64.f * (float)(jlo + j + 1), nslope);
    finishSM(pB0, pB1, alB, l_reg, pa0, pa1, pa2, pa3); SBAR();
    if (j + 3 < NT) SLOAD(SE, TIDX(j + 3)); SBAR();
    pv_d0(o, vb0 + (int)SHM_V, pa0, pa1, pa2, pa3); partialSM(pA0, pA1, m_reg, mnA, alA);
    __syncthreads(); SWAIT(); SWRITE(1, SO);
    RESC(alA); __syncthreads();
  }
  SBAR(); qkt(pB0, pB1, (bf16_t*)((char*)K_lds + SHM_K), qr, r32, hi);
  if (ntl & 1) alibi<2>(pB0, pB1, fbase, nslope); else alibi<0>(pB0, pB1, fbase - 64.f * (float)jhi, nslope);
  finishSM(pA0, pA1, alA, l_reg, pa0, pa1, pa2, pa3); SBAR();
  pv_d0(o, vb0, pa0, pa1, pa2, pa3); partialSM(pB0, pB1, m_reg, mnB, alB);
  __syncthreads(); RESC(alB);
  finishSM(pB0, pB1, alB, l_reg, pa0, pa1, pa2, pa3); SBAR();
  pv_d0(o, vb0 + (int)SHM_V, pa0, pa1, pa2, pa3);
  if (hi == 0) li_l[r32] = l_reg; asm volatile("s_waitcnt lgkmcnt(0)" ::: "memory");
#pragma unroll
  for (int r = 0; r < 16; ++r) { const float rl = __builtin_amdgcn_rcpf(li_l[crow(r, hi)]);
#pragma unroll
    for (int d = 0; d < 4; ++d) o[d][r] *= rl; }
#undef SLOAD
#undef SWRITE
#undef SWAIT
#undef RESC
#undef TCL
#undef TIDX
}

DEV void attn_unit(const Params& P, int u) {
  unsigned char* ws = P.ws;
  const int tid_ = threadIdx.x, wid = __builtin_amdgcn_readfirstlane(tid_ >> 6);
  const int cc_ = u & 255, b = u >> 8, hg = cc_ & 7, qblk = (cc_ >> 3) & 15, vh = (cc_ >> 7) & 1;
  const unsigned long long tlo = 0x4712560374216530ull, thi = 0x1247035621743065ull;
  const unsigned trow = (unsigned)((hg < 4 ? tlo >> (16 * hg) : thi >> (16 * (hg - 4))) & 0xffffull);
  const int h = (int)((trow >> (4 * b)) & 7u);
  const bf16_t* dq = (const bf16_t*)(ws + O_DQ); const bf16_t* dk = (const bf16_t*)(ws + O_DK); const bf16_t* dv = (const bf16_t*)(ws + O_DV);
  const size_t brow = (size_t)b * LP; const int qrel = 64 + qblk * 256;
  const float slope = __int_as_float(0x3f800000 - ((h + 1) << 23));
  const float nslope = -slope / ASCALE;
  unsigned* stash = (unsigned*)(shm_raw + SHM_ATTN);
  f32x16 o[4];
  for (int mp = 0; mp < 2; ++mp) {
    attn_body(dq + (brow + qrel) * 2048 + h * 256 + mp * 128, dk + brow * 2048 + h * 256 + mp * 128, dv + brow * 2048 + h * 256 + vh * 128,
              (const bf16_t*)(ws + O_DKM) + h * 256 + mp * 128, (const bf16_t*)(ws + O_DVM) + h * 256 + vh * 128, qrel, nslope, slope,
              __uint_as_float(((const unsigned*)(ws + O_KMAX))[b * 16 + h * 2 + mp]), (char*)shm_raw, o);
    if (mp == 0) {
      int tid = tid_; asm volatile("" : "+v"(tid));
#pragma unroll
      for (int d = 0; d < 4; ++d)
#pragma unroll
        for (int r = 0; r < 16; r += 2) stash[(d * 8 + (r >> 1)) * 512 + tid] = pk2(o[d][r], o[d][r + 1]);
    }
  }
  int tid = tid_; asm volatile("" : "+v"(tid));
  const int lane = tid & 63, r32 = lane & 31, hi = lane >> 5;
  const float lam = ((const float*)(shm_raw + DYN_LDS_MAIN + 8))[0];
  bf16_t* dd = (bf16_t*)(ws + O_DD); float* dst = (float*)(ws + O_DST);
  const size_t prow = brow + qrel + wid * 32;
  float ss[16];
#pragma unroll
  for (int r = 0; r < 16; ++r) ss[r] = 0.f;
#pragma unroll
  for (int d = 0; d < 4; ++d)
#pragma unroll
    for (int r = 0; r < 16; r += 2) {
      const unsigned s2 = stash[(d * 8 + (r >> 1)) * 512 + tid];
      const float v0 = __uint_as_float(s2 << 16) - lam * o[d][r], v1 = __uint_as_float(s2 & 0xffff0000u) - lam * o[d][r + 1];
      ss[r] += v0 * v0; ss[r + 1] += v1 * v1;
      dd[(prow + crow(r, hi)) * 2048 + h * 256 + vh * 128 + d * 32 + r32] = f2bf(v0);
      dd[(prow + crow(r + 1, hi)) * 2048 + h * 256 + vh * 128 + d * 32 + r32] = f2bf(v1);
    }
#pragma unroll
  for (int r = 0; r < 16; ++r) {
    float s = ss[r];
#pragma unroll
    for (int of = 16; of >= 1; of >>= 1) s += __shfl_xor(s, of);
    if (r32 == 0) dst[(prow + crow(r, hi)) * 16 + h * 2 + vh] = s;
  }
}

DEV void l2_sweep(const Params& P) {
  const f32x4* src = (const f32x4*)P.x + (size_t)(blockIdx.x & 63) * 131072;
  f32x4 a = (f32x4){0.f, 0.f, 0.f, 0.f};
  for (int i = threadIdx.x; i < 131072; i += NTHR) a += src[i];
  if (a[0] + a[1] + a[2] + a[3] == 123456.789f) ((float*)(P.ws + O_DST))[0] = 1.f;
}
#define XB_TMO      128
#define XB_XCNT(j)  (256  + 64 * (j))
#define XB_XSUB(j)  (1280 + 64 * (j))
#define XB_XGEN(j)  (2304 + 64 * (j))
#define XB_TOP      3328
#define XB_TOPGEN   3392
#define XCD_BAR_WORDS 3456
#define XB_SPIN_CAP (1u << 22)
DEV unsigned xb_ld(unsigned* p) { return __hip_atomic_load(p, __ATOMIC_RELAXED, __HIP_MEMORY_SCOPE_AGENT); }
DEV unsigned xb_add(unsigned* p, unsigned v) { return __hip_atomic_fetch_add(p, v, __ATOMIC_RELAXED, __HIP_MEMORY_SCOPE_AGENT); }
DEV unsigned xb_xcc_id() { return (unsigned)__builtin_amdgcn_s_getreg((3 << 11) | 20) & 0xFu; }
#define XB_SPIN(cond, bar) do { unsigned _sp = 0; while (cond) { __builtin_amdgcn_s_sleep(1); \
    if ((++_sp & 255u) == 0u) { if (xb_ld(&(bar)[XB_TMO])) break; if (_sp > XB_SPIN_CAP) { atomicAdd(&(bar)[XB_TMO], 1u); break; } } } } while (0)
struct XcdBarrier { unsigned* bar; unsigned x; volatile LAS unsigned* st; };
DEV XcdBarrier xcd_barrier_post(unsigned* bar, volatile LAS unsigned* st) {
  XcdBarrier b; b.bar = bar; b.x = xb_xcc_id(); b.st = st;
  if (threadIdx.x == 0) (void)xb_add(&bar[XB_XCNT(b.x)], 1u);
  return b;
}
DEV void xcd_barrier_complete(unsigned* bar, unsigned x, unsigned& nloc, unsigned& nx) {
  const unsigned G = gridDim.x * gridDim.y * gridDim.z;
  unsigned sum, cnt, mine, sp = 0u;
  for (;;) {
    sum = 0u; cnt = 0u; mine = 0u;
#pragma unroll
    for (unsigned j = 0; j < 16; ++j) { const unsigned c = xb_ld(&bar[XB_XCNT(j)]); sum += c; cnt += (c > 0u) ? 1u : 0u; mine = (j == x) ? c : mine; }
    if (sum == G) break;
    __builtin_amdgcn_s_sleep(1);
    if ((++sp & 255u) == 0u) { if (xb_ld(&bar[XB_TMO])) break; if (sp > XB_SPIN_CAP) { atomicAdd(&bar[XB_TMO], 1u); break; } }
  }
  nloc = mine > 0u ? mine : 1u; nx = cnt > 0u ? cnt : 1u;
}
DEV void xcd_barrier(const XcdBarrier& b) {
  asm volatile("s_waitcnt vmcnt(0) lgkmcnt(0)" ::: "memory");
  __syncthreads();
  if (threadIdx.x == 0) {
    unsigned* bar = b.bar;
    __builtin_amdgcn_s_waitcnt(0);
    unsigned nloc = b.st[0], nx = b.st[1];
    if (nloc == 0u) { xcd_barrier_complete(bar, b.x, nloc, nx); b.st[0] = nloc; b.st[1] = nx; }
    const unsigned old = xb_add(&bar[XB_XSUB(b.x)], 1u);
    const unsigned gen = old / nloc;
    if (old + 1u == (gen + 1u) * nloc) {
      __builtin_amdgcn_fence(__ATOMIC_RELEASE, "agent");
      asm volatile("s_waitcnt vmcnt(0)" ::: "memory");
      const unsigned og = xb_add(&bar[XB_TOP], 1u);
      const unsigned tg = og / nx;
      if (og + 1u == (tg + 1u) * nx) xb_add(&bar[XB_TOPGEN], 1u);
      else XB_SPIN(xb_ld(&bar[XB_TOPGEN]) == tg, bar);
      __builtin_amdgcn_fence(__ATOMIC_ACQUIRE, "agent");
      xb_add(&bar[XB_XGEN(b.x)], 1u);
      asm volatile("s_waitcnt vmcnt(0)" ::: "memory");
    } else {
      XB_SPIN(xb_ld(&bar[XB_XGEN(b.x)]) == gen, bar);
      __builtin_amdgcn_fence(__ATOMIC_ACQUIRE, "agent");
      asm volatile("s_waitcnt vmcnt(0)" ::: "memory");
    }
  }
  __syncthreads();
}
DEV void gsync_now(const Params& P) {
  XcdBarrier b; b.bar = (unsigned*)(P.ws + O_BAR); b.x = xb_xcc_id(); b.st = (volatile LAS unsigned*)((LAS unsigned char*)shm_raw + DYN_LDS_MAIN);
  xcd_barrier(b);
}
#define gsync(g) gsync_now(P)
#ifndef REP
#define REP 0
#endif
#ifndef DBG_STOP
#define DBG_STOP 0
#endif
DEV void dbg_dump(const Params& P, size_t off, int ld = 2048) {
  const int tid = threadIdx.x, lane = tid & 63, gw = (blockIdx.x * NTHR + tid) >> 6, nw = (gridDim.x * NTHR) >> 6;
  const bf16_t* buf = (const bf16_t*)(P.ws + off);
  for (int r = gw; r < TR; r += nw) {
    const size_t prow = (size_t)(r >> 12) * LP + 64 + (r & 4095);
    for (int i = 0; i < 8; ++i) { const int c = i * 256 + lane * 4; f32x4 v = (f32x4){0.f, 0.f, 0.f, 0.f}; if (c < ld) v = load_bf4(buf + prow * ld + c); for (int j = 0; j < 4; ++j) if (!(fabsf(v[j]) < 1e30f)) v[j] = 10000.f; *(f32x4*)(P.out + (size_t)r * 2048 + c) = v; }
  }
}
#define STOP_AT(k, off) if (DBG_STOP == (k)) { dbg_dump(P, off); return; }
#define STOP_AT2(k, off) if (DBG_STOP == (k)) { dbg_dump(P, off, 1024); return; }
#ifndef ONLY
#define PH(n) true
#else
#define PH(n) ((ONLY) == (n))
#endif
__global__ void __launch_bounds__(NTHR, 2) mega(Params P) {
  cg::grid_group grid = cg::this_grid();
  unsigned char* ws = P.ws;
  volatile LAS unsigned* xst = (volatile LAS unsigned*)((LAS unsigned char*)shm_raw + DYN_LDS_MAIN);
  if (threadIdx.x == 0) { xst[0] = 0u; xst[1] = 0u; xst[2] = 0u; xst[3] = 0u; }
  __syncthreads();
  (void)xcd_barrier_post((unsigned*)(ws + O_BAR), xst);
  if (P.ws == nullptr) grid.sync();
  if (PH(0)) phase_prologue(P);
  if (REP & 4) phase_prologue(P);
  gsync(grid);
  if (PH(1)) for (int gp = G_FFN1_GU; gp <= G_WIN_META; ++gp) { gemm_phase(P, gp); if ((REP & 1) || ((REP & 64) && gp == G_FFN1_GU) || ((REP & 128) && gp == G_FFN1_D)) gemm_phase(P, gp); gsync(grid); if (gp == G_FFN1_D) { STOP_AT(1, O_ACTB) } if (gp == G_WIN_META) { STOP_AT(6, O_GV) } }
  if (PH(2)) for (int u = blockIdx.x; u < 16 * 65; u += gridDim.x) gla_prep_unit(P, u);
  if (REP & 32) for (int u = blockIdx.x; u < 16 * 65; u += gridDim.x) gla_prep_unit(P, u, true);
  gsync(grid);
  STOP_AT2(7, O_KIB)
  STOP_AT2(10, O_QDB)
  if (DBG_STOP == 11) {
    const int tid = threadIdx.x, lane = tid & 63, gw = (blockIdx.x * NTHR + tid) >> 6, nw = (gridDim.x * NTHR) >> 6;
    const bf16_t* b0 = (const bf16_t*)(ws + O_GK); const bf16_t* b1 = (const bf16_t*)(ws + O_GV); const float* dl = (const float*)(ws + O_DL);
    for (int r = gw; r < TR; r += nw) { const size_t prow = (size_t)(r >> 6) * LP + (r & 63);
      for (int i = 0; i < 8; ++i) { const int c = i * 256 + lane * 4; f32x4 v = (f32x4){0.f, 0.f, 0.f, 0.f};
        if (r < 256) v = c < 1024 ? load_bf4(b0 + prow * 1024 + c) : load_bf4(b1 + prow * 2048 + c - 1024);
        else if (r < 272 && c < 256) v = *(const f32x4*)(dl + (size_t)((r - 256) * 2) * 65 * 256 + c);
        *(f32x4*)(P.out + (size_t)r * 2048 + c) = v; } }
    return;
  }
  if (DBG_STOP == 9) {
    const int tid = threadIdx.x, lane = tid & 63, gw = (blockIdx.x * NTHR + tid) >> 6, nw = (gridDim.x * NTHR) >> 6;
    const bf16_t* b0 = (const bf16_t*)(ws + O_GQ); const bf16_t* b1 = (const bf16_t*)(ws + O_GK);
    for (int r = gw; r < TR; r += nw) { const size_t prow = (size_t)(r >> 12) * LP + 64 + (r & 4095);
      for (int i = 0; i < 8; ++i) { const int c = i * 256 + lane * 4; *(f32x4*)(P.out + (size_t)r * 2048 + c) = c < 1024 ? load_bf4(b0 + prow * 1024 + c) : load_bf4(b1 + prow * 1024 + c - 1024); } }
    return;
  }
  if (PH(3)) for (int u = blockIdx.x; u < 256; u += gridDim.x) gla_scan_unit(P, u);
  if (REP & 8) for (int u = blockIdx.x; u < 256; u += gridDim.x) gla_scan_unit(P, u);
  gsync(grid);
  if (DBG_STOP == 8) {
    const int tid = threadIdx.x, lane = tid & 63, gw = (blockIdx.x * NTHR + tid) >> 6, nw = (gridDim.x * NTHR) >> 6;
    const bf16_t* of = (const bf16_t*)P.out; const bf16_t* ob = of + (size_t)TR * 2048; bf16_t* g = (bf16_t*)(ws + O_GR);
    for (int r = gw; r < TR; r += nw) { const size_t prow = (size_t)(r >> 12) * LP + 64 + (r & 4095);
      for (int i = 0; i < 8; ++i) { const int c = i * 256 + lane * 4; store_bf4(g + prow * 2048 + c, load_bf4(of + (size_t)r * 2048 + c) + load_bf4(ob + (size_t)r * 2048 + c)); } }
    gsync(grid);
    dbg_dump(P, O_GR); return;
  }
  if (PH(4)) for (int u = blockIdx.x; u < 1024; u += gridDim.x) gla_finish_unit(P, u);
  if (REP & 16) for (int u = blockIdx.x; u < 1024; u += gridDim.x) gla_finish_unit(P, u, true);
  gsync(grid);
  STOP_AT(2, O_GR)
  if (PH(1)) gemm_phase(P, G_WIN_B);
  if (REP & 1) gemm_phase(P, G_WIN_B);
  gsync(grid);
  if (PH(5)) {
    int tid = threadIdx.x; asm volatile("" : "+v"(tid)); const int lane = tid & 63;
    const int gw = (blockIdx.x * NTHR + tid) >> 6, nw = (gridDim.x * NTHR) >> 6;
    const int kb = gw & 3; const bf16_t* dk = (const bf16_t*)(ws + O_DK); const bf16_t* dkm = (const bf16_t*)(ws + O_DKM);
    unsigned* km = (unsigned*)(ws + O_KMAX);
    float mx = 0.f;
    for (int r = gw >> 2; r < SEQ + 16; r += nw >> 2) {
      const bf16_t* rowp = r < SEQ ? dk + ((size_t)kb * LP + 64 + r) * 2048 : dkm + (size_t)(48 + r - SEQ) * 2048;
      float ssq = 0.f;
#pragma unroll
      for (int i = 0; i < 8; ++i) { const f32x4 v = load_bf4(rowp + lane * 32 + i * 4); ssq += v[0] * v[0] + v[1] * v[1] + v[2] * v[2] + v[3] * v[3]; }
      ssq += __shfl_xor(ssq, 1); ssq += __shfl_xor(ssq, 2);
      mx = fmaxf(mx, ssq);
    }
    if ((lane & 3) == 0) atomicMax(km + kb * 16 + (lane >> 2), __float_as_uint(mx));
  }
  gsync(grid);
  if (PH(5)) {
    float s1 = 0.f, s2 = 0.f;
    for (int i = 0; i < 128; ++i) { s1 = fmaf(P.lq1[i], P.lk1[i], s1); s2 = fmaf(P.lq2[i], P.lk2[i], s2); }
    const float lam = __expf(s1) - __expf(s2) + 0.2f;
    { float* lw = (float*)(shm_raw + DYN_LDS_MAIN + 8); if (threadIdx.x == 0) lw[0] = lam; }
    __syncthreads();
    for (int u = blockIdx.x; u < 1024; u += gridDim.x) attn_unit(P, u);
    if (REP & 2) for (int u = blockIdx.x; u < 1024; u += gridDim.x) attn_unit(P, u);
  }
  gsync(grid);
  if (PH(6)) {
    int tid = threadIdx.x; asm volatile("" : "+v"(tid)); const int lane = tid & 63;
    const int gw = (blockIdx.x * NTHR + tid) >> 6, nw = (gridDim.x * NTHR) >> 6;
    bf16_t* dd = (bf16_t*)(ws + O_DD); const float* dst = (const float*)(ws + O_DST);
    for (int r = gw; r < TR; r += nw) {
      const size_t prow = (size_t)(r >> 12) * LP + 64 + (r & 4095);
      const int col = lane * 32, hh = col >> 8;
      const float rs = rsqrtf((dst[prow * 16 + hh * 2] + dst[prow * 16 + hh * 2 + 1]) * (1.f / 256.f) + EPS) * 0.8f;
#pragma unroll
      for (int i = 0; i < 8; ++i) { bf16_t* p = dd + prow * 2048 + col + i * 4; f32x4 v = load_bf4(p); const f32x4 nw4 = *(const f32x4*)(P.dnorm + ((col + i * 4) & 255)); v = v * nw4 * rs; store_bf4(p, v); }
    }
    int tbase = 0, t = blockIdx.x; bf16_t* wf = (bf16_t*)(ws + O_WF);
    transpose_job(P.w2g, 2048, DFF, wf + (size_t)DFF * 2048, P.n2, false, tbase, t);
    transpose_job(P.w2u, 2048, DFF, wf + (size_t)2 * DFF * 2048, P.n2, false, tbase, t);
    transpose_job(P.w2d, DFF, 2048, wf, nullptr, false, tbase, t);
  }
  gsync(grid);
  STOP_AT(3, O_DD)
  if (PH(1)) for (int gp = G_MERGE; gp <= G_FFN2_D; ++gp) { gemm_phase(P, gp); if (((REP & 1) && gp != G_FFN2_D) || ((REP & 256) && gp == G_OUT) || ((REP & 512) && gp == G_MERGE)) gemm_phase(P, gp); gsync(grid); if (gp == G_MERGE) { STOP_AT(4, O_MRG) } if (gp == G_OUT) { STOP_AT(5, O_ACTB) } }
  if (PH(7)) {
    int tid = threadIdx.x; asm volatile("" : "+v"(tid)); const int lane = tid & 63;
    const int gw = (blockIdx.x * NTHR + tid) >> 6, nw = (gridDim.x * NTHR) >> 6;
    for (int r = gw; r < TR; r += nw) {
      float* p = P.out + (size_t)r * 2048;
      f32x4 v[8]; float ss = 0.f;
#pragma unroll
      for (int i = 0; i < 8; ++i) { v[i] = *(f32x4*)(p + i * 256 + lane * 4); ss += v[i][0] * v[i][0] + v[i][1] * v[i][1] + v[i][2] * v[i][2] + v[i][3] * v[i][3]; }
#pragma unroll
      for (int o = 32; o >= 1; o >>= 1) ss += __shfl_xor(ss, o);
      const float rs = rsqrtf(ss * (1.f / 2048.f) + EPS);
#pragma unroll
      for (int i = 0; i < 8; ++i) { const int c = i * 256 + lane * 4; const f32x4 g = *(const f32x4*)(P.nfin + c); *(f32x4*)(p + c) = v[i] * g * rs; }
    }
  }
}

constexpr size_t DYN_LDS = DYN_LDS_MAIN + 16;
static_assert(DYN_LDS >= 8 * HT * 2 && DYN_LDS >= SHM_ATTN + 65536, "lds");

extern "C" void kernel_launch(void* const* d_in, const int* in_sizes, int n_in, void* d_out, int out_size, void* d_ws, size_t ws_size, hipStream_t stream) {
  if (n_in != 26 || ws_size < WS_TOTAL || out_size != TR * 2048) { fprintf(stderr, "kernel_launch: bad shapes n_in %d ws %zu need %zu out %d\n", n_in, ws_size, WS_TOTAL, out_size); return; }
  static int grid_blocks = 0;
  if (!grid_blocks) {
    hipFuncSetAttribute((const void*)mega, hipFuncAttributeMaxDynamicSharedMemorySize, (int)DYN_LDS);
    int dev = 0, cus = 0, per_cu = 0;
    hipGetDevice(&dev);
    hipDeviceGetAttribute(&cus, hipDeviceAttributeMultiprocessorCount, dev);
    hipOccupancyMaxActiveBlocksPerMultiprocessor(&per_cu, mega, NTHR, DYN_LDS);
    if (per_cu < 1) per_cu = 1;
    grid_blocks = cus;
  }
  Params p{};
  const float** pp = (const float**)&p;
  for (int i = 0; i < 26; ++i) pp[i] = (const float*)d_in[i];
  p.out = (float*)d_out; p.ws = (unsigned char*)d_ws;
  hipMemsetAsync((unsigned char*)d_ws + O_BAR, 0, 16384, stream);
  void* args[] = {&p};
  hipError_t e = hipLaunchCooperativeKernel((void*)mega, dim3(grid_blocks), dim3(NTHR), args, DYN_LDS, stream);
  if (e != hipSuccess) fprintf(stderr, "cooperative launch failed: %s (grid %d)\n", hipGetErrorString(e), grid_blocks);
}
```

```cpp
#include <hip/hip_runtime.h>
#include <hip/hip_cooperative_groups.h>
#include <stdint.h>
#include <cstdio>
namespace cg = cooperative_groups;

#define DEV __device__ __forceinline__
typedef unsigned short bf16_t;
using bf16x8 = __attribute__((ext_vector_type(8))) short;
using s16x4  = __attribute__((ext_vector_type(4))) short;
using f32x4  = __attribute__((ext_vector_type(4))) float;
using f32x16 = __attribute__((ext_vector_type(16))) float;
using u32x4  = __attribute__((ext_vector_type(4))) unsigned;
using u32x2  = __attribute__((ext_vector_type(2))) unsigned;

constexpr int DM = 2048, DFF = 5504, NB = 4, SEQ = 4096, LP = 4160, RP = NB * LP  , TR = NB * SEQ  ;
constexpr int INW = 16416;
constexpr float EPS = 1e-6f;
constexpr size_t DYN_LDS_MAIN = 4 * 64 * 264 * 2 + 64 * 32 * 4;
constexpr int NTHR = 512;

constexpr size_t SZ_ACT = (size_t)RP * 2048 * 2;
constexpr size_t SZ_HALF = (size_t)RP * 1024 * 2;
constexpr size_t SZ_SQ = (size_t)2048 * 2048 * 2;
constexpr size_t SZ_FW = (size_t)DFF * 2048 * 2;
constexpr size_t SZ_HID = (size_t)RP * DFF * 2;
constexpr size_t O_ACTB = 0;
constexpr size_t O_WIN = O_ACTB + SZ_ACT;
constexpr size_t O_WS = O_WIN + SZ_ACT;
constexpr size_t O_WF = O_WS + 3 * SZ_SQ;
constexpr size_t O_HID = O_WF + 3 * SZ_FW;
constexpr size_t O_R = O_HID + SZ_HID;
constexpr size_t O_F = O_R;
constexpr size_t O_GR = O_F + SZ_ACT;
constexpr size_t O_P = O_GR + SZ_ACT;
constexpr size_t SZ_P = (size_t)16 * 65 * 4096 * 2;
constexpr size_t O_LOW = O_P + SZ_P;
constexpr size_t O_DL = O_LOW + (size_t)RP * 32 * 4;
constexpr size_t O_ST = O_DL + (size_t)16 * 2 * 65 * 256 * 4;
constexpr size_t O_ST1 = O_ST + (size_t)RP * 4, O_ST2 = O_ST1 + (size_t)RP * 32 * 4;
constexpr size_t O_DST = O_ST2 + (size_t)RP * 32 * 4;
constexpr size_t O_DKM = O_DST + (size_t)RP * 16 * 4;
constexpr size_t O_DVM = O_DKM + (size_t)64 * 2048 * 2;
constexpr size_t O_BAR = O_DVM + (size_t)64 * 2048 * 2;
constexpr size_t O_KMAX = O_BAR + 14336;
constexpr size_t O_MCNT = O_BAR + 14720;
constexpr size_t WS_TOTAL = O_BAR + 16384;
constexpr size_t O_GQ = O_WF + SZ_FW, O_GK = O_HID + (size_t)256 * DFF * 2, O_GV = O_GK + SZ_HALF, O_QDB = O_GV + SZ_ACT, O_KIB = O_QDB + SZ_HALF;
static_assert(O_GQ + SZ_HALF <= O_HID && O_KIB + SZ_HALF <= O_R, "gla overlay 2");
constexpr size_t O_DQ = O_WF, O_DK = O_DQ + SZ_ACT, O_DV = O_DK + SZ_ACT;
constexpr size_t O_MRG = O_DK;
constexpr size_t O_DD = O_WIN;
static_assert(O_DV + SZ_ACT <= O_R, "diff overlay");

struct Params {
  const float *x, *meta, *n1, *w1g, *w1u, *w1d, *nmix, *win, *wa2f, *baf, *wa2b, *bab, *gnorm,
      *lq1, *lk1, *lq2, *lk2, *dnorm, *wbg, *wbd, *wout, *n2, *w2g, *w2u, *w2d, *nfin;
  float* out;
  unsigned char* ws;
};

extern __shared__ __attribute__((aligned(16))) unsigned char shm_raw[];
#define shm ((bf16_t*)shm_raw)

DEV float bf2f(bf16_t v) { return __uint_as_float(((unsigned)v) << 16); }
typedef __bf16 bf16x2_t __attribute__((ext_vector_type(2)));
typedef float f32x2_t __attribute__((ext_vector_type(2)));
DEV unsigned pk2(float lo, float hi) { f32x2_t v = {lo, hi}; bf16x2_t b = __builtin_convertvector(v, bf16x2_t); return __builtin_bit_cast(unsigned, b); }
DEV bf16_t f2bf(float f) { return (bf16_t)(pk2(f, 0.f) & 0xffffu); }
DEV float to_sgpr(float v) { float r; asm volatile("v_readfirstlane_b32 %0, %1" : "=s"(r) : "v"(v)); return r; }
DEV float sigm(float v) { return 1.f / (1.f + __expf(-v)); }

constexpr int BM = 256, BK = 64, HALF = 128, HT = HALF * BK, NXCD = 8, WGM = 8;
DEV int lds_byte(int r, int c) { int st = (r >> 4) * 2 + (c >> 5), rr = r & 15, cc = c & 31, ob = rr * 64 + cc * 2; return st * 1024 + (ob ^ (((ob >> 9) & 1) << 5)); }
DEV void stage_rc(int b, int& R, int& C) { int st = b / 1024, sb = b % 1024, swz = sb ^ (((sb >> 9) & 1) << 5); R = (st >> 1) * 16 + swz / 64; C = (st & 1) * 32 + (swz % 64) / 2; }

#define LAS __attribute__((address_space(3)))
constexpr int HTB = HALF * BK * 2;
#define PG8_SA(b, h) (((b) * 2 + (h)) * HTB)
#define PG8_SB(b, h) ((4 + (b) * 2 + (h)) * HTB)
#define STAGE(bufoff, gbase, voff) do { _Pragma("unroll") for (int _i = 0; _i < 2; ++_i) \
    __builtin_amdgcn_global_load_lds((const unsigned*)((const char*)(gbase) + (voff)[_i]), (LAS unsigned*)(lds + (bufoff) + ldsw + _i * 8192), 16, 0, 0); } while (0)
#define LDA(dst, b, h) do { _Pragma("unroll") for (int m = 0; m < 4; ++m) _Pragma("unroll") for (int k = 0; k < 2; ++k) dst[m][k] = *(const LAS bf16x8*)(lds + PG8_SA(b, h) + aoff + m * 2048 + k * 1024); } while (0)
#define LDB(dst, b, h) do { _Pragma("unroll") for (int n = 0; n < 2; ++n) _Pragma("unroll") for (int k = 0; k < 2; ++k) dst[n][k] = *(const LAS bf16x8*)(lds + PG8_SB(b, h) + boff + n * 2048 + k * 1024); } while (0)
#define MMA(ai, bj, At_, Bt_) do { __builtin_amdgcn_s_setprio(1); \
    _Pragma("unroll") for (int m = 0; m < 4; ++m) _Pragma("unroll") for (int n = 0; n < 2; ++n) _Pragma("unroll") for (int k = 0; k < 2; ++k) \
      acc[ai][bj][m][n] = __builtin_amdgcn_mfma_f32_16x16x32_bf16(Bt_[n][k], At_[m][k], acc[ai][bj][m][n], 0, 0, 0); \
    __builtin_amdgcn_s_setprio(0); } while (0)
#define WAIT_V(n) asm volatile("s_waitcnt vmcnt(" #n ")" ::: "memory")
#define WAIT_L(n) asm volatile("s_waitcnt lgkmcnt(" #n ")" ::: "memory")
#define BAR __builtin_amdgcn_s_barrier()
#define SCHED __builtin_amdgcn_sched_barrier(0)

DEV void gemm_mainloop(const char* __restrict__ cA, const char* __restrict__ cB0, const char* __restrict__ cB1, const int K, f32x4 (&acc)[2][2][4][2]) {
  LAS unsigned char* lds = (LAS unsigned char*)shm_raw;
  int tid = threadIdx.x; asm volatile("" : "+v"(tid));
  const int wid = __builtin_amdgcn_readfirstlane(tid >> 6), lane = tid & 63, wr = wid >> 2, wc = wid & 3, fr = lane & 15, fq = lane >> 4;
  unsigned voff[2];
#pragma unroll
  for (int i = 0; i < 2; ++i) { int R, C; stage_rc(tid * 16 + i * 8192, R, C); voff[i] = (unsigned)(R * K + C) * 2u; }
  const size_t kstep = (size_t)(BK * 2), hstep = (size_t)HALF * K * 2;
  const unsigned ldsw = (unsigned)wid * 1024u;
  const int aoff = lds_byte(wr * 64 + fr, fq * 8), boff = lds_byte(wc * 32 + fr, fq * 8);
  bf16x8 At[4][2], B0[2][2], B1[2][2];
  const int nt = K / BK;
  STAGE(PG8_SB(0, 0), cB0, voff); STAGE(PG8_SB(0, 1), cB1, voff); STAGE(PG8_SA(0, 0), cA, voff); STAGE(PG8_SA(0, 1), cA + hstep, voff);
  if (wr == 1) BAR;
  WAIT_V(2); BAR;
  STAGE(PG8_SB(1, 0), cB0 + kstep, voff); STAGE(PG8_SA(1, 0), cA + kstep, voff); STAGE(PG8_SB(1, 1), cB1 + kstep, voff);
  WAIT_V(6); BAR;
  for (int t = 0; t < nt; t += 2) {
    const int t2 = (t == nt - 2) ? 0 : t + 2;
    const char* a1 = cA + (size_t)(t + 1) * kstep + hstep;
    const char* a2 = cA + (size_t)t2 * kstep; const char* b02 = cB0 + (size_t)t2 * kstep; const char* b12 = cB1 + (size_t)t2 * kstep;
    LDB(B0, 0, 0); LDB(B1, 0, 1); SCHED; LDA(At, 0, 0); STAGE(PG8_SA(1, 1), a1, voff);
    WAIT_V(8); WAIT_L(0); BAR; MMA(0, 0, At, B0); MMA(0, 1, At, B1); BAR; SCHED;
    LDA(At, 0, 1); STAGE(PG8_SB(0, 0), b02, voff); STAGE(PG8_SB(0, 1), b12, voff); STAGE(PG8_SA(0, 0), a2, voff);
    WAIT_V(8); WAIT_L(0); BAR; MMA(1, 0, At, B0); MMA(1, 1, At, B1); BAR; SCHED;
    LDB(B0, 1, 0); LDB(B1, 1, 1); SCHED; LDA(At, 1, 0); STAGE(PG8_SA(0, 1), a2 + hstep, voff);
    WAIT_V(8); WAIT_L(0); BAR; MMA(0, 0, At, B0); MMA(0, 1, At, B1); BAR; SCHED;
    LDA(At, 1, 1); STAGE(PG8_SB(1, 0), b02 + kstep, voff); STAGE(PG8_SB(1, 1), b12 + kstep, voff); STAGE(PG8_SA(1, 0), a2 + kstep, voff);
    WAIT_V(8); WAIT_L(0); BAR; MMA(1, 0, At, B0); MMA(1, 1, At, B1); BAR; SCHED;
  }
  WAIT_V(0);
  if (wr == 0) BAR;
  BAR;
}

enum { G_FFN1_GU = 0, G_FFN1_D, G_WIN_A, G_WIN_META, G_WIN_B, G_MERGE, G_OUT, G_FFN2_GU, G_FFN2_D };

DEV void store_bf4(bf16_t* p, f32x4 v) { u32x2 w; w.x = pk2(v[0], v[1]); w.y = pk2(v[2], v[3]); *(u32x2*)p = w; }
DEV f32x4 load_bf4(const bf16_t* p) { u32x2 w = *(const u32x2*)p; f32x4 v; v[0] = __uint_as_float(w.x << 16); v[1] = __uint_as_float(w.x & 0xffff0000u); v[2] = __uint_as_float(w.y << 16); v[3] = __uint_as_float(w.y & 0xffff0000u); return v; }

DEV void main_order(int L, int nN, int& pm, int& pn) {
  const int nwg = 64 * nN;
  int wgid = L; { const int q = nwg / NXCD, r = nwg % NXCD, xcd = wgid % NXCD, off = wgid / NXCD; wgid = (xcd < r ? xcd * (q + 1) : r * (q + 1) + (xcd - r) * q) + off; }
  const int nig = WGM * nN, gid = wgid / nig, fm = gid * WGM;
  pm = fm + ((wgid % nig) % WGM); pn = (wgid % nig) / WGM;
}

DEV void gemm_phase(const Params& P, const int gp) {
  int tid = threadIdx.x; asm volatile("" : "+v"(tid));
  const int wid = __builtin_amdgcn_readfirstlane(tid >> 6), lane = tid & 63, wr = wid >> 2, wc = wid & 3, fr_ = lane & 15, fq_ = lane >> 4;
  unsigned char* ws = P.ws;
  float* stats = (float*)(ws + O_ST);
  int nN, nPre = 0, nMain, nMeta = 0, pnoff = 0;
  switch (gp) {
    case G_FFN1_GU: nN = 43; nMeta = 43; break;
    case G_FFN1_D: nN = 8; break;
    case G_WIN_A: nN = 25; nPre = 8; nMeta = 65; break;
    case G_WIN_META: nN = 0; nMeta = 65; break;
    case G_WIN_B: nN = 40; pnoff = 25; break;
    case G_MERGE: nN = 8; break;
    case G_OUT: nN = 8; break;
    case G_FFN2_GU: nN = 43; break;
    default: nN = 8; break;
  }
  nMain = 64 * nN;
  const int ntiles = nPre + nMain + nMeta;
  for (int t = blockIdx.x; t < ntiles; t += gridDim.x) {
    int pm, pn, kind = gp;
    bool meta = false;
    if (t < nPre) { pm = 64; pn = t; meta = true; kind = G_FFN1_D; }
    else if (t < nPre + nMain) { main_order(t - nPre, nN, pm, pn); pn += pnoff; }
    else { pm = 64; pn = t - nPre - nMain; meta = true; }
    const int arow0 = meta ? 0 : (pm >> 4) * LP + 64 + (pm & 15) * 256;
    const int nrow0 = pm * 256;
    if (gp == G_WIN_A && t >= nPre + nMain) {
      if (tid == 0) {
        unsigned* cnt = (unsigned*)(ws + O_MCNT); unsigned sp = 0;
        while (__hip_atomic_load(cnt, __ATOMIC_RELAXED, __HIP_MEMORY_SCOPE_AGENT) < 8u) { __builtin_amdgcn_s_sleep(2); if (++sp > (1u << 24)) break; }
        __builtin_amdgcn_fence(__ATOMIC_ACQUIRE, "agent");
        asm volatile("s_waitcnt vmcnt(0)" ::: "memory");
      }
      __syncthreads();
    }
    const bf16_t *A, *B0p, *B1p; int K;
    switch (kind) {
      case G_FFN1_GU: A = (const bf16_t*)(ws + O_ACTB); K = 2048; B0p = (const bf16_t*)(ws + O_WF) + (size_t)DFF * 2048 + (size_t)pn * 128 * 2048; B1p = B0p + (size_t)DFF * 2048; break;
      case G_FFN2_GU: A = (const bf16_t*)(ws + O_ACTB); K = 2048; B0p = (const bf16_t*)(ws + O_WF) + (size_t)DFF * 2048 + (size_t)pn * 128 * 2048; B1p = B0p + (size_t)DFF * 2048; break;
      case G_FFN1_D: case G_FFN2_D: A = (const bf16_t*)(ws + O_HID); K = DFF; B0p = (const bf16_t*)(ws + O_WF) + (size_t)pn * 256 * DFF; B1p = B0p + (size_t)128 * DFF; break;
      case G_WIN_A: case G_WIN_META: case G_WIN_B: A = (const bf16_t*)(ws + O_ACTB); K = 2048; B0p = (const bf16_t*)(ws + O_WIN) + (size_t)pn * 256 * 2048; B1p = B0p + (size_t)128 * 2048; break;
      case G_MERGE: A = (const bf16_t*)(ws + O_GR); K = 2048; B0p = (const bf16_t*)(ws + O_WS) + (size_t)pn * 256 * 2048; B1p = B0p + (size_t)128 * 2048; break;
      default  : A = (const bf16_t*)(ws + O_MRG); K = 2048; B0p = (const bf16_t*)(ws + O_WS) + 2 * (size_t)2048 * 2048 + (size_t)pn * 256 * 2048; B1p = B0p + (size_t)128 * 2048; break;
    }
    f32x4 acc[2][2][4][2];
#pragma unroll
    for (int a = 0; a < 2; ++a)
#pragma unroll
      for (int b = 0; b < 2; ++b)
#pragma unroll
        for (int m = 0; m < 4; ++m)
#pragma unroll
          for (int n = 0; n < 2; ++n) acc[a][b][m][n] = (f32x4){0.f, 0.f, 0.f, 0.f};
    const int nk = (kind == G_MERGE) ? 2 : 1;
    for (int kl = 0; kl < nk; ++kl) {
      if (kl == 1) {
        int fr = fr_, fq = fq_; asm volatile("" : "+v"(fr), "+v"(fq));
        const bf16_t* gA = (const bf16_t*)P.out; const bf16_t* gB = gA + (size_t)TR * 2048;
#pragma unroll
      for (int aim = 0; aim < 4; ++aim) {
          const int ai = aim >> 1, m0 = (aim & 1) * 2;
          u32x2 ga[2][2][2], gb[2][2][2];
#pragma unroll
          for (int mm = 0; mm < 2; ++mm) {
            const int m = m0 + mm;
            const size_t nrow = (size_t)(nrow0 + ai * 128 + wr * 64 + m * 16 + fr) * 2048;
#pragma unroll
            for (int bj = 0; bj < 2; ++bj)
#pragma unroll
              for (int n = 0; n < 2; ++n) { const int col = pn * 256 + bj * 128 + wc * 32 + n * 16 + fq * 4; ga[mm][bj][n] = *(const u32x2*)(gA + nrow + col); gb[mm][bj][n] = *(const u32x2*)(gB + nrow + col); }
          }
          asm volatile("" ::: "memory"); SCHED;
#pragma unroll
          for (int mm = 0; mm < 2; ++mm)
#pragma unroll
            for (int bj = 0; bj < 2; ++bj)
#pragma unroll
              for (int n = 0; n < 2; ++n) {
                const int m = m0 + mm;
                const u32x2 wa = ga[mm][bj][n], wb = gb[mm][bj][n];
                const float a4[4] = {__uint_as_float(wa.x << 16), __uint_as_float(wa.x & 0xffff0000u), __uint_as_float(wa.y << 16), __uint_as_float(wa.y & 0xffff0000u)};
                const float b4[4] = {__uint_as_float(wb.x << 16), __uint_as_float(wb.x & 0xffff0000u), __uint_as_float(wb.y << 16), __uint_as_float(wb.y & 0xffff0000u)};
#pragma unroll
                for (int j = 0; j < 4; ++j) { float ea = __expf(-fminf(fmaxf(a4[j], -40.f), 40.f)), eb = __expf(-fminf(fmaxf(b4[j], -40.f), 40.f)); acc[ai][bj][m][n][j] *= (1.f + eb) / (1.f + ea); }
              }
          asm volatile("" ::: "memory"); SCHED;
        }
        A = (const bf16_t*)(ws + O_DD); B0p += (size_t)2048 * 2048; B1p += (size_t)2048 * 2048;
        asm volatile("s_waitcnt vmcnt(0)" ::: "memory");
      }
      gemm_mainloop((const char*)(A + (size_t)arow0 * K), (const char*)B0p, (const char*)B1p, K, acc);
    }
    int fr = fr_, fq = fq_; asm volatile("" : "+v"(fr), "+v"(fq));
    if (kind == G_FFN1_GU || kind == G_FFN2_GU || kind == G_WIN_A || kind == G_WIN_META || kind == G_WIN_B) {
      float* rsl = (float*)shm_raw;
      const int tid2 = wid * 64 + (int)__builtin_amdgcn_mbcnt_hi(~0u, __builtin_amdgcn_mbcnt_lo(~0u, 0u));
      if (tid2 < 256) {
        const size_t row = (size_t)(arow0 + tid2); float sum;
        if (kind == G_FFN1_GU) sum = stats[row];
        else { const f32x4* pp = (const f32x4*)((const float*)(ws + (kind == G_FFN2_GU ? O_ST2 : O_ST1)) + row * 32); f32x4 a = pp[0];
#pragma unroll
          for (int i = 1; i < 8; ++i) a += pp[i];
          sum = (a[0] + a[1]) + (a[2] + a[3]); }
        rsl[tid2] = rsqrtf(sum * (1.f / 2048.f) + EPS);
      }
      __syncthreads();
    }
    if (kind == G_FFN1_GU || kind == G_FFN2_GU) {
      const float* rsl = (const float*)shm_raw;
      bf16_t* hid = (bf16_t*)(ws + O_HID);
#pragma unroll
      for (int ai = 0; ai < 2; ++ai)
#pragma unroll
        for (int m = 0; m < 4; ++m) {
          const int r = ai * 128 + wr * 64 + m * 16 + fr;
          if (meta && (r < 48 || r >= 64)) continue;
          const int prow = arow0 + r;
          const float rs = rsl[r];
#pragma unroll
          for (int n = 0; n < 2; ++n) {
            f32x4 g = acc[ai][0][m][n] * rs, u = acc[ai][1][m][n] * rs, h;
#pragma unroll
            for (int j = 0; j < 4; ++j) h[j] = g[j] * sigm(g[j]) * u[j];
            store_bf4(hid + (size_t)prow * DFF + pn * 128 + wc * 32 + n * 16 + fq * 4, h);
          }
          asm volatile("" ::: "memory"); SCHED;
        }
    } else if (kind == G_FFN1_D || kind == G_OUT || kind == G_FFN2_D) {
      const float* resA = (kind == G_FFN2_D) ? P.out : P.x;
      const bf16_t* resF = (kind == G_OUT) ? (const bf16_t*)(ws + O_F) : nullptr;
      float* outF32 = (kind == G_FFN1_D) ? nullptr : P.out;
      bf16_t* outB = (kind == G_FFN2_D) ? nullptr : (bf16_t*)(ws + O_ACTB);
      bf16_t* outF = (kind == G_FFN1_D && !meta) ? (bf16_t*)(ws + O_F) : nullptr;
      const float scale = (kind == G_OUT) ? 1.f : 0.5f;
      float* st = (kind == G_FFN1_D) ? (float*)(ws + O_ST1) : (kind == G_OUT ? (float*)(ws + O_ST2) : nullptr);
#pragma unroll
      for (int aim = 0; aim < 4; ++aim) {
        const int ai = aim >> 1, m0 = (aim & 1) * 2;
        f32x4 rres[2][2][2];
#pragma unroll
        for (int mm = 0; mm < 2; ++mm) {
          const int m = m0 + mm;
          const int r = ai * 128 + wr * 64 + m * 16 + fr;
          const bool rowok = !(meta && (r < 48 || r >= 64));
          const size_t prow = arow0 + r, nrow = nrow0 + r;
          const float* rp = meta ? (P.meta + (size_t)(rowok ? r - 48 : 0) * 2048) : (resA + nrow * 2048);
#pragma unroll
          for (int bj = 0; bj < 2; ++bj)
#pragma unroll
            for (int n = 0; n < 2; ++n) {
              const int col = pn * 256 + bj * 128 + wc * 32 + n * 16 + fq * 4;
              rres[mm][bj][n] = *(const f32x4*)(rp + col);
            }
        }
        asm volatile("" ::: "memory"); SCHED;
#pragma unroll
        for (int mm = 0; mm < 2; ++mm) {
          const int m = m0 + mm;
          const int r = ai * 128 + wr * 64 + m * 16 + fr;
          const bool rowok = !(meta && (r < 48 || r >= 64));
          const size_t prow = arow0 + r, nrow = nrow0 + r;
          float ss = 0.f;
#pragma unroll
          for (int bj = 0; bj < 2; ++bj)
#pragma unroll
            for (int n = 0; n < 2; ++n) {
              const int col = pn * 256 + bj * 128 + wc * 32 + n * 16 + fq * 4;
              f32x4 res = rres[mm][bj][n];
              if (resF) { const u32x2 w = *(const u32x2*)(resF + prow * 2048 + col); res[0] += __uint_as_float(w.x << 16); res[1] += __uint_as_float(w.x & 0xffff0000u); res[2] += __uint_as_float(w.y << 16); res[3] += __uint_as_float(w.y & 0xffff0000u); }
              const f32x4 d = acc[ai][bj][m][n] * scale, v = res + d;
              if (rowok) {
                if (outF32) *(f32x4*)(outF32 + nrow * 2048 + col) = v;
                if (outB) store_bf4(outB + prow * 2048 + col, v);
                if (outF) store_bf4(outF + prow * 2048 + col, d);
              }
              ss += v[0] * v[0] + v[1] * v[1] + v[2] * v[2] + v[3] * v[3];
            }
          ss += __shfl_xor(ss, 16); ss += __shfl_xor(ss, 32);
          if (fq == 0 && st && rowok) st[prow * 32 + pn * 4 + wc] = ss;
        }
        asm volatile("" ::: "memory"); SCHED;
      }
    } else if (kind == G_MERGE) {
      const bf16_t* gB = (const bf16_t*)P.out + (size_t)TR * 2048;
      bf16_t* mo = (bf16_t*)(ws + O_MRG);
#pragma unroll
      for (int ai = 0; ai < 2; ++ai) {
        u32x2 gw[4][2][2];
#pragma unroll
        for (int m = 0; m < 4; ++m) {
          const size_t nrow = nrow0 + ai * 128 + wr * 64 + m * 16 + fr;
#pragma unroll
          for (int bj = 0; bj < 2; ++bj)
#pragma unroll
            for (int n = 0; n < 2; ++n) gw[m][bj][n] = *(const u32x2*)(gB + nrow * 2048 + pn * 256 + bj * 128 + wc * 32 + n * 16 + fq * 4);
        }
        asm volatile("" ::: "memory"); SCHED;
#pragma unroll
        for (int m = 0; m < 4; ++m) {
          const size_t prow = arow0 + ai * 128 + wr * 64 + m * 16 + fr;
#pragma unroll
          for (int bj = 0; bj < 2; ++bj)
#pragma unroll
            for (int n = 0; n < 2; ++n) {
              const int col = pn * 256 + bj * 128 + wc * 32 + n * 16 + fq * 4;
              const u32x2 w = gw[m][bj][n];
              const float b4[4] = {__uint_as_float(w.x << 16), __uint_as_float(w.x & 0xffff0000u), __uint_as_float(w.y << 16), __uint_as_float(w.y & 0xffff0000u)};
              f32x4 v;
#pragma unroll
              for (int j = 0; j < 4; ++j) v[j] = acc[ai][bj][m][n][j] / (1.f + __expf(-fminf(fmaxf(b4[j], -40.f), 40.f)));
              store_bf4(mo + prow * 2048 + col, v);
            }
        }
        asm volatile("" ::: "memory"); SCHED;
      }
    } else {
      const float* rsl = (const float*)shm_raw;
      bf16_t* dst; int ld, c0; bool natural = false, isLow = false;
      if (pn < 4) { dst = (bf16_t*)(ws + O_GQ); ld = 1024; c0 = pn * 256; }
      else if (pn < 8) { dst = (bf16_t*)(ws + O_GK); ld = 1024; c0 = (pn - 4) * 256; }
      else if (pn < 16) { dst = (bf16_t*)(ws + O_GV); ld = 2048; c0 = (pn - 8) * 256; }
      else if (pn < 24) { dst = (bf16_t*)(ws + O_GR); ld = 2048; c0 = (pn - 16) * 256; }
      else if (pn == 24) { dst = nullptr; ld = 32; c0 = 0; isLow = true; }
      else if (pn < 33) { dst = (bf16_t*)(ws + O_DQ); ld = 2048; c0 = (pn - 25) * 256; }
      else if (pn < 41) { dst = (bf16_t*)(ws + O_DK); ld = 2048; c0 = (pn - 33) * 256; }
      else if (pn < 49) { dst = (bf16_t*)(ws + O_DV); ld = 2048; c0 = (pn - 41) * 256; }
      else if (pn < 57) { dst = (bf16_t*)P.out; ld = 2048; c0 = (pn - 49) * 256; natural = true; }
      else { dst = (bf16_t*)P.out + (size_t)TR * 2048; ld = 2048; c0 = (pn - 57) * 256; natural = true; }
      float* low = (float*)(ws + O_LOW);
      bool single = false;
      if (meta && pn >= 25) { single = true; if (pn >= 33 && pn < 41) dst = (bf16_t*)(ws + O_DKM); else if (pn >= 41 && pn < 49) dst = (bf16_t*)(ws + O_DVM); else natural = true; }
      if (!(meta && natural)) {
#pragma unroll
        for (int ai = 0; ai < 2; ++ai)
#pragma unroll
          for (int m = 0; m < 4; ++m) {
            const int r = ai * 128 + wr * 64 + m * 16 + fr;
            if (meta && r >= 64) continue;
            const size_t prow = arow0 + r, nrow = nrow0 + r;
            const float rs = rsl[r];
            const bool zero = meta && r < 48;
#pragma unroll
            for (int bj = 0; bj < 2; ++bj)
#pragma unroll
              for (int n = 0; n < 2; ++n) {
                const int cc = bj * 128 + wc * 32 + n * 16 + fq * 4;
                f32x4 v = acc[ai][bj][m][n] * rs;
                if (zero) v = (f32x4){0.f, 0.f, 0.f, 0.f};
                if (isLow) {
                  if (cc < 32) { if (meta) { for (int b4 = 0; b4 < 4; ++b4) *(f32x4*)(low + (size_t)(b4 * LP + r) * 32 + cc) = v; } else *(f32x4*)(low + prow * 32 + cc) = v; }
                } else if (single) {
                  store_bf4(dst + (size_t)r * ld + c0 + cc, v);
                } else if (meta) {
                  for (int b4 = 0; b4 < 4; ++b4) store_bf4(dst + (size_t)(b4 * LP + r) * ld + c0 + cc, v);
                } else {
                  store_bf4(dst + (natural ? nrow : prow) * ld + c0 + cc, v);
                }
              }
            asm volatile("" ::: "memory"); SCHED;
          }
      }
    }
    asm volatile("s_waitcnt vmcnt(0)" ::: "memory");
    __syncthreads();
    if (gp == G_WIN_A && t < nPre && tid == 0) {
      __builtin_amdgcn_fence(__ATOMIC_RELEASE, "agent");
      asm volatile("s_waitcnt vmcnt(0)" ::: "memory");
      __hip_atomic_fetch_add((unsigned*)(ws + O_MCNT), 1u, __ATOMIC_RELAXED, __HIP_MEMORY_SCOPE_AGENT);
    }
  }
}

struct TReg { f32x4 v[8]; };
DEV void tt_load(const float* __restrict__ src, int K, int N, const float* __restrict__ gain, int tk, int tn, TReg& r) {
  const int tid = threadIdx.x, k0 = tk * 128, n0 = tn * 128;
#pragma unroll
  for (int i = 0; i < 8; ++i) {
    const int kr = i * 16 + (tid >> 5), nc = (tid & 31) * 4;
    f32x4 v = (f32x4){0.f, 0.f, 0.f, 0.f};
    if (n0 + nc < N) v = *(const f32x4*)(src + (size_t)(k0 + kr) * N + n0 + nc);
    if (gain) v = v * gain[k0 + kr];
    r.v[i] = v;
  }
}
DEV void tt_store(int K, int N, bf16_t* __restrict__ dst, bool winmap, int tk, int tn, const TReg& r) {
  const int tid = threadIdx.x;
  bf16_t* T = shm;
  const int k0 = tk * 128, n0 = tn * 128;
  __syncthreads();
#pragma unroll
  for (int i = 0; i < 8; ++i) {
    const int kr = i * 16 + (tid >> 5), nc = (tid & 31) * 4;
    unsigned* tp = (unsigned*)(T + kr * 130 + nc);
    tp[0] = pk2(r.v[i][0], r.v[i][1]); tp[1] = pk2(r.v[i][2], r.v[i][3]);
  }
  __syncthreads();
  const int nr = tid >> 2, n = n0 + nr;
  if (n < N) {
    const int drow = winmap ? (n < 6176 ? n : n + 224) : n;
#pragma unroll
    for (int q = 0; q < 4; ++q) {
      const int kk = (tid & 3) * 8 + q * 32;
      unsigned short e[8];
#pragma unroll
      for (int i = 0; i < 8; ++i) e[i] = T[(kk + i) * 130 + nr];
      u32x4 w; w.x = e[0] | ((unsigned)e[1] << 16); w.y = e[2] | ((unsigned)e[3] << 16); w.z = e[4] | ((unsigned)e[5] << 16); w.w = e[6] | ((unsigned)e[7] << 16);
      *(u32x4*)(dst + (size_t)drow * K + k0 + kk) = w;
    }
  }
}

DEV void transpose_job(const float* src, int K, int N, bf16_t* dst, const float* gain, bool winmap, int& tbase, int& t) {
  const int ntn = (N + 127) / 128, nt = (K / 128) * ntn, tend = tbase + nt;
  TReg cur, nxt;
  if (t < tend) { const int l = t - tbase; tt_load(src, K, N, gain, l / ntn, l % ntn, cur); }
  while (t < tend) {
    const int l = t - tbase, t2 = t + gridDim.x;
    if (t2 < tend) { const int l2 = t2 - tbase; tt_load(src, K, N, gain, l2 / ntn, l2 % ntn, nxt); }
    tt_store(K, N, dst, winmap, l / ntn, l % ntn, cur);
    cur = nxt; t = t2;
  }
  tbase += nt;
}

DEV void phase_prologue(const Params& P) {
  unsigned char* ws = P.ws;
  const int tid = threadIdx.x, gtid = blockIdx.x * NTHR + tid, gsz = gridDim.x * NTHR;
  { u32x4* z = (u32x4*)((bf16_t*)(ws + O_WIN) + (size_t)6176 * 2048); const int nz = 224 * 2048 / 8;
    for (int i = gtid; i < nz; i += gsz) z[i] = (u32x4){0u, 0u, 0u, 0u}; }
  { const int gw = (blockIdx.x * NTHR + tid) >> 6, nw = gsz >> 6, lane = tid & 63;
    bf16_t* xb = (bf16_t*)(ws + O_ACTB); float* st0 = (float*)(ws + O_ST);
    for (int r = gw; r < TR + 16; r += nw) {
      const float* src; size_t prow;
      if (r < TR) { src = P.x + (size_t)r * 2048; prow = (size_t)(r >> 12) * LP + 64 + (r & 4095); } else { src = P.meta + (size_t)(r - TR) * 2048; prow = 48 + (r - TR); }
      float ss = 0.f;
#pragma unroll
      for (int i = 0; i < 8; ++i) { const int c = i * 256 + lane * 4; f32x4 v = *(const f32x4*)(src + c); ss += v[0] * v[0] + v[1] * v[1] + v[2] * v[2] + v[3] * v[3]; store_bf4(xb + prow * 2048 + c, v); }
#pragma unroll
      for (int o = 32; o >= 1; o >>= 1) ss += __shfl_xor(ss, o);
      if (lane == 0) st0[prow] = ss;
    } }
  int tbase = 0, t = blockIdx.x;
  bf16_t* wf = (bf16_t*)(ws + O_WF); bf16_t* wsq = (bf16_t*)(ws + O_WS);
  transpose_job(P.w1g, 2048, DFF, wf + (size_t)DFF * 2048, P.n1, false, tbase, t);
  transpose_job(P.w1u, 2048, DFF, wf + (size_t)2 * DFF * 2048, P.n1, false, tbase, t);
  transpose_job(P.w1d, DFF, 2048, wf, nullptr, false, tbase, t);
  transpose_job(P.win, 2048, INW, (bf16_t*)(ws + O_WIN), P.nmix, true, tbase, t);
  transpose_job(P.wbg, 2048, 2048, wsq, nullptr, false, tbase, t);
  transpose_job(P.wbd, 2048, 2048, wsq + (size_t)2048 * 2048, nullptr, false, tbase, t);
  transpose_job(P.wout, 2048, 2048, wsq + (size_t)2 * 2048 * 2048, nullptr, false, tbase, t);
}

DEV f32x4 mfma16(bf16x8 a, bf16x8 b, f32x4 c) { return __builtin_amdgcn_mfma_f32_16x16x32_bf16(a, b, c, 0, 0, 0); }
#define LD8(p) (*reinterpret_cast<const bf16x8*>(p))

DEV void gla_prep_unit(const Params& P, int u, bool dummy = false) {
  unsigned char* ws = P.ws;
  const bool st_ok = !dummy || (P.ws == nullptr);
  int tid = threadIdx.x; asm volatile("" : "+v"(tid));
  const int w = tid >> 6, lane = tid & 63, fr = lane & 15, fq = lane >> 4;
  const int c = u % 65, bh = u / 65, b = bh >> 2, h = bh & 3;
  bf16_t* QD0 = shm; bf16_t* KI0 = QD0 + 64 * 264; bf16_t* QD1 = KI0 + 64 * 264; bf16_t* KI1 = QD1 + 64 * 264;
  float* LOWs = (float*)(KI1 + 64 * 264);
  bf16_t* gq = (bf16_t*)(ws + O_GQ); bf16_t* gk = (bf16_t*)(ws + O_GK);
  const size_t prow0 = (size_t)b * LP + c * 64;
  const int dir = tid >> 8, k = tid & 255, col = h * 256 + k;
  unsigned qk[64];
#pragma unroll
  for (int tt = 0; tt < 64; ++tt) { const int t = dir ? 63 - tt : tt; qk[tt] = (unsigned)gq[(prow0 + t) * 1024 + col] | ((unsigned)gk[(prow0 + t) * 1024 + col] << 16); }
  __syncthreads();
  { const int idx = tid * 4, row = idx >> 5, cl = idx & 31;
    *(f32x4*)(LOWs + idx) = *(const f32x4*)((const float*)(ws + O_LOW) + (prow0 + row) * 32 + cl); }
  __syncthreads();
  {
    const float* wa2 = dir ? P.wa2b : P.wa2f;
    float wv[16];
#pragma unroll
    for (int r = 0; r < 16; ++r) wv[r] = wa2[r * 1024 + col];
    const float bias = (dir ? P.bab : P.baf)[col];
    bf16_t* QD = dir ? QD1 : QD0; bf16_t* KI = dir ? KI1 : KI0;
    float bc = 0.f;
#pragma unroll
    for (int tt = 0; tt < 64; ++tt) {
      const int t = dir ? 63 - tt : tt;
      const f32x4* lr = (const f32x4*)(LOWs + t * 32 + dir * 16);
      const f32x4 l0 = lr[0], l1 = lr[1], l2 = lr[2], l3 = lr[3];
      float z = bias;
#pragma unroll
      for (int r = 0; r < 4; ++r) { z = fmaf(l0[r], wv[r], z); z = fmaf(l1[r], wv[4 + r], z); z = fmaf(l2[r], wv[8 + r], z); z = fmaf(l3[r], wv[12 + r], z); }
      const float ls = fminf(z, 0.f) - __logf(1.f + __expf(-fabsf(z)));
      const bool valid = !(c == 0 && t < 48);
      bc += valid ? ls * 0.0625f : 0.f;
      const float e = __expf(bc), ei = __expf(-bc);
      QD[t * 264 + k] = f2bf(__uint_as_float(qk[tt] << 16) * e * 0.0625f);
      KI[t * 264 + k] = f2bf(__uint_as_float(qk[tt] & 0xffff0000u) * ei);
    }
    if (st_ok) ((float*)(ws + O_DL))[((size_t)(bh * 2 + dir) * 65 + c) * 256 + k] = __expf(bc);
  }
  __syncthreads();
  if (c >= 1) {
    const int d = w >> 2, ti = w & 3;
    const bf16_t* QD = d ? QD1 : QD0; const bf16_t* KI = d ? KI1 : KI0;
    bf16_t* Pg = (bf16_t*)(ws + O_P) + (size_t)u * 4096;
#pragma unroll
    for (int tj = 0; tj < 4; ++tj) {
      f32x4 a4 = (f32x4){0.f, 0.f, 0.f, 0.f};
#pragma unroll
      for (int kk = 0; kk < 8; ++kk) a4 = mfma16(LD8(QD + (ti * 16 + fr) * 264 + kk * 32 + fq * 8), LD8(KI + (tj * 16 + fr) * 264 + kk * 32 + fq * 8), a4);
#pragma unroll
      for (int r = 0; r < 4; ++r) { const int i = ti * 16 + fq * 4 + r, j = tj * 16 + fr; const bool keep = d ? (j > i) : (j <= i); if (keep && st_ok) Pg[i * 64 + j] = f2bf(a4[r]); }
    }
  }
  bf16_t* qdb = (bf16_t*)(ws + O_QDB); bf16_t* kib = (bf16_t*)(ws + O_KIB);
#pragma unroll
  for (int i = 0; i < 4; ++i) {
    const int p = tid + 512 * i, tok = p >> 5, kc = (p & 31) * 8;
    const size_t g = (prow0 + tok) * 1024 + h * 256 + kc;
    if (st_ok) { *(u32x4*)(gq + g) = *(const u32x4*)(QD0 + tok * 264 + kc);
    *(u32x4*)(qdb + g) = *(const u32x4*)(QD1 + tok * 264 + kc); }
  }
  {
    const bf16_t* KI = dir ? KI1 : KI0;
    bf16_t* dst = (dir ? kib : gk) + (prow0 + (k >> 2)) * 1024 + h * 256 + (k & 3) * 64;
#pragma unroll
    for (int q = 0; q < 8; ++q) {
      unsigned e[8];
#pragma unroll
      for (int i = 0; i < 8; ++i) e[i] = KI[(q * 8 + i) * 264 + k];
      u32x4 wv4; wv4.x = e[0] | (e[1] << 16); wv4.y = e[2] | (e[3] << 16); wv4.z = e[4] | (e[5] << 16); wv4.w = e[6] | (e[7] << 16);
      if (st_ok) *(u32x4*)(dst + q * 8) = wv4;
    }
  }
  __syncthreads();
  bf16_t* gv = (bf16_t*)(ws + O_GV);
  bf16_t* VN = shm;
#pragma unroll
  for (int q = 0; q < 8; ++q) {
    const int p = tid + 512 * q, tok = p >> 6, vc = (p & 63) * 8;
    *(u32x4*)(VN + tok * 520 + vc) = *(const u32x4*)(gv + (prow0 + tok) * 2048 + h * 512 + vc);
  }
  __syncthreads();
  {
    const int v = tid;
    bf16_t* dst = gv + (prow0 + (v >> 3)) * 2048 + h * 512 + (v & 7) * 64;
#pragma unroll
    for (int q = 0; q < 8; ++q) {
      unsigned e[8];
#pragma unroll
      for (int i = 0; i < 8; ++i) e[i] = VN[(q * 8 + i) * 520 + v];
      u32x4 wv4; wv4.x = e[0] | (e[1] << 16); wv4.y = e[2] | (e[3] << 16); wv4.z = e[4] | (e[5] << 16); wv4.w = e[6] | (e[7] << 16);
      if (st_ok) *(u32x4*)(dst + q * 8) = wv4;
    }
  }
}

DEV void gla_scan_unit(const Params& P, int u) {
  unsigned char* ws = P.ws;
  int tid = threadIdx.x; asm volatile("" : "+v"(tid));
  const int w = tid >> 6, lane = tid & 63, fr = lane & 15, fq = lane >> 4;
  const int xj = u >> 3, sl = xj & 7, grp = (xj >> 3) * 8 + (u & 7);
  const int b = grp >> 3, h = (grp >> 1) & 3, dir = grp & 1;
  bf16_t* QDs = shm;
  bf16_t* KIT = QDs + 64 * 264;
  bf16_t* VT = KIT + 256 * 72;
  bf16_t* SBs = VT + 64 * 72;
  const bf16_t* qsrc = (const bf16_t*)(ws + (dir ? O_QDB : O_GQ));
  const bf16_t* ksrc = (const bf16_t*)(ws + (dir ? O_KIB : O_GK));
  const bf16_t* vsrc = (const bf16_t*)(ws + O_GV);
  const float* dlp = (const float*)(ws + O_DL) + (size_t)((b * 4 + h) * 2 + dir) * 65 * 256;
  bf16_t* osrc = (bf16_t*)P.out + (size_t)dir * TR * 2048;
  f32x4 S[2][4];
#pragma unroll
  for (int a = 0; a < 4; ++a) { S[0][a] = (f32x4){0.f, 0.f, 0.f, 0.f}; S[1][a] = (f32x4){0.f, 0.f, 0.f, 0.f}; }
  u32x4 rqA[4], rkA[4], rvA, rqB[4], rkB[4], rvB; f32x4 rdA0, rdA1, rdB0, rdB1;
  const int nsteps = dir ? 64 : 65;
#define SCAN_LOAD(RQ, RK, RV, RD0, RD1, cc) do { const size_t pr0 = (size_t)b * LP + (cc) * 64; \
    _Pragma("unroll") for (int i = 0; i < 4; ++i) { const int p = tid + 512 * i; \
      { const int tok = p >> 5, kc = (p & 31) * 8; RQ[i] = *(const u32x4*)(qsrc + (pr0 + tok) * 1024 + h * 256 + kc); } \
      { const int kr = p >> 3, tc = (p & 7) * 8; RK[i] = *(const u32x4*)(ksrc + (pr0 + (kr >> 2)) * 1024 + h * 256 + (kr & 3) * 64 + tc); } } \
    { const int vv = sl * 64 + (tid >> 3), tc = (tid & 7) * 8; RV = *(const u32x4*)(vsrc + (pr0 + (vv >> 3)) * 2048 + h * 512 + (vv & 7) * 64 + tc); } \
    RD0 = *(const f32x4*)(dlp + (cc) * 256 + (2 * w) * 16 + fq * 4); RD1 = *(const f32x4*)(dlp + (cc) * 256 + (2 * w + 1) * 16 + fq * 4); } while (0)
#define SCAN_STEP(RQ, RK, RV, RD0, RD1, s_) do { \
    const int c = dir ? 64 - (s_) : (s_); \
    const bool do_o = dir ? true : (c >= 1), do_upd = dir ? (c >= 2) : (c <= 63); \
    __syncthreads(); \
    _Pragma("unroll") for (int i = 0; i < 4; ++i) { const int p = tid + 512 * i; \
      *(u32x4*)(QDs + (p >> 5) * 264 + (p & 31) * 8) = RQ[i]; \
      *(u32x4*)(KIT + (p >> 3) * 72 + (p & 7) * 8) = RK[i]; } \
    *(u32x4*)(VT + (tid >> 3) * 72 + (tid & 7) * 8) = RV; \
    _Pragma("unroll") for (int vt = 0; vt < 4; ++vt) _Pragma("unroll") for (int kt = 0; kt < 2; ++kt) { \
        u32x2 pw; pw.x = pk2(S[kt][vt][0], S[kt][vt][1]); pw.y = pk2(S[kt][vt][2], S[kt][vt][3]); \
        *(u32x2*)(SBs + (vt * 16 + fr) * 264 + (2 * w + kt) * 16 + fq * 4) = pw; } \
    const f32x4 dl0 = RD0, dl1 = RD1; \
    __syncthreads(); \
    if ((s_) + 2 < nsteps) SCAN_LOAD(RQ, RK, RV, RD0, RD1, dir ? 64 - ((s_) + 2) : (s_) + 2); \
    if (do_o) { \
      const int ti = w >> 1; \
      _Pragma("unroll") for (int jj = 0; jj < 2; ++jj) { \
        const int tj = (w & 1) * 2 + jj; \
        f32x4 a4 = (f32x4){0.f, 0.f, 0.f, 0.f}; \
        _Pragma("unroll") for (int kk = 0; kk < 8; ++kk) a4 = mfma16(LD8(SBs + (tj * 16 + fr) * 264 + kk * 32 + fq * 8), LD8(QDs + (ti * 16 + fr) * 264 + kk * 32 + fq * 8), a4); \
        const size_t nrow = (size_t)b * SEQ + (c - 1) * 64 + ti * 16 + fr; \
        store_bf4(osrc + nrow * 2048 + h * 512 + sl * 64 + tj * 16 + fq * 4, a4); } } \
    if (do_upd) { \
      _Pragma("unroll") for (int kt = 0; kt < 2; ++kt) _Pragma("unroll") for (int vt = 0; vt < 4; ++vt) { \
          _Pragma("unroll") for (int kk = 0; kk < 2; ++kk) S[kt][vt] = mfma16(LD8(KIT + ((2 * w + kt) * 16 + fr) * 72 + kk * 32 + fq * 8), LD8(VT + (vt * 16 + fr) * 72 + kk * 32 + fq * 8), S[kt][vt]); \
          S[kt][vt] = S[kt][vt] * (kt ? dl1 : dl0); } } \
  } while (0)
  SCAN_LOAD(rqA, rkA, rvA, rdA0, rdA1, dir ? 64 : 0);
  SCAN_LOAD(rqB, rkB, rvB, rdB0, rdB1, dir ? 63 : 1);
  for (int s = 0; s < nsteps; s += 2) {
    SCAN_STEP(rqA, rkA, rvA, rdA0, rdA1, s);
    if (s + 1 < nsteps) SCAN_STEP(rqB, rkB, rvB, rdB0, rdB1, s + 1);
  }
#undef SCAN_STEP
#undef SCAN_LOAD
}

DEV void gla_finish_unit(const Params& P, int u, bool dummy = false) {
  unsigned char* ws = P.ws;
  const bool st_ok = !dummy || (P.ws == nullptr);
  int tid = threadIdx.x; asm volatile("" : "+v"(tid));
  const int w = tid >> 6, lane = tid & 63, fr = lane & 15, fq = lane >> 4;
  const int c = (u & 63) + 1, bh = u >> 6, b = bh >> 2, h = bh & 3;
  bf16_t* VTf = shm;
  bf16_t* Pl = VTf + 512 * 72;
  float* red = (float*)(Pl + 64 * 72);
  const size_t prow0 = (size_t)b * LP + c * 64, nrow0 = (size_t)b * SEQ + (c - 1) * 64;
  const bf16_t* gv = (const bf16_t*)(ws + O_GV);
  __syncthreads();
  { const int i = tid >> 3, j0 = (tid & 7) * 8;
    *(u32x4*)(Pl + i * 72 + j0) = *(const u32x4*)((const bf16_t*)(ws + O_P) + (size_t)(bh * 65 + c) * 4096 + i * 64 + j0); }
#pragma unroll
  for (int q = 0; q < 8; ++q) {
    const int p = tid + 512 * q, v = p >> 3, tc = (p & 7) * 8;
    *(u32x4*)(VTf + v * 72 + tc) = *(const u32x4*)(gv + (prow0 + (v >> 3)) * 2048 + h * 512 + (v & 7) * 64 + tc);
  }
  __syncthreads();
  f32x4 acc[4][4];
  const bf16_t* of = (const bf16_t*)P.out; const bf16_t* ob = of + (size_t)TR * 2048;
  float ss[4] = {0.f, 0.f, 0.f, 0.f};
#pragma unroll
  for (int vt = 0; vt < 4; ++vt)
#pragma unroll
    for (int it = 0; it < 4; ++it) {
      f32x4 a4 = (f32x4){0.f, 0.f, 0.f, 0.f};
#pragma unroll
      for (int kk = 0; kk < 2; ++kk) a4 = mfma16(LD8(VTf + (w * 64 + vt * 16 + fr) * 72 + kk * 32 + fq * 8), LD8(Pl + (it * 16 + fr) * 72 + kk * 32 + fq * 8), a4);
      const size_t g = (nrow0 + it * 16 + fr) * 2048 + h * 512 + w * 64 + vt * 16 + fq * 4;
      a4 = a4 + load_bf4(of + g) + load_bf4(ob + g);
      acc[vt][it] = a4;
      ss[it] += a4[0] * a4[0] + a4[1] * a4[1] + a4[2] * a4[2] + a4[3] * a4[3];
    }
#pragma unroll
  for (int it = 0; it < 4; ++it) { float s2 = ss[it]; s2 += __shfl_xor(s2, 16); s2 += __shfl_xor(s2, 32); if (fq == 0) red[w * 64 + it * 16 + fr] = s2; }
  __syncthreads();
  bf16_t* gr = (bf16_t*)(ws + O_GR);
#pragma unroll
  for (int it = 0; it < 4; ++it) {
    float tot = 0.f;
#pragma unroll
    for (int ww = 0; ww < 8; ++ww) tot += red[ww * 64 + it * 16 + fr];
    const float rs = rsqrtf(tot * (1.f / 512.f) + EPS);
#pragma unroll
    for (int vt = 0; vt < 4; ++vt) {
      const int vcol = w * 64 + vt * 16 + fq * 4;
      bf16_t* gp = gr + (prow0 + it * 16 + fr) * 2048 + h * 512 + vcol;
      const f32x4 g4 = load_bf4(gp), nw = *(const f32x4*)(P.gnorm + vcol);
      f32x4 y;
#pragma unroll
      for (int j = 0; j < 4; ++j) y[j] = acc[vt][it][j] * rs * nw[j] * (g4[j] * sigm(g4[j]));
      if (st_ok) store_bf4(gp, y);
    }
  }
}

constexpr int QBLK = 32, KVBLK = 64;
constexpr float ASCALE = 0.088388347648318440f;
constexpr float ATHR = 8.f;
constexpr int LDA_ = 2048;
constexpr size_t SHM_V = KVBLK * 128 * 2, SHM_K = KVBLK * 128 * 2, SHM_ATTN = 2 * SHM_V + 2 * SHM_K + 8 * 64 * 4;
#define KSWZ(row, colB) ((row) * 256 + ((colB) ^ (((row) & 7) << 4)))
#define SBAR() __builtin_amdgcn_sched_barrier(0)
DEV int crow(int r, int hi) { return (r & 3) + 8 * (r >> 2) + 4 * hi; }

template <int MODE> DEV void alibi(f32x16& p0, f32x16& p1, float base, float nslope) {
#pragma unroll
  for (int r = 0; r < 16; ++r) {
    const float cc = (float)((r & 3) + 8 * (r >> 2));
    p0[r] = fmaf(nslope, fabsf(base - cc), p0[r]);
    p1[r] = fmaf(nslope, fabsf(base - cc - 32.f), p1[r]);
    if (MODE == 1) { p0[r] = -1e30f; if (r < 8) p1[r] = -1e30f; }
    if (MODE == 2) { p0[r] = -1e30f; p1[r] = -1e30f; }
  }
}
DEV void partialSM(f32x16& p0, f32x16& p1, float& m_reg, float& mn, float& alpha) {
  constexpr float C = ASCALE * 1.4426950408889634f;
  float pmax = p0[0];
#pragma unroll
  for (int r = 1; r < 16; ++r) pmax = fmaxf(pmax, p0[r]);
#pragma unroll
  for (int r = 0; r < 16; ++r) pmax = fmaxf(pmax, p1[r]);
  { auto rr = __builtin_amdgcn_permlane32_swap(__float_as_uint(pmax), __float_as_uint(pmax), false, false);
    pmax = fmaxf(__uint_as_float(rr[0]), __uint_as_float(rr[1])); }
  if (__builtin_expect(__all(pmax - m_reg <= ATHR / ASCALE), 1)) { mn = m_reg; alpha = 1.f; }
  else { mn = fmaxf(m_reg, pmax); alpha = __builtin_amdgcn_exp2f((m_reg - mn) * C); m_reg = mn; }
  const float mnC = -mn * C;
#pragma unroll
  for (int r = 0; r < 16; ++r) p0[r] = fmaf(p0[r], C, mnC);
#pragma unroll
  for (int r = 0; r < 16; ++r) p1[r] = fmaf(p1[r], C, mnC);
#pragma unroll
  for (int r = 0; r < 16; ++r) p0[r] = __builtin_amdgcn_exp2f(p0[r]);
}
DEV void finishSM(f32x16& p0, f32x16& p1, float alpha, float& l_reg, bf16x8& pa0, bf16x8& pa1, bf16x8& pa2, bf16x8& pa3) {
#pragma unroll
  for (int r = 0; r < 16; ++r) p1[r] = __builtin_amdgcn_exp2f(p1[r]);
  float ps = 0;
#pragma unroll
  for (int r = 0; r < 16; ++r) ps += p0[r];
#pragma unroll
  for (int r = 0; r < 16; ++r) ps += p1[r];
  { auto rr = __builtin_amdgcn_permlane32_swap(__float_as_uint(ps), __float_as_uint(ps), false, false);
    ps = __uint_as_float(rr[0]) + __uint_as_float(rr[1]); }
  l_reg = l_reg * alpha + ps;
#define PK4(P_, BASE, OUT) do { unsigned a0 = pk2(P_[BASE + 0], P_[BASE + 1]), a1 = pk2(P_[BASE + 2], P_[BASE + 3]);   \
    unsigned b0 = pk2(P_[BASE + 4], P_[BASE + 5]), b1 = pk2(P_[BASE + 6], P_[BASE + 7]);                              \
    auto r0 = __builtin_amdgcn_permlane32_swap(a0, b0, false, false); auto r1 = __builtin_amdgcn_permlane32_swap(a1, b1, false, false); \
    u32x4 w_ = {r0[0], r1[0], r0[1], r1[1]}; OUT = *reinterpret_cast<bf16x8*>(&w_); } while (0)
  PK4(p0, 0, pa0); PK4(p0, 8, pa1); PK4(p1, 0, pa2); PK4(p1, 8, pa3);
#undef PK4
}
DEV void qkt(f32x16& p0, f32x16& p1, const bf16_t* Ks, const bf16x8* qr, int r32, int hi) {
  p0 = f32x16{}; p1 = f32x16{};
#pragma unroll
  for (int d0 = 0; d0 < 8; ++d0) { const int cb = (d0 * 16 + hi * 8) * 2;
    bf16x8 b0 = *reinterpret_cast<const bf16x8*>((const char*)Ks + KSWZ(r32, cb));
    bf16x8 b1 = *reinterpret_cast<const bf16x8*>((const char*)Ks + KSWZ(32 + r32, cb));
    p0 = __builtin_amdgcn_mfma_f32_32x32x16_bf16(b0, qr[d0], p0, 0, 0, 0);
    p1 = __builtin_amdgcn_mfma_f32_32x32x16_bf16(b1, qr[d0], p1, 0, 0, 0); }
}
DEV int v_st(int k, int c) { const int kk = (k & ~0xC) | ((k & 4) << 1) | ((k & 8) >> 1); return ((kk >> 3) * 4 + (c >> 5)) * 512 + ((kk & 7) * 32 + (c & 31)) * 2; }
DEV int v_rd_base(int lane) { return ((lane & 3) << 3) | (((lane >> 2) & 3) << 6) | (((lane >> 4) & 1) << 5) | (((lane >> 5) & 1) << 8); }
constexpr int v_rd_off(int d0, int ks, int half) { return d0 * 512 + ks * 4096 + half * 2048; }
template <int OFF> DEV s16x4 tr_read(int vb) { s16x4 r; asm volatile("ds_read_b64_tr_b16 %0, %1 offset:%2" : "=&v"(r) : "v"(vb), "i"(OFF) : "memory"); return r; }
template <int D0> DEV void pv_one(f32x16& od, int vb, bf16x8 pa0, bf16x8 pa1, bf16x8 pa2, bf16x8 pa3) {
  const s16x4 l0 = tr_read<v_rd_off(D0, 0, 0)>(vb), h0 = tr_read<v_rd_off(D0, 0, 1)>(vb), l1 = tr_read<v_rd_off(D0, 1, 0)>(vb), h1 = tr_read<v_rd_off(D0, 1, 1)>(vb);
  const s16x4 l2 = tr_read<v_rd_off(D0, 2, 0)>(vb), h2 = tr_read<v_rd_off(D0, 2, 1)>(vb), l3 = tr_read<v_rd_off(D0, 3, 0)>(vb), h3 = tr_read<v_rd_off(D0, 3, 1)>(vb);
  asm volatile("s_waitcnt lgkmcnt(0)" ::: "memory"); SBAR();
#define PK(L, H) (bf16x8){L[0], L[1], L[2], L[3], H[0], H[1], H[2], H[3]}
  od = __builtin_amdgcn_mfma_f32_32x32x16_bf16(pa0, PK(l0, h0), od, 0, 0, 0);
  od = __builtin_amdgcn_mfma_f32_32x32x16_bf16(pa1, PK(l1, h1), od, 0, 0, 0);
  od = __builtin_amdgcn_mfma_f32_32x32x16_bf16(pa2, PK(l2, h2), od, 0, 0, 0);
  od = __builtin_amdgcn_mfma_f32_32x32x16_bf16(pa3, PK(l3, h3), od, 0, 0, 0);
#undef PK
}
DEV void pv_d0(f32x16* o, int vb, bf16x8 pa0, bf16x8 pa1, bf16x8 pa2, bf16x8 pa3) {
  pv_one<0>(o[0], vb, pa0, pa1, pa2, pa3); pv_one<1>(o[1], vb, pa0, pa1, pa2, pa3); pv_one<2>(o[2], vb, pa0, pa1, pa2, pa3); pv_one<3>(o[3], vb, pa0, pa1, pa2, pa3);
}

DEV void attn_body(const bf16_t* __restrict__ Qb, const bf16_t* __restrict__ Kh, const bf16_t* __restrict__ Vh, const bf16_t* __restrict__ Km, const bf16_t* __restrict__ Vm, int qrel, float nslope, float slope, float kmax2, char* lds, f32x16 (&o)[4]) {
  int tid = threadIdx.x; asm volatile("" : "+v"(tid));
  const int wid = __builtin_amdgcn_readfirstlane(tid >> 6), lane = tid & 63, r32 = lane & 31, hi = lane >> 5;
  bf16_t* V_lds = (bf16_t*)lds; bf16_t* K_lds = (bf16_t*)(lds + 2 * SHM_V);
  float* wsl = (float*)(lds + 2 * SHM_V + 2 * SHM_K) + wid * 64; float* li_l = wsl; float* al_l = wsl + 32;
  float m_reg = -1e30f, l_reg = 0;
#pragma unroll
  for (int d = 0; d < 4; ++d) o[d] = f32x16{};
  bf16x8 qr[8];
  const bf16_t* Qw = Qb + (long)(wid * QBLK + r32) * LDA_ + hi * 8;
#pragma unroll
  for (int d0 = 0; d0 < 8; ++d0) qr[d0] = *reinterpret_cast<const bf16x8*>(Qw + d0 * 16);
  const float fbase = (float)(qrel + wid * QBLK + r32 - 4 * hi);
  const int sr = tid >> 4, sc = (tid & 15) * 8, vst0 = v_st(sr, sc), vst1 = v_st(32 + sr, sc);
  const int vb0 = (int)(uintptr_t)V_lds + v_rd_base(lane);
  struct { bf16x8 vs0, vs1, ks0, ks1; } sr_[2];
  float qn2 = 0.f;
#pragma unroll
  for (int d0 = 0; d0 < 8; ++d0)
#pragma unroll
    for (int e = 0; e < 8; ++e) { const float qv = __uint_as_float(((unsigned)(unsigned short)qr[d0][e]) << 16); qn2 = fmaf(qv, qv, qn2); }
  qn2 += __shfl_xor(qn2, 32);
#pragma unroll
  for (int of = 16; of >= 1; of >>= 1) qn2 = fmaxf(qn2, __shfl_xor(qn2, of));
  __syncthreads();
  if (lane == 0) wsl[0] = qn2;
  __syncthreads();
  { const float* w0 = (const float*)(lds + 2 * SHM_V + 2 * SHM_K); float mq = w0[0];
#pragma unroll
    for (int ww = 1; ww < 8; ++ww) mq = fmaxf(mq, w0[ww * 64]);
    qn2 = mq; }
  const float bnd = 2.f * ASCALE * sqrtf(qn2 * kmax2) * 1.02f + 1e-3f;
  const float dskip = fminf((104.f + bnd) / slope, 1e6f);
  int jlo = (int)ceilf(((float)(qrel - 63) - dskip) * (1.f / 64.f)); jlo = jlo < 0 ? 0 : jlo;
  int jhi = (int)floorf(((float)(qrel + 255) + dskip) * (1.f / 64.f)); jhi = jhi > 64 ? 64 : jhi;
  jlo = __builtin_amdgcn_readfirstlane(jlo); jhi = __builtin_amdgcn_readfirstlane(jhi);
  const int ntl = jhi - jlo + 1, NT = ntl + (ntl & 1);
#define TIDX(r) ((r) < ntl ? jlo + (r) : 65)
#define TCL(j) ((j) < 64 ? (j) : 64)
#define SLOAD(i, jt) do { const long k0_ = (long)TCL(jt) * KVBLK; const bf16_t* Vt_ = (jt) == 0 ? Vm : Vh; const bf16_t* Kt_ = (jt) == 0 ? Km : Kh; \
    sr_[i].vs0 = *reinterpret_cast<const bf16x8*>(&Vt_[(k0_ + sr) * LDA_ + sc]); sr_[i].vs1 = *reinterpret_cast<const bf16x8*>(&Vt_[(k0_ + 32 + sr) * LDA_ + sc]); \
    sr_[i].ks0 = *reinterpret_cast<const bf16x8*>(&Kt_[(k0_ + sr) * LDA_ + sc]); sr_[i].ks1 = *reinterpret_cast<const bf16x8*>(&Kt_[(k0_ + 32 + sr) * LDA_ + sc]); } while (0)
#define SWRITE(b, i) do { *(bf16x8*)((char*)V_lds + (b) * SHM_V + vst0) = sr_[i].vs0;          \
    *(bf16x8*)((char*)V_lds + (b) * SHM_V + vst1) = sr_[i].vs1; const int kc = sc * 2;               \
    *(bf16x8*)((char*)K_lds + (b) * SHM_K + KSWZ(sr, kc)) = sr_[i].ks0;                       \
    *(bf16x8*)((char*)K_lds + (b) * SHM_K + KSWZ(32 + sr, kc)) = sr_[i].ks1; } while (0)
#define SWAIT() asm volatile("s_waitcnt vmcnt(4)" ::: "memory")
#define RESC(a) do { if (__any((a) < 1.f)) { if (hi == 0) al_l[r32] = (a); asm volatile("s_waitcnt lgkmcnt(0)" ::: "memory"); \
    _Pragma("unroll") for (int d = 0; d < 4; ++d) _Pragma("unroll") for (int r = 0; r < 16; ++r) o[d][r] *= al_l[crow(r, hi)]; } } while (0)
  f32x16 pA0, pA1, pB0, pB1; float mnA, mnB, alA, alB; bf16x8 pa0, pa1, pa2, pa3;
  constexpr int SE = 0, SO = 1;
  __syncthreads();
  SLOAD(SE, jlo); asm volatile("s_waitcnt vmcnt(0)" ::: "memory"); SWRITE(0, SE); __syncthreads();
  qkt(pA0, pA1, K_lds, qr, r32, hi);
  if (jlo == 0) alibi<1>(pA0, pA1, fbase, nslope); else alibi<0>(pA0, pA1, fbase - 64.f * (float)jlo, nslope);
  partialSM(pA0, pA1, m_reg, mnA, alA);
  SLOAD(SO, TIDX(1)); SLOAD(SE, TIDX(2));
  SWAIT(); SWRITE(1, SO); __syncthreads();
  for (int j = 1; j + 1 < NT; j += 2) {
    SBAR(); qkt(pB0, pB1, (bf16_t*)((char*)K_lds + SHM_K), qr, r32, hi); alibi<0>(pB0, pB1, fbase - 64.f * (float)(jlo + j), nslope);
    finishSM(pA0, pA1, alA, l_reg, pa0, pa1, pa2, pa3); SBAR();
    SLOAD(SO, TIDX(j + 2)); SBAR();
    pv_d0(o, vb0, pa0, pa1, pa2, pa3); partialSM(pB0, pB1, m_reg, mnB, alB);
    __syncthreads(); SWAIT(); SWRITE(0, SE);
    RESC(alB); __syncthreads();
    SBAR(); qkt(pA0, pA1, K_lds, qr, r32, hi); alibi<0>(pA0, pA1, fbase - 64.f * (float)(jlo + j + 1), nslope);
    finishSM(pB0, pB1, alB, l_reg, pa0, pa1, pa2, pa3); SBAR();
    if (j + 3 < NT) SLOAD(SE, TIDX(j + 3)); SBAR();
    pv_d0(o, vb0 + (int)SHM_V, pa0, pa1, pa2, pa3); partialSM(pA0, pA1, m_reg, mnA, alA);
    __syncthreads(); SWAIT(); SWRITE(1, SO);
    RESC(alA); __syncthreads();
  }
  SBAR(); qkt(pB0, pB1, (bf16_t*)((char*)K_lds + SHM_K), qr, r32, hi);
  if (ntl & 1) alibi<2>(pB0, pB1, fbase, nslope); else alibi<0>(pB0, pB1, fbase - 64.f * (float)jhi, nslope);
  finishSM(pA0, pA1, alA, l_reg, pa0, pa1, pa2, pa3); SBAR();
  pv_d0(o, vb0, pa0, pa1, pa2, pa3); partialSM(pB0, pB1, m_reg, mnB, alB);
  __syncthreads(); RESC(alB);
  finishSM(pB0, pB1, alB, l_reg, pa0, pa1, pa2, pa3); SBAR();
  pv_d0(o, vb0 + (int)SHM_V, pa0, pa1, pa2, pa3);
  if (hi == 0) li_l[r32] = l_reg; asm volatile("s_waitcnt lgkmcnt(0)" ::: "memory");
#pragma unroll
  for (int r = 0; r < 16; ++r) { const float rl = __builtin_amdgcn_rcpf(li_l[crow(r, hi)]);
#pragma unroll
    for (int d = 0; d < 4; ++d) o[d][r] *= rl; }
#undef SLOAD
#undef SWRITE
#undef SWAIT
#undef RESC
#undef TCL
#undef TIDX
}

DEV void attn_unit(const Params& P, int u) {
  unsigned char* ws = P.ws;
  const int tid_ = threadIdx.x, wid = __builtin_amdgcn_readfirstlane(tid_ >> 6);
  const int cc_ = u & 255, b = u >> 8, hg = cc_ & 7, qblk = (cc_ >> 3) & 15, vh = (cc_ >> 7) & 1;
  const unsigned long long tlo = 0x4712560374216530ull, thi = 0x1247035621743065ull;
  const unsigned trow = (unsigned)((hg < 4 ? tlo >> (16 * hg) : thi >> (16 * (hg - 4))) & 0xffffull);
  const int h = (int)((trow >> (4 * b)) & 7u);
  const bf16_t* dq = (const bf16_t*)(ws + O_DQ); const bf16_t* dk = (const bf16_t*)(ws + O_DK); const bf16_t* dv = (const bf16_t*)(ws + O_DV);
  const size_t brow = (size_t)b * LP; const int qrel = 64 + qblk * 256;
  const float slope = __int_as_float(0x3f800000 - ((h + 1) << 23));
  const float nslope = -slope / ASCALE;
  unsigned* stash = (unsigned*)(shm_raw + SHM_ATTN);
  f32x16 o[4];
  for (int mp = 0; mp < 2; ++mp) {
    attn_body(dq + (brow + qrel) * 2048 + h * 256 + mp * 128, dk + brow * 2048 + h * 256 + mp * 128, dv + brow * 2048 + h * 256 + vh * 128,
              (const bf16_t*)(ws + O_DKM) + h * 256 + mp * 128, (const bf16_t*)(ws + O_DVM) + h * 256 + vh * 128, qrel, nslope, slope,
              __uint_as_float(((const unsigned*)(ws + O_KMAX))[b * 16 + h * 2 + mp]), (char*)shm_raw, o);
    if (mp == 0) {
      int tid = tid_; asm volatile("" : "+v"(tid));
#pragma unroll
      for (int d = 0; d < 4; ++d)
#pragma unroll
        for (int r = 0; r < 16; r += 2) stash[(d * 8 + (r >> 1)) * 512 + tid] = pk2(o[d][r], o[d][r + 1]);
    }
  }
  int tid = tid_; asm volatile("" : "+v"(tid));
  const int lane = tid & 63, r32 = lane & 31, hi = lane >> 5;
  const float lam = ((const float*)(shm_raw + DYN_LDS_MAIN + 8))[0];
  bf16_t* dd = (bf16_t*)(ws + O_DD); float* dst = (float*)(ws + O_DST);
  const size_t prow = brow + qrel + wid * 32;
  float ss[16];
#pragma unroll
  for (int r = 0; r < 16; ++r) ss[r] = 0.f;
#pragma unroll
  for (int d = 0; d < 4; ++d)
#pragma unroll
    for (int r = 0; r < 16; r += 2) {
      const unsigned s2 = stash[(d * 8 + (r >> 1)) * 512 + tid];
      const float v0 = __uint_as_float(s2 << 16) - lam * o[d][r], v1 = __uint_as_float(s2 & 0xffff0000u) - lam * o[d][r + 1];
      ss[r] += v0 * v0; ss[r + 1] += v1 * v1;
      dd[(prow + crow(r, hi)) * 2048 + h * 256 + vh * 128 + d * 32 + r32] = f2bf(v0);
      dd[(prow + crow(r + 1, hi)) * 2048 + h * 256 + vh * 128 + d * 32 + r32] = f2bf(v1);
    }
#pragma unroll
  for (int r = 0; r < 16; ++r) {
    float s = ss[r];
#pragma unroll
    for (int of = 16; of >= 1; of >>= 1) s += __shfl_xor(s, of);
    if (r32 == 0) dst[(prow + crow(r, hi)) * 16 + h * 2 + vh] = s;
  }
}

DEV void l2_sweep(const Params& P) {
  const f32x4* src = (const f32x4*)P.x + (size_t)(blockIdx.x & 63) * 131072;
  f32x4 a = (f32x4){0.f, 0.f, 0.f, 0.f};
  for (int i = threadIdx.x; i < 131072; i += NTHR) a += src[i];
  if (a[0] + a[1] + a[2] + a[3] == 123456.789f) ((float*)(P.ws + O_DST))[0] = 1.f;
}
#define XB_TMO      128
#define XB_XCNT(j)  (256  + 64 * (j))
#define XB_XSUB(j)  (1280 + 64 * (j))
#define XB_XGEN(j)  (2304 + 64 * (j))
#define XB_TOP      3328
#define XB_TOPGEN   3392
#define XCD_BAR_WORDS 3456
#define XB_SPIN_CAP (1u << 22)
DEV unsigned xb_ld(unsigned* p) { return __hip_atomic_load(p, __ATOMIC_RELAXED, __HIP_MEMORY_SCOPE_AGENT); }
DEV unsigned xb_add(unsigned* p, unsigned v) { return __hip_atomic_fetch_add(p, v, __ATOMIC_RELAXED, __HIP_MEMORY_SCOPE_AGENT); }
DEV unsigned xb_xcc_id() { return (unsigned)__builtin_amdgcn_s_getreg((3 << 11) | 20) & 0xFu; }
#define XB_SPIN(cond, bar) do { unsigned _sp = 0; while (cond) { __builtin_amdgcn_s_sleep(1); \
    if ((++_sp & 255u) == 0u) { if (xb_ld(&(bar)[XB_TMO])) break; if (_sp > XB_SPIN_CAP) { atomicAdd(&(bar)[XB_TMO], 1u); break; } } } } while (0)
struct XcdBarrier { unsigned* bar; unsigned x; volatile LAS unsigned* st; };
DEV XcdBarrier xcd_barrier_post(unsigned* bar, volatile LAS unsigned* st) {
  XcdBarrier b; b.bar = bar; b.x = xb_xcc_id(); b.st = st;
  if (threadIdx.x == 0) (void)xb_add(&bar[XB_XCNT(b.x)], 1u);
  return b;
}
DEV void xcd_barrier_complete(unsigned* bar, unsigned x, unsigned& nloc, unsigned& nx) {
  const unsigned G = gridDim.x * gridDim.y * gridDim.z;
  unsigned sum, cnt, mine, sp = 0u;
  for (;;) {
    sum = 0u; cnt = 0u; mine = 0u;
#pragma unroll
    for (unsigned j = 0; j < 16; ++j) { const unsigned c = xb_ld(&bar[XB_XCNT(j)]); sum += c; cnt += (c > 0u) ? 1u : 0u; mine = (j == x) ? c : mine; }
    if (sum == G) break;
    __builtin_amdgcn_s_sleep(1);
    if ((++sp & 255u) == 0u) { if (xb_ld(&bar[XB_TMO])) break; if (sp > XB_SPIN_CAP) { atomicAdd(&bar[XB_TMO], 1u); break; } }
  }
  nloc = mine > 0u ? mine : 1u; nx = cnt > 0u ? cnt : 1u;
}
DEV void xcd_barrier(const XcdBarrier& b) {
  asm volatile("s_waitcnt vmcnt(0) lgkmcnt(0)" ::: "memory");
  __syncthreads();
  if (threadIdx.x == 0) {
    unsigned* bar = b.bar;
    __builtin_amdgcn_s_waitcnt(0);
    unsigned nloc = b.st[0], nx = b.st[1];
    if (nloc == 0u) { xcd_barrier_complete(bar, b.x, nloc, nx); b.st[0] = nloc; b.st[1] = nx; }
    const unsigned old = xb_add(&bar[XB_XSUB(b.x)], 1u);
    const unsigned gen = old / nloc;
    if (old + 1u == (gen + 1u) * nloc) {
      __builtin_amdgcn_fence(__ATOMIC_RELEASE, "agent");
      asm volatile("s_waitcnt vmcnt(0)" ::: "memory");
      const unsigned og = xb_add(&bar[XB_TOP], 1u);
      const unsigned tg = og / nx;
      if (og + 1u == (tg + 1u) * nx) xb_add(&bar[XB_TOPGEN], 1u);
      else XB_SPIN(xb_ld(&bar[XB_TOPGEN]) == tg, bar);
      __builtin_amdgcn_fence(__ATOMIC_ACQUIRE, "agent");
      xb_add(&bar[XB_XGEN(b.x)], 1u);
      asm volatile("s_waitcnt vmcnt(0)" ::: "memory");
    } else {
      XB_SPIN(xb_ld(&bar[XB_XGEN(b.x)]) == gen, bar);
      __builtin_amdgcn_fence(__ATOMIC_ACQUIRE, "agent");
      asm volatile("s_waitcnt vmcnt(0)" ::: "memory");
    }
  }
  __syncthreads();
}
DEV void gsync_now(const Params& P) {
  XcdBarrier b; b.bar = (unsigned*)(P.ws + O_BAR); b.x = xb_xcc_id(); b.st = (volatile LAS unsigned*)((LAS unsigned char*)shm_raw + DYN_LDS_MAIN);
  xcd_barrier(b);
}
#define gsync(g) gsync_now(P)
#ifndef REP
#define REP 0
#endif
#ifndef DBG_STOP
#define DBG_STOP 0
#endif
DEV void dbg_dump(const Params& P, size_t off, int ld = 2048) {
  const int tid = threadIdx.x, lane = tid & 63, gw = (blockIdx.x * NTHR + tid) >> 6, nw = (gridDim.x * NTHR) >> 6;
  const bf16_t* buf = (const bf16_t*)(P.ws + off);
  for (int r = gw; r < TR; r += nw) {
    const size_t prow = (size_t)(r >> 12) * LP + 64 + (r & 4095);
    for (int i = 0; i < 8; ++i) { const int c = i * 256 + lane * 4; f32x4 v = (f32x4){0.f, 0.f, 0.f, 0.f}; if (c < ld) v = load_bf4(buf + prow * ld + c); for (int j = 0; j < 4; ++j) if (!(fabsf(v[j]) < 1e30f)) v[j] = 10000.f; *(f32x4*)(P.out + (size_t)r * 2048 + c) = v; }
  }
}
#define STOP_AT(k, off) if (DBG_STOP == (k)) { dbg_dump(P, off); return; }
#define STOP_AT2(k, off) if (DBG_STOP == (k)) { dbg_dump(P, off, 1024); return; }
#ifndef ONLY
#define PH(n) true
#else
#define PH(n) ((ONLY) == (n))
#endif
__global__ void __launch_bounds__(NTHR, 2) mega(Params P) {
  cg::grid_group grid = cg::this_grid();
  unsigned char* ws = P.ws;
  volatile LAS unsigned* xst = (volatile LAS unsigned*)((LAS unsigned char*)shm_raw + DYN_LDS_MAIN);
  if (threadIdx.x == 0) { xst[0] = 0u; xst[1] = 0u; xst[2] = 0u; xst[3] = 0u; }
  __syncthreads();
  (void)xcd_barrier_post((unsigned*)(ws + O_BAR), xst);
  if (P.ws == nullptr) grid.sync();
  if (PH(0)) phase_prologue(P);
  if (REP & 4) phase_prologue(P);
  gsync(grid);
  if (PH(1)) for (int gp = G_FFN1_GU; gp <= G_WIN_A; ++gp) { gemm_phase(P, gp); if ((REP & 1) || ((REP & 64) && gp == G_FFN1_GU) || ((REP & 128) && gp == G_FFN1_D)) gemm_phase(P, gp); gsync(grid); if (gp == G_FFN1_D) { STOP_AT(1, O_ACTB) } if (gp == G_WIN_META) { STOP_AT(6, O_GV) } }
  if (PH(2)) for (int u = blockIdx.x; u < 16 * 65; u += gridDim.x) gla_prep_unit(P, u);
  if (REP & 32) for (int u = blockIdx.x; u < 16 * 65; u += gridDim.x) gla_prep_unit(P, u, true);
  gsync(grid);
  STOP_AT2(7, O_KIB)
  STOP_AT2(10, O_QDB)
  if (DBG_STOP == 11) {
    const int tid = threadIdx.x, lane = tid & 63, gw = (blockIdx.x * NTHR + tid) >> 6, nw = (gridDim.x * NTHR) >> 6;
    const bf16_t* b0 = (const bf16_t*)(ws + O_GK); const bf16_t* b1 = (const bf16_t*)(ws + O_GV); const float* dl = (const float*)(ws + O_DL);
    for (int r = gw; r < TR; r += nw) { const size_t prow = (size_t)(r >> 6) * LP + (r & 63);
      for (int i = 0; i < 8; ++i) { const int c = i * 256 + lane * 4; f32x4 v = (f32x4){0.f, 0.f, 0.f, 0.f};
        if (r < 256) v = c < 1024 ? load_bf4(b0 + prow * 1024 + c) : load_bf4(b1 + prow * 2048 + c - 1024);
        else if (r < 272 && c < 256) v = *(const f32x4*)(dl + (size_t)((r - 256) * 2) * 65 * 256 + c);
        *(f32x4*)(P.out + (size_t)r * 2048 + c) = v; } }
    return;
  }
  if (DBG_STOP == 9) {
    const int tid = threadIdx.x, lane = tid & 63, gw = (blockIdx.x * NTHR + tid) >> 6, nw = (gridDim.x * NTHR) >> 6;
    const bf16_t* b0 = (const bf16_t*)(ws + O_GQ); const bf16_t* b1 = (const bf16_t*)(ws + O_GK);
    for (int r = gw; r < TR; r += nw) { const size_t prow = (size_t)(r >> 12) * LP + 64 + (r & 4095);
      for (int i = 0; i < 8; ++i) { const int c = i * 256 + lane * 4; *(f32x4*)(P.out + (size_t)r * 2048 + c) = c < 1024 ? load_bf4(b0 + prow * 1024 + c) : load_bf4(b1 + prow * 1024 + c - 1024); } }
    return;
  }
  if (PH(3)) for (int u = blockIdx.x; u < 256; u += gridDim.x) gla_scan_unit(P, u);
  if (REP & 8) for (int u = blockIdx.x; u < 256; u += gridDim.x) gla_scan_unit(P, u);
  gsync(grid);
  if (DBG_STOP == 8) {
    const int tid = threadIdx.x, lane = tid & 63, gw = (blockIdx.x * NTHR + tid) >> 6, nw = (gridDim.x * NTHR) >> 6;
    const bf16_t* of = (const bf16_t*)P.out; const bf16_t* ob = of + (size_t)TR * 2048; bf16_t* g = (bf16_t*)(ws + O_GR);
    for (int r = gw; r < TR; r += nw) { const size_t prow = (size_t)(r >> 12) * LP + 64 + (r & 4095);
      for (int i = 0; i < 8; ++i) { const int c = i * 256 + lane * 4; store_bf4(g + prow * 2048 + c, load_bf4(of + (size_t)r * 2048 + c) + load_bf4(ob + (size_t)r * 2048 + c)); } }
    gsync(grid);
    dbg_dump(P, O_GR); return;
  }
  if (PH(4)) for (int u = blockIdx.x; u < 1024; u += gridDim.x) gla_finish_unit(P, u);
  if (REP & 16) for (int u = blockIdx.x; u < 1024; u += gridDim.x) gla_finish_unit(P, u, true);
  gsync(grid);
  STOP_AT(2, O_GR)
  if (PH(1)) gemm_phase(P, G_WIN_B);
  if (REP & 1) gemm_phase(P, G_WIN_B);
  gsync(grid);
  if (PH(5)) {
    int tid = threadIdx.x; asm volatile("" : "+v"(tid)); const int lane = tid & 63;
    const int gw = (blockIdx.x * NTHR + tid) >> 6, nw = (gridDim.x * NTHR) >> 6;
    const int kb = gw & 3; const bf16_t* dk = (const bf16_t*)(ws + O_DK); const bf16_t* dkm = (const bf16_t*)(ws + O_DKM);
    unsigned* km = (unsigned*)(ws + O_KMAX);
    float mx = 0.f;
    for (int r = gw >> 2; r < SEQ + 16; r += nw >> 2) {
      const bf16_t* rowp = r < SEQ ? dk + ((size_t)kb * LP + 64 + r) * 2048 : dkm + (size_t)(48 + r - SEQ) * 2048;
      float ssq = 0.f;
#pragma unroll
      for (int i = 0; i < 8; ++i) { const f32x4 v = load_bf4(rowp + lane * 32 + i * 4); ssq += v[0] * v[0] + v[1] * v[1] + v[2] * v[2] + v[3] * v[3]; }
      ssq += __shfl_xor(ssq, 1); ssq += __shfl_xor(ssq, 2);
      mx = fmaxf(mx, ssq);
    }
    if ((lane & 3) == 0) atomicMax(km + kb * 16 + (lane >> 2), __float_as_uint(mx));
  }
  gsync(grid);
  if (PH(5)) {
    float s1 = 0.f, s2 = 0.f;
    for (int i = 0; i < 128; ++i) { s1 = fmaf(P.lq1[i], P.lk1[i], s1); s2 = fmaf(P.lq2[i], P.lk2[i], s2); }
    const float lam = __expf(s1) - __expf(s2) + 0.2f;
    { float* lw = (float*)(shm_raw + DYN_LDS_MAIN + 8); if (threadIdx.x == 0) lw[0] = lam; }
    __syncthreads();
    for (int u = blockIdx.x; u < 1024; u += gridDim.x) attn_unit(P, u);
    if (REP & 2) for (int u = blockIdx.x; u < 1024; u += gridDim.x) attn_unit(P, u);
  }
  gsync(grid);
  if (PH(6)) {
    int tid = threadIdx.x; asm volatile("" : "+v"(tid)); const int lane = tid & 63;
    const int gw = (blockIdx.x * NTHR + tid) >> 6, nw = (gridDim.x * NTHR) >> 6;
    bf16_t* dd = (bf16_t*)(ws + O_DD); const float* dst = (const float*)(ws + O_DST);
    for (int r = gw; r < TR; r += nw) {
      const size_t prow = (size_t)(r >> 12) * LP + 64 + (r & 4095);
      const int col = lane * 32, hh = col >> 8;
      const float rs = rsqrtf((dst[prow * 16 + hh * 2] + dst[prow * 16 + hh * 2 + 1]) * (1.f / 256.f) + EPS) * 0.8f;
#pragma unroll
      for (int i = 0; i < 8; ++i) { bf16_t* p = dd + prow * 2048 + col + i * 4; f32x4 v = load_bf4(p); const f32x4 nw4 = *(const f32x4*)(P.dnorm + ((col + i * 4) & 255)); v = v * nw4 * rs; store_bf4(p, v); }
    }
    int tbase = 0, t = blockIdx.x; bf16_t* wf = (bf16_t*)(ws + O_WF);
    transpose_job(P.w2g, 2048, DFF, wf + (size_t)DFF * 2048, P.n2, false, tbase, t);
    transpose_job(P.w2u, 2048, DFF, wf + (size_t)2 * DFF * 2048, P.n2, false, tbase, t);
    transpose_job(P.w2d, DFF, 2048, wf, nullptr, false, tbase, t);
  }
  gsync(grid);
  STOP_AT(3, O_DD)
  if (PH(1)) for (int gp = G_MERGE; gp <= G_FFN2_D; ++gp) { gemm_phase(P, gp); if (((REP & 1) && gp != G_FFN2_D) || ((REP & 256) && gp == G_OUT) || ((REP & 512) && gp == G_MERGE)) gemm_phase(P, gp); gsync(grid); if (gp == G_MERGE) { STOP_AT(4, O_MRG) } if (gp == G_OUT) { STOP_AT(5, O_ACTB) } }
  if (PH(7)) {
    int tid = threadIdx.x; asm volatile("" : "+v"(tid)); const int lane = tid & 63;
    const int gw = (blockIdx.x * NTHR + tid) >> 6, nw = (gridDim.x * NTHR) >> 6;
    for (int r = gw; r < TR; r += nw) {
      float* p = P.out + (size_t)r * 2048;
      f32x4 v[8]; float ss = 0.f;
#pragma unroll
      for (int i = 0; i < 8; ++i) { v[i] = *(f32x4*)(p + i * 256 + lane * 4); ss += v[i][0] * v[i][0] + v[i][1] * v[i][1] + v[i][2] * v[i][2] + v[i][3] * v[i][3]; }
#pragma unroll
      for (int o = 32; o >= 1; o >>= 1) ss += __shfl_xor(ss, o);
      const float rs = rsqrtf(ss * (1.f / 2048.f) + EPS);
#pragma unroll
      for (int i = 0; i < 8; ++i) { const int c = i * 256 + lane * 4; const f32x4 g = *(const f32x4*)(P.nfin + c); *(f32x4*)(p + c) = v[i] * g * rs; }
    }
  }
}

constexpr size_t DYN_LDS = DYN_LDS_MAIN + 16;
static_assert(DYN_LDS >= 8 * HT * 2 && DYN_LDS >= SHM_ATTN + 65536, "lds");

extern "C" void kernel_launch(void* const* d_in, const int* in_sizes, int n_in, void* d_out, int out_size, void* d_ws, size_t ws_size, hipStream_t stream) {
  if (n_in != 26 || ws_size < WS_TOTAL || out_size != TR * 2048) { fprintf(stderr, "kernel_launch: bad shapes n_in %d ws %zu need %zu out %d\n", n_in, ws_size, WS_TOTAL, out_size); return; }
  static int grid_blocks = 0;
  if (!grid_blocks) {
    hipFuncSetAttribute((const void*)mega, hipFuncAttributeMaxDynamicSharedMemorySize, (int)DYN_LDS);
    int dev = 0, cus = 0, per_cu = 0;
    hipGetDevice(&dev);
    hipDeviceGetAttribute(&cus, hipDeviceAttributeMultiprocessorCount, dev);
    hipOccupancyMaxActiveBlocksPerMultiprocessor(&per_cu, mega, NTHR, DYN_LDS);
    if (per_cu < 1) per_cu = 1;
    grid_blocks = cus;
  }
  Params p{};
  const float** pp = (const float**)&p;
  for (int i = 0; i < 26; ++i) pp[i] = (const float*)d_in[i];
  p.out = (float*)d_out; p.ws = (unsigned char*)d_ws;
  hipMemsetAsync((unsigned char*)d_ws + O_BAR, 0, 16384, stream);
  void* args[] = {&p};
  hipError_t e = hipLaunchCooperativeKernel((void*)mega, dim3(grid_blocks), dim3(NTHR), args, DYN_LDS, stream);
  if (e != hipSuccess) fprintf(stderr, "cooperative launch failed: %s (grid %d)\n", hipGetErrorString(e), grid_blocks);
}
```

```cpp
#include <hip/hip_runtime.h>
#include <hip/hip_cooperative_groups.h>
#include <stdint.h>
#include <cstdio>
namespace cg = cooperative_groups;

#define DEV __device__ __forceinline__
typedef unsigned short bf16_t;
using bf16x8 = __attribute__((ext_vector_type(8))) short;
using s16x4  = __attribute__((ext_vector_type(4))) short;
using f32x4  = __attribute__((ext_vector_type(4))) float;
using f32x16 = __attribute__((ext_vector_type(16))) float;
using u32x4  = __attribute__((ext_vector_type(4))) unsigned;
using u32x2  = __attribute__((ext_vector_type(2))) unsigned;

constexpr int DM = 2048, DFF = 5504, NB = 4, SEQ = 4096, LP = 4160, RP = NB * LP  , TR = NB * SEQ  ;
constexpr int INW = 16416;
constexpr float EPS = 1e-6f;
constexpr size_t DYN_LDS_MAIN = 4 * 64 * 264 * 2 + 64 * 32 * 4;
constexpr int NTHR = 512;

constexpr size_t SZ_ACT = (size_t)RP * 2048 * 2;
constexpr size_t SZ_HALF = (size_t)RP * 1024 * 2;
constexpr size_t SZ_SQ = (size_t)2048 * 2048 * 2;
constexpr size_t SZ_FW = (size_t)DFF * 2048 * 2;
constexpr size_t SZ_HID = (size_t)RP * DFF * 2;
constexpr size_t O_ACTB = 0;
constexpr size_t O_WIN = O_ACTB + SZ_ACT;
constexpr size_t O_WS = O_WIN + SZ_ACT;
constexpr size_t O_WF = O_WS + 3 * SZ_SQ;
constexpr size_t O_HID = O_WF + 3 * SZ_FW;
constexpr size_t O_R = O_HID + SZ_HID;
constexpr size_t O_F = O_R;
constexpr size_t O_GR = O_F + SZ_ACT;
constexpr size_t O_P = O_GR + SZ_ACT;
constexpr size_t SZ_P = (size_t)16 * 65 * 4096 * 2;
constexpr size_t O_LOW = O_P + SZ_P;
constexpr size_t O_DL = O_LOW + (size_t)RP * 32 * 4;
constexpr size_t O_ST = O_DL + (size_t)16 * 2 * 65 * 256 * 4;
constexpr size_t O_ST1 = O_ST + (size_t)RP * 4, O_ST2 = O_ST1 + (size_t)RP * 32 * 4;
constexpr size_t O_DST = O_ST2 + (size_t)RP * 32 * 4;
constexpr size_t O_DKM = O_DST + (size_t)RP * 16 * 4;
constexpr size_t O_DVM = O_DKM + (size_t)64 * 2048 * 2;
constexpr size_t O_BAR = O_DVM + (size_t)64 * 2048 * 2;
constexpr size_t O_KMAX = O_BAR + 14336;
constexpr size_t O_MCNT = O_BAR + 14720;
constexpr size_t WS_TOTAL = O_BAR + 16384;
constexpr size_t O_GQ = O_WF + SZ_FW, O_GK = O_HID + (size_t)256 * DFF * 2, O_GV = O_GK + SZ_HALF, O_QDB = O_GV + SZ_ACT, O_KIB = O_QDB + SZ_HALF;
static_assert(O_GQ + SZ_HALF <= O_HID && O_KIB + SZ_HALF <= O_R, "gla overlay 2");
constexpr size_t O_DQ = O_WF, O_DK = O_DQ + SZ_ACT, O_DV = O_DK + SZ_ACT;
constexpr size_t O_MRG = O_DK;
constexpr size_t O_DD = O_WIN;
static_assert(O_DV + SZ_ACT <= O_R, "diff overlay");

struct Params {
  const float *x, *meta, *n1, *w1g, *w1u, *w1d, *nmix, *win, *wa2f, *baf, *wa2b, *bab, *gnorm,
      *lq1, *lk1, *lq2, *lk2, *dnorm, *wbg, *wbd, *wout, *n2, *w2g, *w2u, *w2d, *nfin;
  float* out;
  unsigned char* ws;
};

extern __shared__ __attribute__((aligned(16))) unsigned char shm_raw[];
#define shm ((bf16_t*)shm_raw)

DEV float bf2f(bf16_t v) { return __uint_as_float(((unsigned)v) << 16); }
typedef __bf16 bf16x2_t __attribute__((ext_vector_type(2)));
typedef float f32x2_t __attribute__((ext_vector_type(2)));
DEV unsigned pk2(float lo, float hi) { f32x2_t v = {lo, hi}; bf16x2_t b = __builtin_convertvector(v, bf16x2_t); return __builtin_bit_cast(unsigned, b); }
DEV bf16_t f2bf(float f) { return (bf16_t)(pk2(f, 0.f) & 0xffffu); }
DEV float to_sgpr(float v) { float r; asm volatile("v_readfirstlane_b32 %0, %1" : "=s"(r) : "v"(v)); return r; }
DEV float sigm(float v) { return 1.f / (1.f + __expf(-v)); }

constexpr int BM = 256, BK = 64, HALF = 128, HT = HALF * BK, NXCD = 8, WGM = 8;
DEV int lds_byte(int r, int c) { int st = (r >> 4) * 2 + (c >> 5), rr = r & 15, cc = c & 31, ob = rr * 64 + cc * 2; return st * 1024 + (ob ^ (((ob >> 9) & 1) << 5)); }
DEV void stage_rc(int b, int& R, int& C) { int st = b / 1024, sb = b % 1024, swz = sb ^ (((sb >> 9) & 1) << 5); R = (st >> 1) * 16 + swz / 64; C = (st & 1) * 32 + (swz % 64) / 2; }

#define LAS __attribute__((address_space(3)))
constexpr int HTB = HALF * BK * 2;
#define PG8_SA(b, h) (((b) * 2 + (h)) * HTB)
#define PG8_SB(b, h) ((4 + (b) * 2 + (h)) * HTB)
#define STAGE(bufoff, gbase, voff) do { _Pragma("unroll") for (int _i = 0; _i < 2; ++_i) \
    __builtin_amdgcn_global_load_lds((const unsigned*)((const char*)(gbase) + (voff)[_i]), (LAS unsigned*)(lds + (bufoff) + ldsw + _i * 8192), 16, 0, 0); } while (0)
#define LDA(dst, b, h) do { _Pragma("unroll") for (int m = 0; m < 4; ++m) _Pragma("unroll") for (int k = 0; k < 2; ++k) dst[m][k] = *(const LAS bf16x8*)(lds + PG8_SA(b, h) + aoff + m * 2048 + k * 1024); } while (0)
#define LDB(dst, b, h) do { _Pragma("unroll") for (int n = 0; n < 2; ++n) _Pragma("unroll") for (int k = 0; k < 2; ++k) dst[n][k] = *(const LAS bf16x8*)(lds + PG8_SB(b, h) + boff + n * 2048 + k * 1024); } while (0)
#define MMA(ai, bj, At_, Bt_) do { __builtin_amdgcn_s_setprio(1); \
    _Pragma("unroll") for (int m = 0; m < 4; ++m) _Pragma("unroll") for (int n = 0; n < 2; ++n) _Pragma("unroll") for (int k = 0; k < 2; ++k) \
      acc[ai][bj][m][n] = __builtin_amdgcn_mfma_f32_16x16x32_bf16(Bt_[n][k], At_[m][k], acc[ai][bj][m][n], 0, 0, 0); \
    __builtin_amdgcn_s_setprio(0); } while (0)
#define WAIT_V(n) asm volatile("s_waitcnt vmcnt(" #n ")" ::: "memory")
#define WAIT_L(n) asm volatile("s_waitcnt lgkmcnt(" #n ")" ::: "memory")
#define BAR __builtin_amdgcn_s_barrier()
#define SCHED __builtin_amdgcn_sched_barrier(0)

DEV void gemm_mainloop(const char* __restrict__ cA, const char* __restrict__ cB0, const char* __restrict__ cB1, const int K, f32x4 (&acc)[2][2][4][2]) {
  LAS unsigned char* lds = (LAS unsigned char*)shm_raw;
  int tid = threadIdx.x; asm volatile("" : "+v"(tid));
  const int wid = __builtin_amdgcn_readfirstlane(tid >> 6), lane = tid & 63, wr = wid >> 2, wc = wid & 3, fr = lane & 15, fq = lane >> 4;
  unsigned voff[2];
#pragma unroll
  for (int i = 0; i < 2; ++i) { int R, C; stage_rc(tid * 16 + i * 8192, R, C); voff[i] = (unsigned)(R * K + C) * 2u; }
  const size_t kstep = (size_t)(BK * 2), hstep = (size_t)HALF * K * 2;
  const unsigned ldsw = (unsigned)wid * 1024u;
  const int aoff = lds_byte(wr * 64 + fr, fq * 8), boff = lds_byte(wc * 32 + fr, fq * 8);
  bf16x8 At[4][2], B0[2][2], B1[2][2];
  const int nt = K / BK;
  STAGE(PG8_SB(0, 0), cB0, voff); STAGE(PG8_SB(0, 1), cB1, voff); STAGE(PG8_SA(0, 0), cA, voff); STAGE(PG8_SA(0, 1), cA + hstep, voff);
  if (wr == 1) BAR;
  WAIT_V(2); BAR;
  STAGE(PG8_SB(1, 0), cB0 + kstep, voff); STAGE(PG8_SA(1, 0), cA + kstep, voff); STAGE(PG8_SB(1, 1), cB1 + kstep, voff);
  WAIT_V(6); BAR;
  for (int t = 0; t < nt; t += 2) {
    const int t2 = (t == nt - 2) ? 0 : t + 2;
    const char* a1 = cA + (size_t)(t + 1) * kstep + hstep;
    const char* a2 = cA + (size_t)t2 * kstep; const char* b02 = cB0 + (size_t)t2 * kstep; const char* b12 = cB1 + (size_t)t2 * kstep;
    LDB(B0, 0, 0); LDB(B1, 0, 1); SCHED; LDA(At, 0, 0); STAGE(PG8_SA(1, 1), a1, voff);
    WAIT_V(8); WAIT_L(0); BAR; MMA(0, 0, At, B0); MMA(0, 1, At, B1); BAR; SCHED;
    LDA(At, 0, 1); STAGE(PG8_SB(0, 0), b02, voff); STAGE(PG8_SB(0, 1), b12, voff); STAGE(PG8_SA(0, 0), a2, voff);
    WAIT_V(8); WAIT_L(0); BAR; MMA(1, 0, At, B0); MMA(1, 1, At, B1); BAR; SCHED;
    LDB(B0, 1, 0); LDB(B1, 1, 1); SCHED; LDA(At, 1, 0); STAGE(PG8_SA(0, 1), a2 + hstep, voff);
    WAIT_V(8); WAIT_L(0); BAR; MMA(0, 0, At, B0); MMA(0, 1, At, B1); BAR; SCHED;
    LDA(At, 1, 1); STAGE(PG8_SB(1, 0), b02 + kstep, voff); STAGE(PG8_SB(1, 1), b12 + kstep, voff); STAGE(PG8_SA(1, 0), a2 + kstep, voff);
    WAIT_V(8); WAIT_L(0); BAR; MMA(1, 0, At, B0); MMA(1, 1, At, B1); BAR; SCHED;
  }
  WAIT_V(0);
  if (wr == 0) BAR;
  BAR;
}

enum { G_FFN1_GU = 0, G_FFN1_D, G_WIN_A, G_WIN_META, G_WIN_B, G_MERGE, G_OUT, G_FFN2_GU, G_FFN2_D };

DEV void store_bf4(bf16_t* p, f32x4 v) { u32x2 w; w.x = pk2(v[0], v[1]); w.y = pk2(v[2], v[3]); *(u32x2*)p = w; }
DEV f32x4 load_bf4(const bf16_t* p) { u32x2 w = *(const u32x2*)p; f32x4 v; v[0] = __uint_as_float(w.x << 16); v[1] = __uint_as_float(w.x & 0xffff0000u); v[2] = __uint_as_float(w.y << 16); v[3] = __uint_as_float(w.y & 0xffff0000u); return v; }

DEV void main_order(int L, int nN, int& pm, int& pn) {
  const int nwg = 64 * nN;
  int wgid = L; { const int q = nwg / NXCD, r = nwg % NXCD, xcd = wgid % NXCD, off = wgid / NXCD; wgid = (xcd < r ? xcd * (q + 1) : r * (q + 1) + (xcd - r) * q) + off; }
  const int nig = WGM * nN, gid = wgid / nig, fm = gid * WGM;
  pm = fm + ((wgid % nig) % WGM); pn = (wgid % nig) / WGM;
}

DEV void gemm_phase(const Params& P, const int gp) {
  int tid = threadIdx.x; asm volatile("" : "+v"(tid));
  const int wid = __builtin_amdgcn_readfirstlane(tid >> 6), lane = tid & 63, wr = wid >> 2, wc = wid & 3, fr_ = lane & 15, fq_ = lane >> 4;
  unsigned char* ws = P.ws;
  float* stats = (float*)(ws + O_ST);
  int nN, nPre = 0, nMain, nMeta = 0, pnoff = 0;
  switch (gp) {
    case G_FFN1_GU: nN = 43; nMeta = 43; break;
    case G_FFN1_D: nN = 8; break;
    case G_WIN_A: nN = 25; nPre = 8; nMeta = 65; break;
    case G_WIN_META: nN = 0; nMeta = 65; break;
    case G_WIN_B: nN = 40; pnoff = 25; break;
    case G_MERGE: nN = 8; break;
    case G_OUT: nN = 8; break;
    case G_FFN2_GU: nN = 43; break;
    default: nN = 8; break;
  }
  nMain = 64 * nN;
  const int ntiles = nPre + nMain + nMeta;
  for (int t = blockIdx.x; t < ntiles; t += gridDim.x) {
    int pm, pn, kind = gp;
    bool meta = false;
    if (t < nPre) { pm = 64; pn = t; meta = true; kind = G_FFN1_D; }
    else if (t < nPre + nMain) {
      if (nN == 8 && nPre == 0 && gridDim.x == 256) { const int c_ = t & 255; pm = 32 * (t >> 8) + (c_ & 7) * 4 + (c_ >> 6); pn = (c_ >> 3) & 7; }
      else { main_order(t - nPre, nN, pm, pn); pn += pnoff; }
    }
    else { pm = 64; pn = t - nPre - nMain; meta = true; }
    const int arow0 = meta ? 0 : (pm >> 4) * LP + 64 + (pm & 15) * 256;
    const int nrow0 = pm * 256;
    if (gp == G_WIN_A && t >= nPre + nMain) {
      if (tid == 0) {
        unsigned* cnt = (unsigned*)(ws + O_MCNT); unsigned sp = 0;
        while (__hip_atomic_load(cnt, __ATOMIC_RELAXED, __HIP_MEMORY_SCOPE_AGENT) < 8u) { __builtin_amdgcn_s_sleep(2); if (++sp > (1u << 24)) break; }
        __builtin_amdgcn_fence(__ATOMIC_ACQUIRE, "agent");
        asm volatile("s_waitcnt vmcnt(0)" ::: "memory");
      }
      __syncthreads();
    }
    const bf16_t *A, *B0p, *B1p; int K;
    switch (kind) {
      case G_FFN1_GU: A = (const bf16_t*)(ws + O_ACTB); K = 2048; B0p = (const bf16_t*)(ws + O_WF) + (size_t)DFF * 2048 + (size_t)pn * 128 * 2048; B1p = B0p + (size_t)DFF * 2048; break;
      case G_FFN2_GU: A = (const bf16_t*)(ws + O_ACTB); K = 2048; B0p = (const bf16_t*)(ws + O_WF) + (size_t)DFF * 2048 + (size_t)pn * 128 * 2048; B1p = B0p + (size_t)DFF * 2048; break;
      case G_FFN1_D: case G_FFN2_D: A = (const bf16_t*)(ws + O_HID); K = DFF; B0p = (const bf16_t*)(ws + O_WF) + (size_t)pn * 256 * DFF; B1p = B0p + (size_t)128 * DFF; break;
      case G_WIN_A: case G_WIN_META: case G_WIN_B: A = (const bf16_t*)(ws + O_ACTB); K = 2048; B0p = (const bf16_t*)(ws + O_WIN) + (size_t)pn * 256 * 2048; B1p = B0p + (size_t)128 * 2048; break;
      case G_MERGE: A = (const bf16_t*)(ws + O_GR); K = 2048; B0p = (const bf16_t*)(ws + O_WS) + (size_t)pn * 256 * 2048; B1p = B0p + (size_t)128 * 2048; break;
      default  : A = (const bf16_t*)(ws + O_MRG); K = 2048; B0p = (const bf16_t*)(ws + O_WS) + 2 * (size_t)2048 * 2048 + (size_t)pn * 256 * 2048; B1p = B0p + (size_t)128 * 2048; break;
    }
    f32x4 acc[2][2][4][2];
#pragma unroll
    for (int a = 0; a < 2; ++a)
#pragma unroll
      for (int b = 0; b < 2; ++b)
#pragma unroll
        for (int m = 0; m < 4; ++m)
#pragma unroll
          for (int n = 0; n < 2; ++n) acc[a][b][m][n] = (f32x4){0.f, 0.f, 0.f, 0.f};
    const int nk = (kind == G_MERGE) ? 2 : 1;
    for (int kl = 0; kl < nk; ++kl) {
      if (kl == 1) {
        int fr = fr_, fq = fq_; asm volatile("" : "+v"(fr), "+v"(fq));
        const bf16_t* gA = (const bf16_t*)P.out; const bf16_t* gB = gA + (size_t)TR * 2048;
#pragma unroll
      for (int aim = 0; aim < 4; ++aim) {
          const int ai = aim >> 1, m0 = (aim & 1) * 2;
          u32x2 ga[2][2][2], gb[2][2][2];
#pragma unroll
          for (int mm = 0; mm < 2; ++mm) {
            const int m = m0 + mm;
            const size_t nrow = (size_t)(nrow0 + ai * 128 + wr * 64 + m * 16 + fr) * 2048;
#pragma unroll
            for (int bj = 0; bj < 2; ++bj)
#pragma unroll
              for (int n = 0; n < 2; ++n) { const int col = pn * 256 + bj * 128 + wc * 32 + n * 16 + fq * 4; ga[mm][bj][n] = *(const u32x2*)(gA + nrow + col); gb[mm][bj][n] = *(const u32x2*)(gB + nrow + col); }
          }
          asm volatile("" ::: "memory"); SCHED;
#pragma unroll
          for (int mm = 0; mm < 2; ++mm)
#pragma unroll
            for (int bj = 0; bj < 2; ++bj)
#pragma unroll
              for (int n = 0; n < 2; ++n) {
                const int m = m0 + mm;
                const u32x2 wa = ga[mm][bj][n], wb = gb[mm][bj][n];
                const float a4[4] = {__uint_as_float(wa.x << 16), __uint_as_float(wa.x & 0xffff0000u), __uint_as_float(wa.y << 16), __uint_as_float(wa.y & 0xffff0000u)};
                const float b4[4] = {__uint_as_float(wb.x << 16), __uint_as_float(wb.x & 0xffff0000u), __uint_as_float(wb.y << 16), __uint_as_float(wb.y & 0xffff0000u)};
#pragma unroll
                for (int j = 0; j < 4; ++j) { float ea = __expf(-fminf(fmaxf(a4[j], -40.f), 40.f)), eb = __expf(-fminf(fmaxf(b4[j], -40.f), 40.f)); acc[ai][bj][m][n][j] *= (1.f + eb) / (1.f + ea); }
              }
          asm volatile("" ::: "memory"); SCHED;
        }
        A = (const bf16_t*)(ws + O_DD); B0p += (size_t)2048 * 2048; B1p += (size_t)2048 * 2048;
        asm volatile("s_waitcnt vmcnt(0)" ::: "memory");
      }
      gemm_mainloop((const char*)(A + (size_t)arow0 * K), (const char*)B0p, (const char*)B1p, K, acc);
    }
    int fr = fr_, fq = fq_; asm volatile("" : "+v"(fr), "+v"(fq));
    if (kind == G_FFN1_GU || kind == G_FFN2_GU || kind == G_WIN_A || kind == G_WIN_META || kind == G_WIN_B) {
      float* rsl = (float*)shm_raw;
      const int tid2 = wid * 64 + (int)__builtin_amdgcn_mbcnt_hi(~0u, __builtin_amdgcn_mbcnt_lo(~0u, 0u));
      if (tid2 < 256) {
        const size_t row = (size_t)(arow0 + tid2); float sum;
        if (kind == G_FFN1_GU) sum = stats[row];
        else { const f32x4* pp = (const f32x4*)((const float*)(ws + (kind == G_FFN2_GU ? O_ST2 : O_ST1)) + row * 32); f32x4 a = pp[0];
#pragma unroll
          for (int i = 1; i < 8; ++i) a += pp[i];
          sum = (a[0] + a[1]) + (a[2] + a[3]); }
        rsl[tid2] = rsqrtf(sum * (1.f / 2048.f) + EPS);
      }
      __syncthreads();
    }
    if (kind == G_FFN1_GU || kind == G_FFN2_GU) {
      const float* rsl = (const float*)shm_raw;
      bf16_t* hid = (bf16_t*)(ws + O_HID);
#pragma unroll
      for (int ai = 0; ai < 2; ++ai)
#pragma unroll
        for (int m = 0; m < 4; ++m) {
          const int r = ai * 128 + wr * 64 + m * 16 + fr;
          if (meta && (r < 48 || r >= 64)) continue;
          const int prow = arow0 + r;
          const float rs = rsl[r];
#pragma unroll
          for (int n = 0; n < 2; ++n) {
            f32x4 g = acc[ai][0][m][n] * rs, u = acc[ai][1][m][n] * rs, h;
#pragma unroll
            for (int j = 0; j < 4; ++j) h[j] = g[j] * sigm(g[j]) * u[j];
            store_bf4(hid + (size_t)prow * DFF + pn * 128 + wc * 32 + n * 16 + fq * 4, h);
          }
          asm volatile("" ::: "memory"); SCHED;
        }
    } else if (kind == G_FFN1_D || kind == G_OUT || kind == G_FFN2_D) {
      const float* resA = (kind == G_FFN2_D) ? P.out : P.x;
      const bf16_t* resF = (kind == G_OUT) ? (const bf16_t*)(ws + O_F) : nullptr;
      float* outF32 = (kind == G_FFN1_D) ? nullptr : P.out;
      bf16_t* outB = (kind == G_FFN2_D) ? nullptr : (bf16_t*)(ws + O_ACTB);
      bf16_t* outF = (kind == G_FFN1_D && !meta) ? (bf16_t*)(ws + O_F) : nullptr;
      const float scale = (kind == G_OUT) ? 1.f : 0.5f;
      float* st = (kind == G_FFN1_D) ? (float*)(ws + O_ST1) : (kind == G_OUT ? (float*)(ws + O_ST2) : nullptr);
#pragma unroll
      for (int aim = 0; aim < 4; ++aim) {
        const int ai = aim >> 1, m0 = (aim & 1) * 2;
        f32x4 rres[2][2][2];
#pragma unroll
        for (int mm = 0; mm < 2; ++mm) {
          const int m = m0 + mm;
          const int r = ai * 128 + wr * 64 + m * 16 + fr;
          const bool rowok = !(meta && (r < 48 || r >= 64));
          const size_t prow = arow0 + r, nrow = nrow0 + r;
          const float* rp = meta ? (P.meta + (size_t)(rowok ? r - 48 : 0) * 2048) : (resA + nrow * 2048);
#pragma unroll
          for (int bj = 0; bj < 2; ++bj)
#pragma unroll
            for (int n = 0; n < 2; ++n) {
              const int col = pn * 256 + bj * 128 + wc * 32 + n * 16 + fq * 4;
              rres[mm][bj][n] = *(const f32x4*)(rp + col);
            }
        }
        asm volatile("" ::: "memory"); SCHED;
#pragma unroll
        for (int mm = 0; mm < 2; ++mm) {
          const int m = m0 + mm;
          const int r = ai * 128 + wr * 64 + m * 16 + fr;
          const bool rowok = !(meta && (r < 48 || r >= 64));
          const size_t prow = arow0 + r, nrow = nrow0 + r;
          float ss = 0.f;
#pragma unroll
          for (int bj = 0; bj < 2; ++bj)
#pragma unroll
            for (int n = 0; n < 2; ++n) {
              const int col = pn * 256 + bj * 128 + wc * 32 + n * 16 + fq * 4;
              f32x4 res = rres[mm][bj][n];
              if (resF) { const u32x2 w = *(const u32x2*)(resF + prow * 2048 + col); res[0] += __uint_as_float(w.x << 16); res[1] += __uint_as_float(w.x & 0xffff0000u); res[2] += __uint_as_float(w.y << 16); res[3] += __uint_as_float(w.y & 0xffff0000u); }
              const f32x4 d = acc[ai][bj][m][n] * scale, v = res + d;
              if (rowok) {
                if (outF32) *(f32x4*)(outF32 + nrow * 2048 + col) = v;
                if (outB) store_bf4(outB + prow * 2048 + col, v);
                if (outF) store_bf4(outF + prow * 2048 + col, d);
              }
              ss += v[0] * v[0] + v[1] * v[1] + v[2] * v[2] + v[3] * v[3];
            }
          ss += __shfl_xor(ss, 16); ss += __shfl_xor(ss, 32);
          if (fq == 0 && st && rowok) st[prow * 32 + pn * 4 + wc] = ss;
        }
        asm volatile("" ::: "memory"); SCHED;
      }
    } else if (kind == G_MERGE) {
      const bf16_t* gB = (const bf16_t*)P.out + (size_t)TR * 2048;
      bf16_t* mo = (bf16_t*)(ws + O_MRG);
#pragma unroll
      for (int ai = 0; ai < 2; ++ai) {
        u32x2 gw[4][2][2];
#pragma unroll
        for (int m = 0; m < 4; ++m) {
          const size_t nrow = nrow0 + ai * 128 + wr * 64 + m * 16 + fr;
#pragma unroll
          for (int bj = 0; bj < 2; ++bj)
#pragma unroll
            for (int n = 0; n < 2; ++n) gw[m][bj][n] = *(const u32x2*)(gB + nrow * 2048 + pn * 256 + bj * 128 + wc * 32 + n * 16 + fq * 4);
        }
        asm volatile("" ::: "memory"); SCHED;
#pragma unroll
        for (int m = 0; m < 4; ++m) {
          const size_t prow = arow0 + ai * 128 + wr * 64 + m * 16 + fr;
#pragma unroll
          for (int bj = 0; bj < 2; ++bj)
#pragma unroll
            for (int n = 0; n < 2; ++n) {
              const int col = pn * 256 + bj * 128 + wc * 32 + n * 16 + fq * 4;
              const u32x2 w = gw[m][bj][n];
              const float b4[4] = {__uint_as_float(w.x << 16), __uint_as_float(w.x & 0xffff0000u), __uint_as_float(w.y << 16), __uint_as_float(w.y & 0xffff0000u)};
              f32x4 v;
#pragma unroll
              for (int j = 0; j < 4; ++j) v[j] = acc[ai][bj][m][n][j] / (1.f + __expf(-fminf(fmaxf(b4[j], -40.f), 40.f)));
              store_bf4(mo + prow * 2048 + col, v);
            }
        }
        asm volatile("" ::: "memory"); SCHED;
      }
    } else {
      const float* rsl = (const float*)shm_raw;
      bf16_t* dst; int ld, c0; bool natural = false, isLow = false;
      if (pn < 4) { dst = (bf16_t*)(ws + O_GQ); ld = 1024; c0 = pn * 256; }
      else if (pn < 8) { dst = (bf16_t*)(ws + O_GK); ld = 1024; c0 = (pn - 4) * 256; }
      else if (pn < 16) { dst = (bf16_t*)(ws + O_GV); ld = 2048; c0 = (pn - 8) * 256; }
      else if (pn < 24) { dst = (bf16_t*)(ws + O_GR); ld = 2048; c0 = (pn - 16) * 256; }
      else if (pn == 24) { dst = nullptr; ld = 32; c0 = 0; isLow = true; }
      else if (pn < 33) { dst = (bf16_t*)(ws + O_DQ); ld = 2048; c0 = (pn - 25) * 256; }
      else if (pn < 41) { dst = (bf16_t*)(ws + O_DK); ld = 2048; c0 = (pn - 33) * 256; }
      else if (pn < 49) { dst = (bf16_t*)(ws + O_DV); ld = 2048; c0 = (pn - 41) * 256; }
      else if (pn < 57) { dst = (bf16_t*)P.out; ld = 2048; c0 = (pn - 49) * 256; natural = true; }
      else { dst = (bf16_t*)P.out + (size_t)TR * 2048; ld = 2048; c0 = (pn - 57) * 256; natural = true; }
      float* low = (float*)(ws + O_LOW);
      bool single = false;
      if (meta && pn >= 25) { single = true; if (pn >= 33 && pn < 41) dst = (bf16_t*)(ws + O_DKM); else if (pn >= 41 && pn < 49) dst = (bf16_t*)(ws + O_DVM); else natural = true; }
      if (!(meta && natural)) {
#pragma unroll
        for (int ai = 0; ai < 2; ++ai)
#pragma unroll
          for (int m = 0; m < 4; ++m) {
            const int r = ai * 128 + wr * 64 + m * 16 + fr;
            if (meta && r >= 64) continue;
            const size_t prow = arow0 + r, nrow = nrow0 + r;
            const float rs = rsl[r];
            const bool zero = meta && r < 48;
#pragma unroll
            for (int bj = 0; bj < 2; ++bj)
#pragma unroll
              for (int n = 0; n < 2; ++n) {
                const int cc = bj * 128 + wc * 32 + n * 16 + fq * 4;
                f32x4 v = acc[ai][bj][m][n] * rs;
                if (zero) v = (f32x4){0.f, 0.f, 0.f, 0.f};
                if (isLow) {
                  if (cc < 32) { if (meta) { for (int b4 = 0; b4 < 4; ++b4) *(f32x4*)(low + (size_t)(b4 * LP + r) * 32 + cc) = v; } else *(f32x4*)(low + prow * 32 + cc) = v; }
                } else if (single) {
                  store_bf4(dst + (size_t)r * ld + c0 + cc, v);
                } else if (meta) {
                  for (int b4 = 0; b4 < 4; ++b4) store_bf4(dst + (size_t)(b4 * LP + r) * ld + c0 + cc, v);
                } else {
                  store_bf4(dst + (natural ? nrow : prow) * ld + c0 + cc, v);
                }
              }
            asm volatile("" ::: "memory"); SCHED;
          }
      }
    }
    asm volatile("s_waitcnt vmcnt(0)" ::: "memory");
    __syncthreads();
    if (gp == G_WIN_A && t < nPre && tid == 0) {
      __builtin_amdgcn_fence(__ATOMIC_RELEASE, "agent");
      asm volatile("s_waitcnt vmcnt(0)" ::: "memory");
      __hip_atomic_fetch_add((unsigned*)(ws + O_MCNT), 1u, __ATOMIC_RELAXED, __HIP_MEMORY_SCOPE_AGENT);
    }
  }
}

struct TReg { f32x4 v[8]; };
DEV void tt_load(const float* __restrict__ src, int K, int N, const float* __restrict__ gain, int tk, int tn, TReg& r) {
  const int tid = threadIdx.x, k0 = tk * 128, n0 = tn * 128;
#pragma unroll
  for (int i = 0; i < 8; ++i) {
    const int kr = i * 16 + (tid >> 5), nc = (tid & 31) * 4;
    f32x4 v = (f32x4){0.f, 0.f, 0.f, 0.f};
    if (n0 + nc < N) v = *(const f32x4*)(src + (size_t)(k0 + kr) * N + n0 + nc);
    if (gain) v = v * gain[k0 + kr];
    r.v[i] = v;
  }
}
DEV void tt_store(int K, int N, bf16_t* __restrict__ dst, bool winmap, int tk, int tn, const TReg& r) {
  const int tid = threadIdx.x;
  bf16_t* T = shm;
  const int k0 = tk * 128, n0 = tn * 128;
  __syncthreads();
#pragma unroll
  for (int i = 0; i < 8; ++i) {
    const int kr = i * 16 + (tid >> 5), nc = (tid & 31) * 4;
    unsigned* tp = (unsigned*)(T + kr * 130 + nc);
    tp[0] = pk2(r.v[i][0], r.v[i][1]); tp[1] = pk2(r.v[i][2], r.v[i][3]);
  }
  __syncthreads();
  const int nr = tid >> 2, n = n0 + nr;
  if (n < N) {
    const int drow = winmap ? (n < 6176 ? n : n + 224) : n;
#pragma unroll
    for (int q = 0; q < 4; ++q) {
      const int kk = (tid & 3) * 8 + q * 32;
      unsigned short e[8];
#pragma unroll
      for (int i = 0; i < 8; ++i) e[i] = T[(kk + i) * 130 + nr];
      u32x4 w; w.x = e[0] | ((unsigned)e[1] << 16); w.y = e[2] | ((unsigned)e[3] << 16); w.z = e[4] | ((unsigned)e[5] << 16); w.w = e[6] | ((unsigned)e[7] << 16);
      *(u32x4*)(dst + (size_t)drow * K + k0 + kk) = w;
    }
  }
}

DEV void transpose_job(const float* src, int K, int N, bf16_t* dst, const float* gain, bool winmap, int& tbase, int& t) {
  const int ntn = (N + 127) / 128, nt = (K / 128) * ntn, tend = tbase + nt;
  TReg cur, nxt;
  if (t < tend) { const int l = t - tbase; tt_load(src, K, N, gain, l / ntn, l % ntn, cur); }
  while (t < tend) {
    const int l = t - tbase, t2 = t + gridDim.x;
    if (t2 < tend) { const int l2 = t2 - tbase; tt_load(src, K, N, gain, l2 / ntn, l2 % ntn, nxt); }
    tt_store(K, N, dst, winmap, l / ntn, l % ntn, cur);
    cur = nxt; t = t2;
  }
  tbase += nt;
}

DEV void phase_prologue(const Params& P) {
  unsigned char* ws = P.ws;
  const int tid = threadIdx.x, gtid = blockIdx.x * NTHR + tid, gsz = gridDim.x * NTHR;
  { u32x4* z = (u32x4*)((bf16_t*)(ws + O_WIN) + (size_t)6176 * 2048); const int nz = 224 * 2048 / 8;
    for (int i = gtid; i < nz; i += gsz) z[i] = (u32x4){0u, 0u, 0u, 0u}; }
  { const int gw = (blockIdx.x * NTHR + tid) >> 6, nw = gsz >> 6, lane = tid & 63;
    bf16_t* xb = (bf16_t*)(ws + O_ACTB); float* st0 = (float*)(ws + O_ST);
    for (int r = gw; r < TR + 16; r += nw) {
      const float* src; size_t prow;
      if (r < TR) { src = P.x + (size_t)r * 2048; prow = (size_t)(r >> 12) * LP + 64 + (r & 4095); } else { src = P.meta + (size_t)(r - TR) * 2048; prow = 48 + (r - TR); }
      float ss = 0.f;
#pragma unroll
      for (int i = 0; i < 8; ++i) { const int c = i * 256 + lane * 4; f32x4 v = *(const f32x4*)(src + c); ss += v[0] * v[0] + v[1] * v[1] + v[2] * v[2] + v[3] * v[3]; store_bf4(xb + prow * 2048 + c, v); }
#pragma unroll
      for (int o = 32; o >= 1; o >>= 1) ss += __shfl_xor(ss, o);
      if (lane == 0) st0[prow] = ss;
    } }
  int tbase = 0, t = blockIdx.x;
  bf16_t* wf = (bf16_t*)(ws + O_WF); bf16_t* wsq = (bf16_t*)(ws + O_WS);
  transpose_job(P.w1g, 2048, DFF, wf + (size_t)DFF * 2048, P.n1, false, tbase, t);
  transpose_job(P.w1u, 2048, DFF, wf + (size_t)2 * DFF * 2048, P.n1, false, tbase, t);
  transpose_job(P.w1d, DFF, 2048, wf, nullptr, false, tbase, t);
  transpose_job(P.win, 2048, INW, (bf16_t*)(ws + O_WIN), P.nmix, true, tbase, t);
  transpose_job(P.wbg, 2048, 2048, wsq, nullptr, false, tbase, t);
  transpose_job(P.wbd, 2048, 2048, wsq + (size_t)2048 * 2048, nullptr, false, tbase, t);
  transpose_job(P.wout, 2048, 2048, wsq + (size_t)2 * 2048 * 2048, nullptr, false, tbase, t);
}

DEV f32x4 mfma16(bf16x8 a, bf16x8 b, f32x4 c) { return __builtin_amdgcn_mfma_f32_16x16x32_bf16(a, b, c, 0, 0, 0); }
#define LD8(p) (*reinterpret_cast<const bf16x8*>(p))

DEV void gla_prep_unit(const Params& P, int u, bool dummy = false) {
  unsigned char* ws = P.ws;
  const bool st_ok = !dummy || (P.ws == nullptr);
  int tid = threadIdx.x; asm volatile("" : "+v"(tid));
  const int w = tid >> 6, lane = tid & 63, fr = lane & 15, fq = lane >> 4;
  const int c = u % 65, bh = u / 65, b = bh >> 2, h = bh & 3;
  bf16_t* QD0 = shm; bf16_t* KI0 = QD0 + 64 * 264; bf16_t* QD1 = KI0 + 64 * 264; bf16_t* KI1 = QD1 + 64 * 264;
  float* LOWs = (float*)(KI1 + 64 * 264);
  bf16_t* gq = (bf16_t*)(ws + O_GQ); bf16_t* gk = (bf16_t*)(ws + O_GK);
  const size_t prow0 = (size_t)b * LP + c * 64;
  const int dir = tid >> 8, k = tid & 255, col = h * 256 + k;
  unsigned qk[64];
#pragma unroll
  for (int tt = 0; tt < 64; ++tt) { const int t = dir ? 63 - tt : tt; qk[tt] = (unsigned)gq[(prow0 + t) * 1024 + col] | ((unsigned)gk[(prow0 + t) * 1024 + col] << 16); }
  __syncthreads();
  { const int idx = tid * 4, row = idx >> 5, cl = idx & 31;
    *(f32x4*)(LOWs + idx) = *(const f32x4*)((const float*)(ws + O_LOW) + (prow0 + row) * 32 + cl); }
  __syncthreads();
  {
    const float* wa2 = dir ? P.wa2b : P.wa2f;
    float wv[16];
#pragma unroll
    for (int r = 0; r < 16; ++r) wv[r] = wa2[r * 1024 + col];
    const float bias = (dir ? P.bab : P.baf)[col];
    bf16_t* QD = dir ? QD1 : QD0; bf16_t* KI = dir ? KI1 : KI0;
    float bc = 0.f;
#pragma unroll
    for (int tt = 0; tt < 64; ++tt) {
      const int t = dir ? 63 - tt : tt;
      const f32x4* lr = (const f32x4*)(LOWs + t * 32 + dir * 16);
      const f32x4 l0 = lr[0], l1 = lr[1], l2 = lr[2], l3 = lr[3];
      float z = bias;
#pragma unroll
      for (int r = 0; r < 4; ++r) { z = fmaf(l0[r], wv[r], z); z = fmaf(l1[r], wv[4 + r], z); z = fmaf(l2[r], wv[8 + r], z); z = fmaf(l3[r], wv[12 + r], z); }
      const float ls = fminf(z, 0.f) - __logf(1.f + __expf(-fabsf(z)));
      const bool valid = !(c == 0 && t < 48);
      bc += valid ? ls * 0.0625f : 0.f;
      const float e = __expf(bc), ei = __expf(-bc);
      QD[t * 264 + k] = f2bf(__uint_as_float(qk[tt] << 16) * e * 0.0625f);
      KI[t * 264 + k] = f2bf(__uint_as_float(qk[tt] & 0xffff0000u) * ei);
    }
    if (st_ok) ((float*)(ws + O_DL))[((size_t)(bh * 2 + dir) * 65 + c) * 256 + k] = __expf(bc);
  }
  __syncthreads();
  if (c >= 1) {
    const int d = w >> 2, ti = w & 3;
    const bf16_t* QD = d ? QD1 : QD0; const bf16_t* KI = d ? KI1 : KI0;
    bf16_t* Pg = (bf16_t*)(ws + O_P) + (size_t)u * 4096;
#pragma unroll
    for (int tj = 0; tj < 4; ++tj) {
      f32x4 a4 = (f32x4){0.f, 0.f, 0.f, 0.f};
#pragma unroll
      for (int kk = 0; kk < 8; ++kk) a4 = mfma16(LD8(QD + (ti * 16 + fr) * 264 + kk * 32 + fq * 8), LD8(KI + (tj * 16 + fr) * 264 + kk * 32 + fq * 8), a4);
#pragma unroll
      for (int r = 0; r < 4; ++r) { const int i = ti * 16 + fq * 4 + r, j = tj * 16 + fr; const bool keep = d ? (j > i) : (j <= i); if (keep && st_ok) Pg[i * 64 + j] = f2bf(a4[r]); }
    }
  }
  bf16_t* qdb = (bf16_t*)(ws + O_QDB); bf16_t* kib = (bf16_t*)(ws + O_KIB);
#pragma unroll
  for (int i = 0; i < 4; ++i) {
    const int p = tid + 512 * i, tok = p >> 5, kc = (p & 31) * 8;
    const size_t g = (prow0 + tok) * 1024 + h * 256 + kc;
    if (st_ok) { *(u32x4*)(gq + g) = *(const u32x4*)(QD0 + tok * 264 + kc);
    *(u32x4*)(qdb + g) = *(const u32x4*)(QD1 + tok * 264 + kc); }
  }
  {
    const bf16_t* KI = dir ? KI1 : KI0;
    bf16_t* dst = (dir ? kib : gk) + (prow0 + (k >> 2)) * 1024 + h * 256 + (k & 3) * 64;
#pragma unroll
    for (int q = 0; q < 8; ++q) {
      unsigned e[8];
#pragma unroll
      for (int i = 0; i < 8; ++i) e[i] = KI[(q * 8 + i) * 264 + k];
      u32x4 wv4; wv4.x = e[0] | (e[1] << 16); wv4.y = e[2] | (e[3] << 16); wv4.z = e[4] | (e[5] << 16); wv4.w = e[6] | (e[7] << 16);
      if (st_ok) *(u32x4*)(dst + q * 8) = wv4;
    }
  }
  __syncthreads();
  bf16_t* gv = (bf16_t*)(ws + O_GV);
  bf16_t* VN = shm;
#pragma unroll
  for (int q = 0; q < 8; ++q) {
    const int p = tid + 512 * q, tok = p >> 6, vc = (p & 63) * 8;
    *(u32x4*)(VN + tok * 520 + vc) = *(const u32x4*)(gv + (prow0 + tok) * 2048 + h * 512 + vc);
  }
  __syncthreads();
  {
    const int v = tid;
    bf16_t* dst = gv + (prow0 + (v >> 3)) * 2048 + h * 512 + (v & 7) * 64;
#pragma unroll
    for (int q = 0; q < 8; ++q) {
      unsigned e[8];
#pragma unroll
      for (int i = 0; i < 8; ++i) e[i] = VN[(q * 8 + i) * 520 + v];
      u32x4 wv4; wv4.x = e[0] | (e[1] << 16); wv4.y = e[2] | (e[3] << 16); wv4.z = e[4] | (e[5] << 16); wv4.w = e[6] | (e[7] << 16);
      if (st_ok) *(u32x4*)(dst + q * 8) = wv4;
    }
  }
}

DEV void gla_scan_unit(const Params& P, int u) {
  unsigned char* ws = P.ws;
  int tid = threadIdx.x; asm volatile("" : "+v"(tid));
  const int w = tid >> 6, lane = tid & 63, fr = lane & 15, fq = lane >> 4;
  const int xj = u >> 3, sl = xj & 7, grp = (xj >> 3) * 8 + (u & 7);
  const int b = grp >> 3, h = (grp >> 1) & 3, dir = grp & 1;
  bf16_t* QDs = shm;
  bf16_t* KIT = QDs + 64 * 264;
  bf16_t* VT = KIT + 256 * 72;
  bf16_t* SBs = VT + 64 * 72;
  const bf16_t* qsrc = (const bf16_t*)(ws + (dir ? O_QDB : O_GQ));
  const bf16_t* ksrc = (const bf16_t*)(ws + (dir ? O_KIB : O_GK));
  const bf16_t* vsrc = (const bf16_t*)(ws + O_GV);
  const float* dlp = (const float*)(ws + O_DL) + (size_t)((b * 4 + h) * 2 + dir) * 65 * 256;
  bf16_t* osrc = (bf16_t*)P.out + (size_t)dir * TR * 2048;
  f32x4 S[2][4];
#pragma unroll
  for (int a = 0; a < 4; ++a) { S[0][a] = (f32x4){0.f, 0.f, 0.f, 0.f}; S[1][a] = (f32x4){0.f, 0.f, 0.f, 0.f}; }
  u32x4 rqA[4], rkA[4], rvA, rqB[4], rkB[4], rvB; f32x4 rdA0, rdA1, rdB0, rdB1;
  const int nsteps = dir ? 64 : 65;
#define SCAN_LOAD(RQ, RK, RV, RD0, RD1, cc) do { const size_t pr0 = (size_t)b * LP + (cc) * 64; \
    _Pragma("unroll") for (int i = 0; i < 4; ++i) { const int p = tid + 512 * i; \
      { const int tok = p >> 5, kc = (p & 31) * 8; RQ[i] = *(const u32x4*)(qsrc + (pr0 + tok) * 1024 + h * 256 + kc); } \
      { const int kr = p >> 3, tc = (p & 7) * 8; RK[i] = *(const u32x4*)(ksrc + (pr0 + (kr >> 2)) * 1024 + h * 256 + (kr & 3) * 64 + tc); } } \
    { const int vv = sl * 64 + (tid >> 3), tc = (tid & 7) * 8; RV = *(const u32x4*)(vsrc + (pr0 + (vv >> 3)) * 2048 + h * 512 + (vv & 7) * 64 + tc); } \
    RD0 = *(const f32x4*)(dlp + (cc) * 256 + (2 * w) * 16 + fq * 4); RD1 = *(const f32x4*)(dlp + (cc) * 256 + (2 * w + 1) * 16 + fq * 4); } while (0)
#define SCAN_STEP(RQ, RK, RV, RD0, RD1, s_) do { \
    const int c = dir ? 64 - (s_) : (s_); \
    const bool do_o = dir ? true : (c >= 1), do_upd = dir ? (c >= 2) : (c <= 63); \
    __syncthreads(); \
    _Pragma("unroll") for (int i = 0; i < 4; ++i) { const int p = tid + 512 * i; \
      *(u32x4*)(QDs + (p >> 5) * 264 + (p & 31) * 8) = RQ[i]; \
      *(u32x4*)(KIT + (p >> 3) * 72 + (p & 7) * 8) = RK[i]; } \
    *(u32x4*)(VT + (tid >> 3) * 72 + (tid & 7) * 8) = RV; \
    _Pragma("unroll") for (int vt = 0; vt < 4; ++vt) _Pragma("unroll") for (int kt = 0; kt < 2; ++kt) { \
        u32x2 pw; pw.x = pk2(S[kt][vt][0], S[kt][vt][1]); pw.y = pk2(S[kt][vt][2], S[kt][vt][3]); \
        *(u32x2*)(SBs + (vt * 16 + fr) * 264 + (2 * w + kt) * 16 + fq * 4) = pw; } \
    const f32x4 dl0 = RD0, dl1 = RD1; \
    __syncthreads(); \
    if ((s_) + 2 < nsteps) SCAN_LOAD(RQ, RK, RV, RD0, RD1, dir ? 64 - ((s_) + 2) : (s_) + 2); \
    if (do_o) { \
      const int ti = w >> 1; \
      _Pragma("unroll") for (int jj = 0; jj < 2; ++jj) { \
        const int tj = (w & 1) * 2 + jj; \
        f32x4 a4 = (f32x4){0.f, 0.f, 0.f, 0.f}; \
        _Pragma("unroll") for (int kk = 0; kk < 8; ++kk) a4 = mfma16(LD8(SBs + (tj * 16 + fr) * 264 + kk * 32 + fq * 8), LD8(QDs + (ti * 16 + fr) * 264 + kk * 32 + fq * 8), a4); \
        const size_t nrow = (size_t)b * SEQ + (c - 1) * 64 + ti * 16 + fr; \
        store_bf4(osrc + nrow * 2048 + h * 512 + sl * 64 + tj * 16 + fq * 4, a4); } } \
    if (do_upd) { \
      _Pragma("unroll") for (int kt = 0; kt < 2; ++kt) _Pragma("unroll") for (int vt = 0; vt < 4; ++vt) { \
          _Pragma("unroll") for (int kk = 0; kk < 2; ++kk) S[kt][vt] = mfma16(LD8(KIT + ((2 * w + kt) * 16 + fr) * 72 + kk * 32 + fq * 8), LD8(VT + (vt * 16 + fr) * 72 + kk * 32 + fq * 8), S[kt][vt]); \
          S[kt][vt] = S[kt][vt] * (kt ? dl1 : dl0); } } \
  } while (0)
  SCAN_LOAD(rqA, rkA, rvA, rdA0, rdA1, dir ? 64 : 0);
  SCAN_LOAD(rqB, rkB, rvB, rdB0, rdB1, dir ? 63 : 1);
  for (int s = 0; s < nsteps; s += 2) {
    SCAN_STEP(rqA, rkA, rvA, rdA0, rdA1, s);
    if (s + 1 < nsteps) SCAN_STEP(rqB, rkB, rvB, rdB0, rdB1, s + 1);
  }
#undef SCAN_STEP
#undef SCAN_LOAD
}

DEV void gla_finish_unit(const Params& P, int u, bool dummy = false) {
  unsigned char* ws = P.ws;
  const bool st_ok = !dummy || (P.ws == nullptr);
  int tid = threadIdx.x; asm volatile("" : "+v"(tid));
  const int w = tid >> 6, lane = tid & 63, fr = lane & 15, fq = lane >> 4;
  const int c = (u & 63) + 1, bh = u >> 6, b = bh >> 2, h = bh & 3;
  bf16_t* VTf = shm;
  bf16_t* Pl = VTf + 512 * 72;
  float* red = (float*)(Pl + 64 * 72);
  const size_t prow0 = (size_t)b * LP + c * 64, nrow0 = (size_t)b * SEQ + (c - 1) * 64;
  const bf16_t* gv = (const bf16_t*)(ws + O_GV);
  __syncthreads();
  { const int i = tid >> 3, j0 = (tid & 7) * 8;
    *(u32x4*)(Pl + i * 72 + j0) = *(const u32x4*)((const bf16_t*)(ws + O_P) + (size_t)(bh * 65 + c) * 4096 + i * 64 + j0); }
#pragma unroll
  for (int q = 0; q < 8; ++q) {
    const int p = tid + 512 * q, v = p >> 3, tc = (p & 7) * 8;
    *(u32x4*)(VTf + v * 72 + tc) = *(const u32x4*)(gv + (prow0 + (v >> 3)) * 2048 + h * 512 + (v & 7) * 64 + tc);
  }
  __syncthreads();
  f32x4 acc[4][4];
  const bf16_t* of = (const bf16_t*)P.out; const bf16_t* ob = of + (size_t)TR * 2048;
  float ss[4] = {0.f, 0.f, 0.f, 0.f};
#pragma unroll
  for (int vt = 0; vt < 4; ++vt)
#pragma unroll
    for (int it = 0; it < 4; ++it) {
      f32x4 a4 = (f32x4){0.f, 0.f, 0.f, 0.f};
#pragma unroll
      for (int kk = 0; kk < 2; ++kk) a4 = mfma16(LD8(VTf + (w * 64 + vt * 16 + fr) * 72 + kk * 32 + fq * 8), LD8(Pl + (it * 16 + fr) * 72 + kk * 32 + fq * 8), a4);
      const size_t g = (nrow0 + it * 16 + fr) * 2048 + h * 512 + w * 64 + vt * 16 + fq * 4;
      a4 = a4 + load_bf4(of + g) + load_bf4(ob + g);
      acc[vt][it] = a4;
      ss[it] += a4[0] * a4[0] + a4[1] * a4[1] + a4[2] * a4[2] + a4[3] * a4[3];
    }
#pragma unroll
  for (int it = 0; it < 4; ++it) { float s2 = ss[it]; s2 += __shfl_xor(s2, 16); s2 += __shfl_xor(s2, 32); if (fq == 0) red[w * 64 + it * 16 + fr] = s2; }
  __syncthreads();
  bf16_t* gr = (bf16_t*)(ws + O_GR);
#pragma unroll
  for (int it = 0; it < 4; ++it) {
    float tot = 0.f;
#pragma unroll
    for (int ww = 0; ww < 8; ++ww) tot += red[ww * 64 + it * 16 + fr];
    const float rs = rsqrtf(tot * (1.f / 512.f) + EPS);
#pragma unroll
    for (int vt = 0; vt < 4; ++vt) {
      const int vcol = w * 64 + vt * 16 + fq * 4;
      bf16_t* gp = gr + (prow0 + it * 16 + fr) * 2048 + h * 512 + vcol;
      const f32x4 g4 = load_bf4(gp), nw = *(const f32x4*)(P.gnorm + vcol);
      f32x4 y;
#pragma unroll
      for (int j = 0; j < 4; ++j) y[j] = acc[vt][it][j] * rs * nw[j] * (g4[j] * sigm(g4[j]));
      if (st_ok) store_bf4(gp, y);
    }
  }
}

constexpr int QBLK = 32, KVBLK = 64;
constexpr float ASCALE = 0.088388347648318440f;
constexpr float ATHR = 8.f;
constexpr int LDA_ = 2048;
constexpr size_t SHM_V = KVBLK * 128 * 2, SHM_K = KVBLK * 128 * 2, SHM_ATTN = 2 * SHM_V + 2 * SHM_K + 8 * 64 * 4;
#define KSWZ(row, colB) ((row) * 256 + ((colB) ^ (((row) & 7) << 4)))
#define SBAR() __builtin_amdgcn_sched_barrier(0)
DEV int crow(int r, int hi) { return (r & 3) + 8 * (r >> 2) + 4 * hi; }

template <int MODE> DEV void alibi(f32x16& p0, f32x16& p1, float base, float nslope) {
#pragma unroll
  for (int r = 0; r < 16; ++r) {
    const float cc = (float)((r & 3) + 8 * (r >> 2));
    p0[r] = fmaf(nslope, fabsf(base - cc), p0[r]);
    p1[r] = fmaf(nslope, fabsf(base - cc - 32.f), p1[r]);
    if (MODE == 1) { p0[r] = -1e30f; if (r < 8) p1[r] = -1e30f; }
    if (MODE == 2) { p0[r] = -1e30f; p1[r] = -1e30f; }
  }
}
DEV void partialSM(f32x16& p0, f32x16& p1, float& m_reg, float& mn, float& alpha) {
  constexpr float C = ASCALE * 1.4426950408889634f;
  float pmax = p0[0];
#pragma unroll
  for (int r = 1; r < 16; ++r) pmax = fmaxf(pmax, p0[r]);
#pragma unroll
  for (int r = 0; r < 16; ++r) pmax = fmaxf(pmax, p1[r]);
  { auto rr = __builtin_amdgcn_permlane32_swap(__float_as_uint(pmax), __float_as_uint(pmax), false, false);
    pmax = fmaxf(__uint_as_float(rr[0]), __uint_as_float(rr[1])); }
  if (__builtin_expect(__all(pmax - m_reg <= ATHR / ASCALE), 1)) { mn = m_reg; alpha = 1.f; }
  else { mn = fmaxf(m_reg, pmax); alpha = __builtin_amdgcn_exp2f((m_reg - mn) * C); m_reg = mn; }
  const float mnC = -mn * C;
#pragma unroll
  for (int r = 0; r < 16; ++r) p0[r] = fmaf(p0[r], C, mnC);
#pragma unroll
  for (int r = 0; r < 16; ++r) p1[r] = fmaf(p1[r], C, mnC);
#pragma unroll
  for (int r = 0; r < 16; ++r) p0[r] = __builtin_amdgcn_exp2f(p0[r]);
}
DEV void finishSM(f32x16& p0, f32x16& p1, float alpha, float& l_reg, bf16x8& pa0, bf16x8& pa1, bf16x8& pa2, bf16x8& pa3) {
#pragma unroll
  for (int r = 0; r < 16; ++r) p1[r] = __builtin_amdgcn_exp2f(p1[r]);
  float ps = 0;
#pragma unroll
  for (int r = 0; r < 16; ++r) ps += p0[r];
#pragma unroll
  for (int r = 0; r < 16; ++r) ps += p1[r];
  { auto rr = __builtin_amdgcn_permlane32_swap(__float_as_uint(ps), __float_as_uint(ps), false, false);
    ps = __uint_as_float(rr[0]) + __uint_as_float(rr[1]); }
  l_reg = l_reg * alpha + ps;
#define PK4(P_, BASE, OUT) do { unsigned a0 = pk2(P_[BASE + 0], P_[BASE + 1]), a1 = pk2(P_[BASE + 2], P_[BASE + 3]);   \
    unsigned b0 = pk2(P_[BASE + 4], P_[BASE + 5]), b1 = pk2(P_[BASE + 6], P_[BASE + 7]);                              \
    auto r0 = __builtin_amdgcn_permlane32_swap(a0, b0, false, false); auto r1 = __builtin_amdgcn_permlane32_swap(a1, b1, false, false); \
    u32x4 w_ = {r0[0], r1[0], r0[1], r1[1]}; OUT = *reinterpret_cast<bf16x8*>(&w_); } while (0)
  PK4(p0, 0, pa0); PK4(p0, 8, pa1); PK4(p1, 0, pa2); PK4(p1, 8, pa3);
#undef PK4
}
DEV void qkt(f32x16& p0, f32x16& p1, const bf16_t* Ks, const bf16x8* qr, int r32, int hi) {
  p0 = f32x16{}; p1 = f32x16{};
#pragma unroll
  for (int d0 = 0; d0 < 8; ++d0) { const int cb = (d0 * 16 + hi * 8) * 2;
    bf16x8 b0 = *reinterpret_cast<const bf16x8*>((const char*)Ks + KSWZ(r32, cb));
    bf16x8 b1 = *reinterpret_cast<const bf16x8*>((const char*)Ks + KSWZ(32 + r32, cb));
    p0 = __builtin_amdgcn_mfma_f32_32x32x16_bf16(b0, qr[d0], p0, 0, 0, 0);
    p1 = __builtin_amdgcn_mfma_f32_32x32x16_bf16(b1, qr[d0], p1, 0, 0, 0); }
}
DEV int v_st(int k, int c) { const int kk = (k & ~0xC) | ((k & 4) << 1) | ((k & 8) >> 1); return ((kk >> 3) * 4 + (c >> 5)) * 512 + ((kk & 7) * 32 + (c & 31)) * 2; }
DEV int v_rd_base(int lane) { return ((lane & 3) << 3) | (((lane >> 2) & 3) << 6) | (((lane >> 4) & 1) << 5) | (((lane >> 5) & 1) << 8); }
constexpr int v_rd_off(int d0, int ks, int half) { return d0 * 512 + ks * 4096 + half * 2048; }
template <int OFF> DEV s16x4 tr_read(int vb) { s16x4 r; asm volatile("ds_read_b64_tr_b16 %0, %1 offset:%2" : "=&v"(r) : "v"(vb), "i"(OFF) : "memory"); return r; }
template <int D0> DEV void pv_one(f32x16& od, int vb, bf16x8 pa0, bf16x8 pa1, bf16x8 pa2, bf16x8 pa3) {
  const s16x4 l0 = tr_read<v_rd_off(D0, 0, 0)>(vb), h0 = tr_read<v_rd_off(D0, 0, 1)>(vb), l1 = tr_read<v_rd_off(D0, 1, 0)>(vb), h1 = tr_read<v_rd_off(D0, 1, 1)>(vb);
  const s16x4 l2 = tr_read<v_rd_off(D0, 2, 0)>(vb), h2 = tr_read<v_rd_off(D0, 2, 1)>(vb), l3 = tr_read<v_rd_off(D0, 3, 0)>(vb), h3 = tr_read<v_rd_off(D0, 3, 1)>(vb);
  asm volatile("s_waitcnt lgkmcnt(0)" ::: "memory"); SBAR();
#define PK(L, H) (bf16x8){L[0], L[1], L[2], L[3], H[0], H[1], H[2], H[3]}
  od = __builtin_amdgcn_mfma_f32_32x32x16_bf16(pa0, PK(l0, h0), od, 0, 0, 0);
  od = __builtin_amdgcn_mfma_f32_32x32x16_bf16(pa1, PK(l1, h1), od, 0, 0, 0);
  od = __builtin_amdgcn_mfma_f32_32x32x16_bf16(pa2, PK(l2, h2), od, 0, 0, 0);
  od = __builtin_amdgcn_mfma_f32_32x32x16_bf16(pa3, PK(l3, h3), od, 0, 0, 0);
#undef PK
}
DEV void pv_d0(f32x16* o, int vb, bf16x8 pa0, bf16x8 pa1, bf16x8 pa2, bf16x8 pa3) {
  pv_one<0>(o[0], vb, pa0, pa1, pa2, pa3); pv_one<1>(o[1], vb, pa0, pa1, pa2, pa3); pv_one<2>(o[2], vb, pa0, pa1, pa2, pa3); pv_one<3>(o[3], vb, pa0, pa1, pa2, pa3);
}

DEV void attn_body(const bf16_t* __restrict__ Qb, const bf16_t* __restrict__ Kh, const bf16_t* __restrict__ Vh, const bf16_t* __restrict__ Km, const bf16_t* __restrict__ Vm, int qrel, float nslope, float slope, float kmax2, char* lds, f32x16 (&o)[4]) {
  int tid = threadIdx.x; asm volatile("" : "+v"(tid));
  const int wid = __builtin_amdgcn_readfirstlane(tid >> 6), lane = tid & 63, r32 = lane & 31, hi = lane >> 5;
  bf16_t* V_lds = (bf16_t*)lds; bf16_t* K_lds = (bf16_t*)(lds + 2 * SHM_V);
  float* wsl = (float*)(lds + 2 * SHM_V + 2 * SHM_K) + wid * 64; float* li_l = wsl; float* al_l = wsl + 32;
  float m_reg = -1e30f, l_reg = 0;
#pragma unroll
  for (int d = 0; d < 4; ++d) o[d] = f32x16{};
  bf16x8 qr[8];
  const bf16_t* Qw = Qb + (long)(wid * QBLK + r32) * LDA_ + hi * 8;
#pragma unroll
  for (int d0 = 0; d0 < 8; ++d0) qr[d0] = *reinterpret_cast<const bf16x8*>(Qw + d0 * 16);
  const float fbase = (float)(qrel + wid * QBLK + r32 - 4 * hi);
  const int sr = tid >> 4, sc = (tid & 15) * 8, vst0 = v_st(sr, sc), vst1 = v_st(32 + sr, sc);
  const int vb0 = (int)(uintptr_t)V_lds + v_rd_base(lane);
  struct { bf16x8 vs0, vs1, ks0, ks1; } sr_[2];
  float qn2 = 0.f;
#pragma unroll
  for (int d0 = 0; d0 < 8; ++d0)
#pragma unroll
    for (int e = 0; e < 8; ++e) { const float qv = __uint_as_float(((unsigned)(unsigned short)qr[d0][e]) << 16); qn2 = fmaf(qv, qv, qn2); }
  qn2 += __shfl_xor(qn2, 32);
#pragma unroll
  for (int of = 16; of >= 1; of >>= 1) qn2 = fmaxf(qn2, __shfl_xor(qn2, of));
  __syncthreads();
  if (lane == 0) wsl[0] = qn2;
  __syncthreads();
  { const float* w0 = (const float*)(lds + 2 * SHM_V + 2 * SHM_K); float mq = w0[0];
#pragma unroll
    for (int ww = 1; ww < 8; ++ww) mq = fmaxf(mq, w0[ww * 64]);
    qn2 = mq; }
  const float bnd = 2.f * ASCALE * sqrtf(qn2 * kmax2) * 1.02f + 1e-3f;
  const float dskip = fminf((104.f + bnd) / slope, 1e6f);
  int jlo = (int)ceilf(((float)(qrel - 63) - dskip) * (1.f / 64.f)); jlo = jlo < 0 ? 0 : jlo;
  int jhi = (int)floorf(((float)(qrel + 255) + dskip) * (1.f / 64.f)); jhi = jhi > 64 ? 64 : jhi;
  jlo = __builtin_amdgcn_readfirstlane(jlo); jhi = __builtin_amdgcn_readfirstlane(jhi);
  const int ntl = jhi - jlo + 1, NT = ntl + (ntl & 1);
#define TIDX(r) ((r) < ntl ? jlo + (r) : 65)
#define TCL(j) ((j) < 64 ? (j) : 64)
#define SLOAD(i, jt) do { const long k0_ = (long)TCL(jt) * KVBLK; const bf16_t* Vt_ = (jt) == 0 ? Vm : Vh; const bf16_t* Kt_ = (jt) == 0 ? Km : Kh; \
    sr_[i].vs0 = *reinterpret_cast<const bf16x8*>(&Vt_[(k0_ + sr) * LDA_ + sc]); sr_[i].vs1 = *reinterpret_cast<const bf16x8*>(&Vt_[(k0_ + 32 + sr) * LDA_ + sc]); \
    sr_[i].ks0 = *reinterpret_cast<const bf16x8*>(&Kt_[(k0_ + sr) * LDA_ + sc]); sr_[i].ks1 = *reinterpret_cast<const bf16x8*>(&Kt_[(k0_ + 32 + sr) * LDA_ + sc]); } while (0)
#define SWRITE(b, i) do { *(bf16x8*)((char*)V_lds + (b) * SHM_V + vst0) = sr_[i].vs0;          \
    *(bf16x8*)((char*)V_lds + (b) * SHM_V + vst1) = sr_[i].vs1; const int kc = sc * 2;               \
    *(bf16x8*)((char*)K_lds + (b) * SHM_K + KSWZ(sr, kc)) = sr_[i].ks0;                       \
    *(bf16x8*)((char*)K_lds + (b) * SHM_K + KSWZ(32 + sr, kc)) = sr_[i].ks1; } while (0)
#define SWAIT() asm volatile("s_waitcnt vmcnt(4)" ::: "memory")
#define RESC(a) do { if (__any((a) < 1.f)) { if (hi == 0) al_l[r32] = (a); asm volatile("s_waitcnt lgkmcnt(0)" ::: "memory"); \
    _Pragma("unroll") for (int d = 0; d < 4; ++d) _Pragma("unroll") for (int r = 0; r < 16; ++r) o[d][r] *= al_l[crow(r, hi)]; } } while (0)
  f32x16 pA0, pA1, pB0, pB1; float mnA, mnB, alA, alB; bf16x8 pa0, pa1, pa2, pa3;
  constexpr int SE = 0, SO = 1;
  __syncthreads();
  SLOAD(SE, jlo); asm volatile("s_waitcnt vmcnt(0)" ::: "memory"); SWRITE(0, SE); __syncthreads();
  qkt(pA0, pA1, K_lds, qr, r32, hi);
  if (jlo == 0) alibi<1>(pA0, pA1, fbase, nslope); else alibi<0>(pA0, pA1, fbase - 64.f * (float)jlo, nslope);
  partialSM(pA0, pA1, m_reg, mnA, alA);
  SLOAD(SO, TIDX(1)); SLOAD(SE, TIDX(2));
  SWAIT(); SWRITE(1, SO); __syncthreads();
  for (int j = 1; j + 1 < NT; j += 2) {
    SBAR(); qkt(pB0, pB1, (bf16_t*)((char*)K_lds + SHM_K), qr, r32, hi); alibi<0>(pB0, pB1, fbase - 64.f * (float)(jlo + j), nslope);
    finishSM(pA0, pA1, alA, l_reg, pa0, pa1, pa2, pa3); SBAR();
    SLOAD(SO, TIDX(j + 2)); SBAR();
    pv_d0(o, vb0, pa0, pa1, pa2, pa3); partialSM(pB0, pB1, m_reg, mnB, alB);
    __syncthreads(); SWAIT(); SWRITE(0, SE);
    RESC(alB); __syncthreads();
    SBAR(); qkt(pA0, pA1, K_lds, qr, r32, hi); alibi<0>(pA0, pA1, fbase - 64.f * (float)(jlo + j + 1), nslope);
    finishSM(pB0, pB1, alB, l_reg, pa0, pa1, pa2, pa3); SBAR();
    if (j + 3 < NT) SLOAD(SE, TIDX(j + 3)); SBAR();
    pv_d0(o, vb0 + (int)SHM_V, pa0, pa1, pa2, pa3); partialSM(pA0, pA1, m_reg, mnA, alA);
    __syncthreads(); SWAIT(); SWRITE(1, SO);
    RESC(alA); __syncthreads();
  }
  SBAR(); qkt(pB0, pB1, (bf16_t*)((char*)K_lds + SHM_K), qr, r32, hi);
  if (ntl & 1) alibi<2>(pB0, pB1, fbase, nslope); else alibi<0>(pB0, pB1, fbase - 64.f * (float)jhi, nslope);
  finishSM(pA0, pA1, alA, l_reg, pa0, pa1, pa2, pa3); SBAR();
  pv_d0(o, vb0, pa0, pa1, pa2, pa3); partialSM(pB0, pB1, m_reg, mnB, alB);
  __syncthreads(); RESC(alB);
  finishSM(pB0, pB1, alB, l_reg, pa0, pa1, pa2, pa3); SBAR();
  pv_d0(o, vb0 + (int)SHM_V, pa0, pa1, pa2, pa3);
  if (hi == 0) li_l[r32] = l_reg; asm volatile("s_waitcnt lgkmcnt(0)" ::: "memory");
#pragma unroll
  for (int r = 0; r < 16; ++r) { const float rl = __builtin_amdgcn_rcpf(li_l[crow(r, hi)]);
#pragma unroll
    for (int d = 0; d < 4; ++d) o[d][r] *= rl; }
#undef SLOAD
#undef SWRITE
#undef SWAIT
#undef RESC
#undef TCL
#undef TIDX
}

DEV void attn_unit(const Params& P, int u) {
  unsigned char* ws = P.ws;
  const int tid_ = threadIdx.x, wid = __builtin_amdgcn_readfirstlane(tid_ >> 6);
  const int cc_ = u & 255, b = u >> 8, hg = cc_ & 7, qblk = (cc_ >> 3) & 15, vh = (cc_ >> 7) & 1;
  const unsigned long long tlo = 0x4712560374216530ull, thi = 0x1247035621743065ull;
  const unsigned trow = (unsigned)((hg < 4 ? tlo >> (16 * hg) : thi >> (16 * (hg - 4))) & 0xffffull);
  const int h = (int)((trow >> (4 * b)) & 7u);
  const bf16_t* dq = (const bf16_t*)(ws + O_DQ); const bf16_t* dk = (const bf16_t*)(ws + O_DK); const bf16_t* dv = (const bf16_t*)(ws + O_DV);
  const size_t brow = (size_t)b * LP; const int qrel = 64 + qblk * 256;
  const float slope = __int_as_float(0x3f800000 - ((h + 1) << 23));
  const float nslope = -slope / ASCALE;
  unsigned* stash = (unsigned*)(shm_raw + SHM_ATTN);
  f32x16 o[4];
  for (int mp = 0; mp < 2; ++mp) {
    attn_body(dq + (brow + qrel) * 2048 + h * 256 + mp * 128, dk + brow * 2048 + h * 256 + mp * 128, dv + brow * 2048 + h * 256 + vh * 128,
              (const bf16_t*)(ws + O_DKM) + h * 256 + mp * 128, (const bf16_t*)(ws + O_DVM) + h * 256 + vh * 128, qrel, nslope, slope,
              __uint_as_float(((const unsigned*)(ws + O_KMAX))[b * 16 + h * 2 + mp]), (char*)shm_raw, o);
    if (mp == 0) {
      int tid = tid_; asm volatile("" : "+v"(tid));
#pragma unroll
      for (int d = 0; d < 4; ++d)
#pragma unroll
        for (int r = 0; r < 16; r += 2) stash[(d * 8 + (r >> 1)) * 512 + tid] = pk2(o[d][r], o[d][r + 1]);
    }
  }
  int tid = tid_; asm volatile("" : "+v"(tid));
  const int lane = tid & 63, r32 = lane & 31, hi = lane >> 5;
  const float lam = ((const float*)(shm_raw + DYN_LDS_MAIN + 8))[0];
  bf16_t* dd = (bf16_t*)(ws + O_DD); float* dst = (float*)(ws + O_DST);
  const size_t prow = brow + qrel + wid * 32;
  float ss[16];
#pragma unroll
  for (int r = 0; r < 16; ++r) ss[r] = 0.f;
#pragma unroll
  for (int d = 0; d < 4; ++d)
#pragma unroll
    for (int r = 0; r < 16; r += 2) {
      const unsigned s2 = stash[(d * 8 + (r >> 1)) * 512 + tid];
      const float v0 = __uint_as_float(s2 << 16) - lam * o[d][r], v1 = __uint_as_float(s2 & 0xffff0000u) - lam * o[d][r + 1];
      ss[r] += v0 * v0; ss[r + 1] += v1 * v1;
      dd[(prow + crow(r, hi)) * 2048 + h * 256 + vh * 128 + d * 32 + r32] = f2bf(v0);
      dd[(prow + crow(r + 1, hi)) * 2048 + h * 256 + vh * 128 + d * 32 + r32] = f2bf(v1);
    }
#pragma unroll
  for (int r = 0; r < 16; ++r) {
    float s = ss[r];
#pragma unroll
    for (int of = 16; of >= 1; of >>= 1) s += __shfl_xor(s, of);
    if (r32 == 0) dst[(prow + crow(r, hi)) * 16 + h * 2 + vh] = s;
  }
}

DEV void l2_sweep(const Params& P) {
  const f32x4* src = (const f32x4*)P.x + (size_t)(blockIdx.x & 63) * 131072;
  f32x4 a = (f32x4){0.f, 0.f, 0.f, 0.f};
  for (int i = threadIdx.x; i < 131072; i += NTHR) a += src[i];
  if (a[0] + a[1] + a[2] + a[3] == 123456.789f) ((float*)(P.ws + O_DST))[0] = 1.f;
}
#define XB_TMO      128
#define XB_XCNT(j)  (256  + 64 * (j))
#define XB_XSUB(j)  (1280 + 64 * (j))
#define XB_XGEN(j)  (2304 + 64 * (j))
#define XB_TOP      3328
#define XB_TOPGEN   3392
#define XCD_BAR_WORDS 3456
#define XB_SPIN_CAP (1u << 22)
DEV unsigned xb_ld(unsigned* p) { return __hip_atomic_load(p, __ATOMIC_RELAXED, __HIP_MEMORY_SCOPE_AGENT); }
DEV unsigned xb_add(unsigned* p, unsigned v) { return __hip_atomic_fetch_add(p, v, __ATOMIC_RELAXED, __HIP_MEMORY_SCOPE_AGENT); }
DEV unsigned xb_xcc_id() { return (unsigned)__builtin_amdgcn_s_getreg((3 << 11) | 20) & 0xFu; }
#define XB_SPIN(cond, bar) do { unsigned _sp = 0; while (cond) { __builtin_amdgcn_s_sleep(1); \
    if ((++_sp & 255u) == 0u) { if (xb_ld(&(bar)[XB_TMO])) break; if (_sp > XB_SPIN_CAP) { atomicAdd(&(bar)[XB_TMO], 1u); break; } } } } while (0)
struct XcdBarrier { unsigned* bar; unsigned x; volatile LAS unsigned* st; };
DEV XcdBarrier xcd_barrier_post(unsigned* bar, volatile LAS unsigned* st) {
  XcdBarrier b; b.bar = bar; b.x = xb_xcc_id(); b.st = st;
  if (threadIdx.x == 0) (void)xb_add(&bar[XB_XCNT(b.x)], 1u);
  return b;
}
DEV void xcd_barrier_complete(unsigned* bar, unsigned x, unsigned& nloc, unsigned& nx) {
  const unsigned G = gridDim.x * gridDim.y * gridDim.z;
  unsigned sum, cnt, mine, sp = 0u;
  for (;;) {
    sum = 0u; cnt = 0u; mine = 0u;
#pragma unroll
    for (unsigned j = 0; j < 16; ++j) { const unsigned c = xb_ld(&bar[XB_XCNT(j)]); sum += c; cnt += (c > 0u) ? 1u : 0u; mine = (j == x) ? c : mine; }
    if (sum == G) break;
    __builtin_amdgcn_s_sleep(1);
    if ((++sp & 255u) == 0u) { if (xb_ld(&bar[XB_TMO])) break; if (sp > XB_SPIN_CAP) { atomicAdd(&bar[XB_TMO], 1u); break; } }
  }
  nloc = mine > 0u ? mine : 1u; nx = cnt > 0u ? cnt : 1u;
}
DEV void xcd_barrier(const XcdBarrier& b) {
  asm volatile("s_waitcnt vmcnt(0) lgkmcnt(0)" ::: "memory");
  __syncthreads();
  if (threadIdx.x == 0) {
    unsigned* bar = b.bar;
    __builtin_amdgcn_s_waitcnt(0);
    unsigned nloc = b.st[0], nx = b.st[1];
    if (nloc == 0u) { xcd_barrier_complete(bar, b.x, nloc, nx); b.st[0] = nloc; b.st[1] = nx; }
    const unsigned old = xb_add(&bar[XB_XSUB(b.x)], 1u);
    const unsigned gen = old / nloc;
    if (old + 1u == (gen + 1u) * nloc) {
      __builtin_amdgcn_fence(__ATOMIC_RELEASE, "agent");
      asm volatile("s_waitcnt vmcnt(0)" ::: "memory");
      const unsigned og = xb_add(&bar[XB_TOP], 1u);
      const unsigned tg = og / nx;
      if (og + 1u == (tg + 1u) * nx) xb_add(&bar[XB_TOPGEN], 1u);
      else XB_SPIN(xb_ld(&bar[XB_TOPGEN]) == tg, bar);
      __builtin_amdgcn_fence(__ATOMIC_ACQUIRE, "agent");
      xb_add(&bar[XB_XGEN(b.x)], 1u);
      asm volatile("s_waitcnt vmcnt(0)" ::: "memory");
    } else {
      XB_SPIN(xb_ld(&bar[XB_XGEN(b.x)]) == gen, bar);
      __builtin_amdgcn_fence(__ATOMIC_ACQUIRE, "agent");
      asm volatile("s_waitcnt vmcnt(0)" ::: "memory");
    }
  }
  __syncthreads();
}
DEV void gsync_now(const Params& P) {
  XcdBarrier b; b.bar = (unsigned*)(P.ws + O_BAR); b.x = xb_xcc_id(); b.st = (volatile LAS unsigned*)((LAS unsigned char*)shm_raw + DYN_LDS_MAIN);
  xcd_barrier(b);
}
#define gsync(g) gsync_now(P)
#ifndef REP
#define REP 0
#endif
#ifndef DBG_STOP
#define DBG_STOP 0
#endif
DEV void dbg_dump(const Params& P, size_t off, int ld = 2048) {
  const int tid = threadIdx.x, lane = tid & 63, gw = (blockIdx.x * NTHR + tid) >> 6, nw = (gridDim.x * NTHR) >> 6;
  const bf16_t* buf = (const bf16_t*)(P.ws + off);
  for (int r = gw; r < TR; r += nw) {
    const size_t prow = (size_t)(r >> 12) * LP + 64 + (r & 4095);
    for (int i = 0; i < 8; ++i) { const int c = i * 256 + lane * 4; f32x4 v = (f32x4){0.f, 0.f, 0.f, 0.f}; if (c < ld) v = load_bf4(buf + prow * ld + c); for (int j = 0; j < 4; ++j) if (!(fabsf(v[j]) < 1e30f)) v[j] = 10000.f; *(f32x4*)(P.out + (size_t)r * 2048 + c) = v; }
  }
}
#define STOP_AT(k, off) if (DBG_STOP == (k)) { dbg_dump(P, off); return; }
#define STOP_AT2(k, off) if (DBG_STOP == (k)) { dbg_dump(P, off, 1024); return; }
#ifndef ONLY
#define PH(n) true
#else
#define PH(n) ((ONLY) == (n))
#endif
__global__ void __launch_bounds__(NTHR, 2) mega(Params P) {
  cg::grid_group grid = cg::this_grid();
  unsigned char* ws = P.ws;
  volatile LAS unsigned* xst = (volatile LAS unsigned*)((LAS unsigned char*)shm_raw + DYN_LDS_MAIN);
  if (threadIdx.x == 0) { xst[0] = 0u; xst[1] = 0u; xst[2] = 0u; xst[3] = 0u; }
  __syncthreads();
  (void)xcd_barrier_post((unsigned*)(ws + O_BAR), xst);
  if (P.ws == nullptr) grid.sync();
  if (PH(0)) phase_prologue(P);
  if (REP & 4) phase_prologue(P);
  gsync(grid);
  if (PH(1)) for (int gp = G_FFN1_GU; gp <= G_WIN_A; ++gp) { gemm_phase(P, gp); if ((REP & 1) || ((REP & 64) && gp == G_FFN1_GU) || ((REP & 128) && gp == G_FFN1_D)) gemm_phase(P, gp); gsync(grid); if (gp == G_FFN1_D) { STOP_AT(1, O_ACTB) } if (gp == G_WIN_META) { STOP_AT(6, O_GV) } }
  if (PH(2)) for (int u = blockIdx.x; u < 16 * 65; u += gridDim.x) gla_prep_unit(P, u);
  if (REP & 32) for (int u = blockIdx.x; u < 16 * 65; u += gridDim.x) gla_prep_unit(P, u, true);
  gsync(grid);
  STOP_AT2(7, O_KIB)
  STOP_AT2(10, O_QDB)
  if (DBG_STOP == 11) {
    const int tid = threadIdx.x, lane = tid & 63, gw = (blockIdx.x * NTHR + tid) >> 6, nw = (gridDim.x * NTHR) >> 6;
    const bf16_t* b0 = (const bf16_t*)(ws + O_GK); const bf16_t* b1 = (const bf16_t*)(ws + O_GV); const float* dl = (const float*)(ws + O_DL);
    for (int r = gw; r < TR; r += nw) { const size_t prow = (size_t)(r >> 6) * LP + (r & 63);
      for (int i = 0; i < 8; ++i) { const int c = i * 256 + lane * 4; f32x4 v = (f32x4){0.f, 0.f, 0.f, 0.f};
        if (r < 256) v = c < 1024 ? load_bf4(b0 + prow * 1024 + c) : load_bf4(b1 + prow * 2048 + c - 1024);
        else if (r < 272 && c < 256) v = *(const f32x4*)(dl + (size_t)((r - 256) * 2) * 65 * 256 + c);
        *(f32x4*)(P.out + (size_t)r * 2048 + c) = v; } }
    return;
  }
  if (DBG_STOP == 9) {
    const int tid = threadIdx.x, lane = tid & 63, gw = (blockIdx.x * NTHR + tid) >> 6, nw = (gridDim.x * NTHR) >> 6;
    const bf16_t* b0 = (const bf16_t*)(ws + O_GQ); const bf16_t* b1 = (const bf16_t*)(ws + O_GK);
    for (int r = gw; r < TR; r += nw) { const size_t prow = (size_t)(r >> 12) * LP + 64 + (r & 4095);
      for (int i = 0; i < 8; ++i) { const int c = i * 256 + lane * 4; *(f32x4*)(P.out + (size_t)r * 2048 + c) = c < 1024 ? load_bf4(b0 + prow * 1024 + c) : load_bf4(b1 + prow * 1024 + c - 1024); } }
    return;
  }
  if (PH(3)) for (int u = blockIdx.x; u < 256; u += gridDim.x) gla_scan_unit(P, u);
  if (REP & 8) for (int u = blockIdx.x; u < 256; u += gridDim.x) gla_scan_unit(P, u);
  gsync(grid);
  if (DBG_STOP == 8) {
    const int tid = threadIdx.x, lane = tid & 63, gw = (blockIdx.x * NTHR + tid) >> 6, nw = (gridDim.x * NTHR) >> 6;
    const bf16_t* of = (const bf16_t*)P.out; const bf16_t* ob = of + (size_t)TR * 2048; bf16_t* g = (bf16_t*)(ws + O_GR);
    for (int r = gw; r < TR; r += nw) { const size_t prow = (size_t)(r >> 12) * LP + 64 + (r & 4095);
      for (int i = 0; i < 8; ++i) { const int c = i * 256 + lane * 4; store_bf4(g + prow * 2048 + c, load_bf4(of + (size_t)r * 2048 + c) + load_bf4(ob + (size_t)r * 2048 + c)); } }
    gsync(grid);
    dbg_dump(P, O_GR); return;
  }
  if (PH(4)) for (int u = blockIdx.x; u < 1024; u += gridDim.x) gla_finish_unit(P, u);
  if (REP & 16) for (int u = blockIdx.x; u < 1024; u += gridDim.x) gla_finish_unit(P, u, true);
  gsync(grid);
  STOP_AT(2, O_GR)
  if (PH(1)) gemm_phase(P, G_WIN_B);
  if (REP & 1) gemm_phase(P, G_WIN_B);
  gsync(grid);
  if (PH(5)) {
    int tid = threadIdx.x; asm volatile("" : "+v"(tid)); const int lane = tid & 63;
    const int gw = (blockIdx.x * NTHR + tid) >> 6, nw = (gridDim.x * NTHR) >> 6;
    const int kb = gw & 3; const bf16_t* dk = (const bf16_t*)(ws + O_DK); const bf16_t* dkm = (const bf16_t*)(ws + O_DKM);
    unsigned* km = (unsigned*)(ws + O_KMAX);
    float mx = 0.f;
    for (int r = gw >> 2; r < SEQ + 16; r += nw >> 2) {
      const bf16_t* rowp = r < SEQ ? dk + ((size_t)kb * LP + 64 + r) * 2048 : dkm + (size_t)(48 + r - SEQ) * 2048;
      float ssq = 0.f;
#pragma unroll
      for (int i = 0; i < 8; ++i) { const f32x4 v = load_bf4(rowp + lane * 32 + i * 4); ssq += v[0] * v[0] + v[1] * v[1] + v[2] * v[2] + v[3] * v[3]; }
      ssq += __shfl_xor(ssq, 1); ssq += __shfl_xor(ssq, 2);
      mx = fmaxf(mx, ssq);
    }
    if ((lane & 3) == 0) atomicMax(km + kb * 16 + (lane >> 2), __float_as_uint(mx));
  }
  gsync(grid);
  if (PH(5)) {
    float s1 = 0.f, s2 = 0.f;
    for (int i = 0; i < 128; ++i) { s1 = fmaf(P.lq1[i], P.lk1[i], s1); s2 = fmaf(P.lq2[i], P.lk2[i], s2); }
    const float lam = __expf(s1) - __expf(s2) + 0.2f;
    { float* lw = (float*)(shm_raw + DYN_LDS_MAIN + 8); if (threadIdx.x == 0) lw[0] = lam; }
    __syncthreads();
    for (int u = blockIdx.x; u < 1024; u += gridDim.x) attn_unit(P, u);
    if (REP & 2) for (int u = blockIdx.x; u < 1024; u += gridDim.x) attn_unit(P, u);
  }
  gsync(grid);
  if (PH(6)) {
    int tid = threadIdx.x; asm volatile("" : "+v"(tid)); const int lane = tid & 63;
    const int gw = (blockIdx.x * NTHR + tid) >> 6, nw = (gridDim.x * NTHR) >> 6;
    bf16_t* dd = (bf16_t*)(ws + O_DD); const float* dst = (const float*)(ws + O_DST);
    for (int r = gw; r < TR; r += nw) {
      const size_t prow = (size_t)(r >> 12) * LP + 64 + (r & 4095);
      const int col = lane * 32, hh = col >> 8;
      const float rs = rsqrtf((dst[prow * 16 + hh * 2] + dst[prow * 16 + hh * 2 + 1]) * (1.f / 256.f) + EPS) * 0.8f;
#pragma unroll
      for (int i = 0; i < 8; ++i) { bf16_t* p = dd + prow * 2048 + col + i * 4; f32x4 v = load_bf4(p); const f32x4 nw4 = *(const f32x4*)(P.dnorm + ((col + i * 4) & 255)); v = v * nw4 * rs; store_bf4(p, v); }
    }
    int tbase = 0, t = blockIdx.x; bf16_t* wf = (bf16_t*)(ws + O_WF);
    transpose_job(P.w2g, 2048, DFF, wf + (size_t)DFF * 2048, P.n2, false, tbase, t);
    transpose_job(P.w2u, 2048, DFF, wf + (size_t)2 * DFF * 2048, P.n2, false, tbase, t);
    transpose_job(P.w2d, DFF, 2048, wf, nullptr, false, tbase, t);
  }
  gsync(grid);
  STOP_AT(3, O_DD)
  if (PH(1)) for (int gp = G_MERGE; gp <= G_FFN2_D; ++gp) { gemm_phase(P, gp); if (((REP & 1) && gp != G_FFN2_D) || ((REP & 256) && gp == G_OUT) || ((REP & 512) && gp == G_MERGE)) gemm_phase(P, gp); gsync(grid); if (gp == G_MERGE) { STOP_AT(4, O_MRG) } if (gp == G_OUT) { STOP_AT(5, O_ACTB) } }
  if (PH(7)) {
    int tid = threadIdx.x; asm volatile("" : "+v"(tid)); const int lane = tid & 63;
    const int gw = (blockIdx.x * NTHR + tid) >> 6, nw = (gridDim.x * NTHR) >> 6;
    for (int r = gw; r < TR; r += nw) {
      float* p = P.out + (size_t)r * 2048;
      f32x4 v[8]; float ss = 0.f;
#pragma unroll
      for (int i = 0; i < 8; ++i) { v[i] = *(f32x4*)(p + i * 256 + lane * 4); ss += v[i][0] * v[i][0] + v[i][1] * v[i][1] + v[i][2] * v[i][2] + v[i][3] * v[i][3]; }
#pragma unroll
      for (int o = 32; o >= 1; o >>= 1) ss += __shfl_xor(ss, o);
      const float rs = rsqrtf(ss * (1.f / 2048.f) + EPS);
#pragma unroll
      for (int i = 0; i < 8; ++i) { const int c = i * 256 + lane * 4; const f32x4 g = *(const f32x4*)(P.nfin + c); *(f32x4*)(p + c) = v[i] * g * rs; }
    }
  }
}

constexpr size_t DYN_LDS = DYN_LDS_MAIN + 16;
static_assert(DYN_LDS >= 8 * HT * 2 && DYN_LDS >= SHM_ATTN + 65536, "lds");

extern "C" void kernel_launch(void* const* d_in, const int* in_sizes, int n_in, void* d_out, int out_size, void* d_ws, size_t ws_size, hipStream_t stream) {
  if (n_in != 26 || ws_size < WS_TOTAL || out_size != TR * 2048) { fprintf(stderr, "kernel_launch: bad shapes n_in %d ws %zu need %zu out %d\n", n_in, ws_size, WS_TOTAL, out_size); return; }
  static int grid_blocks = 0;
  if (!grid_blocks) {
    hipFuncSetAttribute((const void*)mega, hipFuncAttributeMaxDynamicSharedMemorySize, (int)DYN_LDS);
    int dev = 0, cus = 0, per_cu = 0;
    hipGetDevice(&dev);
    hipDeviceGetAttribute(&cus, hipDeviceAttributeMultiprocessorCount, dev);
    hipOccupancyMaxActiveBlocksPerMultiprocessor(&per_cu, mega, NTHR, DYN_LDS);
    if (per_cu < 1) per_cu = 1;
    grid_blocks = cus;
  }
  Params p{};
  const float** pp = (const float**)&p;
  for (int i = 0; i < 26; ++i) pp[i] = (const float*)d_in[i];
  p.out = (float*)d_out; p.ws = (unsigned char*)d_ws;
  hipMemsetAsync((unsigned char*)d_ws + O_BAR, 0, 16384, stream);
  void* args[] = {&p};
  hipError_t e = hipLaunchCooperativeKernel((void*)mega, dim3(grid_blocks), dim3(NTHR), args, DYN_LDS, stream);
  if (e != hipSuccess) fprintf(stderr, "cooperative launch failed: %s (grid %d)\n", hipGetErrorString(e), grid_blocks);
}
```

```cpp
#include <hip/hip_runtime.h>
#include <hip/hip_cooperative_groups.h>
#include <stdint.h>
#include <cstdio>
namespace cg = cooperative_groups;

#define DEV __device__ __forceinline__
typedef unsigned short bf16_t;
using bf16x8 = __attribute__((ext_vector_type(8))) short;
using s16x4  = __attribute__((ext_vector_type(4))) short;
using f32x4  = __attribute__((ext_vector_type(4))) float;
using f32x16 = __attribute__((ext_vector_type(16))) float;
using u32x4  = __attribute__((ext_vector_type(4))) unsigned;
using u32x2  = __attribute__((ext_vector_type(2))) unsigned;

constexpr int DM = 2048, DFF = 5504, NB = 4, SEQ = 4096, LP = 4160, RP = NB * LP  , TR = NB * SEQ  ;
constexpr int INW = 16416;
constexpr float EPS = 1e-6f;
constexpr size_t DYN_LDS_MAIN = 4 * 64 * 264 * 2 + 64 * 32 * 4;
constexpr int NTHR = 512;

constexpr size_t SZ_ACT = (size_t)RP * 2048 * 2;
constexpr size_t SZ_HALF = (size_t)RP * 1024 * 2;
constexpr size_t SZ_SQ = (size_t)2048 * 2048 * 2;
constexpr size_t SZ_FW = (size_t)DFF * 2048 * 2;
constexpr size_t SZ_HID = (size_t)RP * DFF * 2;
constexpr size_t O_ACTB = 0;
constexpr size_t O_WIN = O_ACTB + SZ_ACT;
constexpr size_t O_WS = O_WIN + SZ_ACT;
constexpr size_t O_WF = O_WS + 3 * SZ_SQ;
constexpr size_t O_HID = O_WF + 3 * SZ_FW;
constexpr size_t O_R = O_HID + SZ_HID;
constexpr size_t O_F = O_R;
constexpr size_t O_GR = O_F + SZ_ACT;
constexpr size_t O_P = O_GR + SZ_ACT;
constexpr size_t SZ_P = (size_t)16 * 65 * 4096 * 2;
constexpr size_t O_LOW = O_P + SZ_P;
constexpr size_t O_DL = O_LOW + (size_t)RP * 32 * 4;
constexpr size_t O_ST = O_DL + (size_t)16 * 2 * 65 * 256 * 4;
constexpr size_t O_ST1 = O_ST + (size_t)RP * 4, O_ST2 = O_ST1 + (size_t)RP * 32 * 4;
constexpr size_t O_DST = O_ST2 + (size_t)RP * 32 * 4;
constexpr size_t O_DKM = O_DST + (size_t)RP * 16 * 4;
constexpr size_t O_DVM = O_DKM + (size_t)64 * 2048 * 2;
constexpr size_t O_BAR = O_DVM + (size_t)64 * 2048 * 2;
constexpr size_t O_KMAX = O_BAR + 14336;
constexpr size_t O_MCNT = O_BAR + 14720;
constexpr size_t WS_TOTAL = O_BAR + 16384;
constexpr size_t O_GQ = O_WF + SZ_FW, O_GK = O_HID + (size_t)256 * DFF * 2, O_GV = O_GK + SZ_HALF, O_QDB = O_GV + SZ_ACT, O_KIB = O_QDB + SZ_HALF;
static_assert(O_GQ + SZ_HALF <= O_HID && O_KIB + SZ_HALF <= O_R, "gla overlay 2");
constexpr size_t O_DQ = O_WF, O_DK = O_DQ + SZ_ACT, O_DV = O_DK + SZ_ACT;
constexpr size_t O_MRG = O_DK;
constexpr size_t O_DD = O_WIN;
static_assert(O_DV + SZ_ACT <= O_R, "diff overlay");

struct Params {
  const float *x, *meta, *n1, *w1g, *w1u, *w1d, *nmix, *win, *wa2f, *baf, *wa2b, *bab, *gnorm,
      *lq1, *lk1, *lq2, *lk2, *dnorm, *wbg, *wbd, *wout, *n2, *w2g, *w2u, *w2d, *nfin;
  float* out;
  unsigned char* ws;
};

extern __shared__ __attribute__((aligned(16))) unsigned char shm_raw[];
#define shm ((bf16_t*)shm_raw)

DEV float bf2f(bf16_t v) { return __uint_as_float(((unsigned)v) << 16); }
typedef __bf16 bf16x2_t __attribute__((ext_vector_type(2)));
typedef float f32x2_t __attribute__((ext_vector_type(2)));
DEV unsigned pk2(float lo, float hi) { f32x2_t v = {lo, hi}; bf16x2_t b = __builtin_convertvector(v, bf16x2_t); return __builtin_bit_cast(unsigned, b); }
DEV bf16_t f2bf(float f) { return (bf16_t)(pk2(f, 0.f) & 0xffffu); }
DEV float to_sgpr(float v) { float r; asm volatile("v_readfirstlane_b32 %0, %1" : "=s"(r) : "v"(v)); return r; }
DEV float sigm(float v) { return 1.f / (1.f + __expf(-v)); }

constexpr int BM = 256, BK = 64, HALF = 128, HT = HALF * BK, NXCD = 8, WGM = 8;
DEV int lds_byte(int r, int c) { int st = (r >> 4) * 2 + (c >> 5), rr = r & 15, cc = c & 31, ob = rr * 64 + cc * 2; return st * 1024 + (ob ^ (((ob >> 9) & 1) << 5)); }
DEV void stage_rc(int b, int& R, int& C) { int st = b / 1024, sb = b % 1024, swz = sb ^ (((sb >> 9) & 1) << 5); R = (st >> 1) * 16 + swz / 64; C = (st & 1) * 32 + (swz % 64) / 2; }

#define LAS __attribute__((address_space(3)))
constexpr int HTB = HALF * BK * 2;
#define PG8_SA(b, h) (((b) * 2 + (h)) * HTB)
#define PG8_SB(b, h) ((4 + (b) * 2 + (h)) * HTB)
#define STAGE(bufoff, gbase, voff) do { _Pragma("unroll") for (int _i = 0; _i < 2; ++_i) \
    __builtin_amdgcn_global_load_lds((const unsigned*)((const char*)(gbase) + (voff)[_i]), (LAS unsigned*)(lds + (bufoff) + ldsw + _i * 8192), 16, 0, 0); } while (0)
#define LDA(dst, b, h) do { _Pragma("unroll") for (int m = 0; m < 4; ++m) _Pragma("unroll") for (int k = 0; k < 2; ++k) dst[m][k] = *(const LAS bf16x8*)(lds + PG8_SA(b, h) + aoff + m * 2048 + k * 1024); } while (0)
#define LDB(dst, b, h) do { _Pragma("unroll") for (int n = 0; n < 2; ++n) _Pragma("unroll") for (int k = 0; k < 2; ++k) dst[n][k] = *(const LAS bf16x8*)(lds + PG8_SB(b, h) + boff + n * 2048 + k * 1024); } while (0)
#define MMA(ai, bj, At_, Bt_) do { __builtin_amdgcn_s_setprio(1); \
    _Pragma("unroll") for (int m = 0; m < 4; ++m) _Pragma("unroll") for (int n = 0; n < 2; ++n) _Pragma("unroll") for (int k = 0; k < 2; ++k) \
      acc[ai][bj][m][n] = __builtin_amdgcn_mfma_f32_16x16x32_bf16(Bt_[n][k], At_[m][k], acc[ai][bj][m][n], 0, 0, 0); \
    __builtin_amdgcn_s_setprio(0); } while (0)
#define WAIT_V(n) asm volatile("s_waitcnt vmcnt(" #n ")" ::: "memory")
#define WAIT_L(n) asm volatile("s_waitcnt lgkmcnt(" #n ")" ::: "memory")
#define BAR __builtin_amdgcn_s_barrier()
#define SCHED __builtin_amdgcn_sched_barrier(0)

DEV void gemm_mainloop(const char* __restrict__ cA, const char* __restrict__ cB0, const char* __restrict__ cB1, const int K, f32x4 (&acc)[2][2][4][2]) {
  LAS unsigned char* lds = (LAS unsigned char*)shm_raw;
  int tid = threadIdx.x; asm volatile("" : "+v"(tid));
  const int wid = __builtin_amdgcn_readfirstlane(tid >> 6), lane = tid & 63, wr = wid >> 2, wc = wid & 3, fr = lane & 15, fq = lane >> 4;
  unsigned voff[2], voffb[2];
#pragma unroll
  for (int i = 0; i < 2; ++i) { int R, C; stage_rc(tid * 16 + i * 8192, R, C); voff[i] = (unsigned)(R * K + C) * 2u;
    const int rho = R & 31, Rb = (R & ~31) + 8 * ((rho & 15) >> 2) + 4 * (rho >> 4) + (rho & 3); voffb[i] = (unsigned)(Rb * K + C) * 2u; }
  const size_t kstep = (size_t)(BK * 2), hstep = (size_t)HALF * K * 2;
  const unsigned ldsw = (unsigned)wid * 1024u;
  const int aoff = lds_byte(wr * 64 + fr, fq * 8), boff = lds_byte(wc * 32 + fr, fq * 8);
  bf16x8 At[4][2], B0[2][2], B1[2][2];
  const int nt = K / BK;
  STAGE(PG8_SB(0, 0), cB0, voffb); STAGE(PG8_SB(0, 1), cB1, voffb); STAGE(PG8_SA(0, 0), cA, voff); STAGE(PG8_SA(0, 1), cA + hstep, voff);
  if (wr == 1) BAR;
  WAIT_V(2); BAR;
  STAGE(PG8_SB(1, 0), cB0 + kstep, voffb); STAGE(PG8_SA(1, 0), cA + kstep, voff); STAGE(PG8_SB(1, 1), cB1 + kstep, voffb);
  WAIT_V(6); BAR;
  for (int t = 0; t < nt; t += 2) {
    const int t2 = (t == nt - 2) ? 0 : t + 2;
    const char* a1 = cA + (size_t)(t + 1) * kstep + hstep;
    const char* a2 = cA + (size_t)t2 * kstep; const char* b02 = cB0 + (size_t)t2 * kstep; const char* b12 = cB1 + (size_t)t2 * kstep;
    LDB(B0, 0, 0); LDB(B1, 0, 1); SCHED; LDA(At, 0, 0); STAGE(PG8_SA(1, 1), a1, voff);
    WAIT_V(8); WAIT_L(0); BAR; MMA(0, 0, At, B0); MMA(0, 1, At, B1); BAR; SCHED;
    LDA(At, 0, 1); STAGE(PG8_SB(0, 0), b02, voffb); STAGE(PG8_SB(0, 1), b12, voffb); STAGE(PG8_SA(0, 0), a2, voff);
    WAIT_V(8); WAIT_L(0); BAR; MMA(1, 0, At, B0); MMA(1, 1, At, B1); BAR; SCHED;
    LDB(B0, 1, 0); LDB(B1, 1, 1); SCHED; LDA(At, 1, 0); STAGE(PG8_SA(0, 1), a2 + hstep, voff);
    WAIT_V(8); WAIT_L(0); BAR; MMA(0, 0, At, B0); MMA(0, 1, At, B1); BAR; SCHED;
    LDA(At, 1, 1); STAGE(PG8_SB(1, 0), b02 + kstep, voffb); STAGE(PG8_SB(1, 1), b12 + kstep, voffb); STAGE(PG8_SA(1, 0), a2 + kstep, voff);
    WAIT_V(8); WAIT_L(0); BAR; MMA(1, 0, At, B0); MMA(1, 1, At, B1); BAR; SCHED;
  }
  WAIT_V(0);
  if (wr == 0) BAR;
  BAR;
}

enum { G_FFN1_GU = 0, G_FFN1_D, G_WIN_A, G_WIN_META, G_WIN_B, G_MERGE, G_OUT, G_FFN2_GU, G_FFN2_D };

DEV void store_bf4(bf16_t* p, f32x4 v) { u32x2 w; w.x = pk2(v[0], v[1]); w.y = pk2(v[2], v[3]); *(u32x2*)p = w; }
DEV void store_bf8(bf16_t* p, f32x4 a, f32x4 b) { u32x4 w; w.x = pk2(a[0], a[1]); w.y = pk2(a[2], a[3]); w.z = pk2(b[0], b[1]); w.w = pk2(b[2], b[3]); *(u32x4*)p = w; }
DEV f32x4 load_bf4(const bf16_t* p) { u32x2 w = *(const u32x2*)p; f32x4 v; v[0] = __uint_as_float(w.x << 16); v[1] = __uint_as_float(w.x & 0xffff0000u); v[2] = __uint_as_float(w.y << 16); v[3] = __uint_as_float(w.y & 0xffff0000u); return v; }

DEV void main_order(int L, int nN, int& pm, int& pn) {
  const int nwg = 64 * nN;
  int wgid = L; { const int q = nwg / NXCD, r = nwg % NXCD, xcd = wgid % NXCD, off = wgid / NXCD; wgid = (xcd < r ? xcd * (q + 1) : r * (q + 1) + (xcd - r) * q) + off; }
  const int nig = WGM * nN, gid = wgid / nig, fm = gid * WGM;
  pm = fm + ((wgid % nig) % WGM); pn = (wgid % nig) / WGM;
}

DEV void gemm_phase(const Params& P, const int gp) {
  int tid = threadIdx.x; asm volatile("" : "+v"(tid));
  const int wid = __builtin_amdgcn_readfirstlane(tid >> 6), lane = tid & 63, wr = wid >> 2, wc = wid & 3, fr_ = lane & 15, fq_ = lane >> 4;
  unsigned char* ws = P.ws;
  float* stats = (float*)(ws + O_ST);
  int nN, nPre = 0, nMain, nMeta = 0, pnoff = 0;
  switch (gp) {
    case G_FFN1_GU: nN = 43; nMeta = 43; break;
    case G_FFN1_D: nN = 8; break;
    case G_WIN_A: nN = 25; nPre = 8; nMeta = 65; break;
    case G_WIN_META: nN = 0; nMeta = 65; break;
    case G_WIN_B: nN = 40; pnoff = 25; break;
    case G_MERGE: nN = 8; break;
    case G_OUT: nN = 8; break;
    case G_FFN2_GU: nN = 43; break;
    default: nN = 8; break;
  }
  nMain = 64 * nN;
  const int ntiles = nPre + nMain + nMeta;
  for (int t = blockIdx.x; t < ntiles; t += gridDim.x) {
    int pm, pn, kind = gp;
    bool meta = false;
    if (t < nPre) { pm = 64; pn = t; meta = true; kind = G_FFN1_D; }
    else if (t < nPre + nMain) {
      if (nN == 8 && nPre == 0 && gridDim.x == 256) { const int c_ = t & 255; pm = 32 * (t >> 8) + (c_ & 7) * 4 + (c_ >> 6); pn = (c_ >> 3) & 7; }
      else { main_order(t - nPre, nN, pm, pn); pn += pnoff; }
    }
    else { pm = 64; pn = t - nPre - nMain; meta = true; }
    const int arow0 = meta ? 0 : (pm >> 4) * LP + 64 + (pm & 15) * 256;
    const int nrow0 = pm * 256;
    if (gp == G_WIN_A && t >= nPre + nMain) {
      if (tid == 0) {
        unsigned* cnt = (unsigned*)(ws + O_MCNT); unsigned sp = 0;
        while (__hip_atomic_load(cnt, __ATOMIC_RELAXED, __HIP_MEMORY_SCOPE_AGENT) < 8u) { __builtin_amdgcn_s_sleep(2); if (++sp > (1u << 24)) break; }
        __builtin_amdgcn_fence(__ATOMIC_ACQUIRE, "agent");
        asm volatile("s_waitcnt vmcnt(0)" ::: "memory");
      }
      __syncthreads();
    }
    const bf16_t *A, *B0p, *B1p; int K;
    switch (kind) {
      case G_FFN1_GU: A = (const bf16_t*)(ws + O_ACTB); K = 2048; B0p = (const bf16_t*)(ws + O_WF) + (size_t)DFF * 2048 + (size_t)pn * 128 * 2048; B1p = B0p + (size_t)DFF * 2048; break;
      case G_FFN2_GU: A = (const bf16_t*)(ws + O_ACTB); K = 2048; B0p = (const bf16_t*)(ws + O_WF) + (size_t)DFF * 2048 + (size_t)pn * 128 * 2048; B1p = B0p + (size_t)DFF * 2048; break;
      case G_FFN1_D: case G_FFN2_D: A = (const bf16_t*)(ws + O_HID); K = DFF; B0p = (const bf16_t*)(ws + O_WF) + (size_t)pn * 256 * DFF; B1p = B0p + (size_t)128 * DFF; break;
      case G_WIN_A: case G_WIN_META: case G_WIN_B: A = (const bf16_t*)(ws + O_ACTB); K = 2048; B0p = (const bf16_t*)(ws + O_WIN) + (size_t)pn * 256 * 2048; B1p = B0p + (size_t)128 * 2048; break;
      case G_MERGE: A = (const bf16_t*)(ws + O_GR); K = 2048; B0p = (const bf16_t*)(ws + O_WS) + (size_t)pn * 256 * 2048; B1p = B0p + (size_t)128 * 2048; break;
      default  : A = (const bf16_t*)(ws + O_MRG); K = 2048; B0p = (const bf16_t*)(ws + O_WS) + 2 * (size_t)2048 * 2048 + (size_t)pn * 256 * 2048; B1p = B0p + (size_t)128 * 2048; break;
    }
    f32x4 acc[2][2][4][2];
#pragma unroll
    for (int a = 0; a < 2; ++a)
#pragma unroll
      for (int b = 0; b < 2; ++b)
#pragma unroll
        for (int m = 0; m < 4; ++m)
#pragma unroll
          for (int n = 0; n < 2; ++n) acc[a][b][m][n] = (f32x4){0.f, 0.f, 0.f, 0.f};
    const int nk = (kind == G_MERGE) ? 2 : 1;
    for (int kl = 0; kl < nk; ++kl) {
      if (kl == 1) {
        int fr = fr_, fq = fq_; asm volatile("" : "+v"(fr), "+v"(fq));
        const bf16_t* gA = (const bf16_t*)P.out; const bf16_t* gB = gA + (size_t)TR * 2048;
#pragma unroll
      for (int aim = 0; aim < 4; ++aim) {
          const int ai = aim >> 1, m0 = (aim & 1) * 2;
          u32x2 ga[2][2][2], gb[2][2][2];
#pragma unroll
          for (int mm = 0; mm < 2; ++mm) {
            const int m = m0 + mm;
            const size_t nrow = (size_t)(nrow0 + ai * 128 + wr * 64 + m * 16 + fr) * 2048;
#pragma unroll
            for (int bj = 0; bj < 2; ++bj)
#pragma unroll
              for (int n = 0; n < 2; ++n) { const int col = pn * 256 + bj * 128 + wc * 32 + fq * 8 + n * 4; ga[mm][bj][n] = *(const u32x2*)(gA + nrow + col); gb[mm][bj][n] = *(const u32x2*)(gB + nrow + col); }
          }
          asm volatile("" ::: "memory"); SCHED;
#pragma unroll
          for (int mm = 0; mm < 2; ++mm)
#pragma unroll
            for (int bj = 0; bj < 2; ++bj)
#pragma unroll
              for (int n = 0; n < 2; ++n) {
                const int m = m0 + mm;
                const u32x2 wa = ga[mm][bj][n], wb = gb[mm][bj][n];
                const float a4[4] = {__uint_as_float(wa.x << 16), __uint_as_float(wa.x & 0xffff0000u), __uint_as_float(wa.y << 16), __uint_as_float(wa.y & 0xffff0000u)};
                const float b4[4] = {__uint_as_float(wb.x << 16), __uint_as_float(wb.x & 0xffff0000u), __uint_as_float(wb.y << 16), __uint_as_float(wb.y & 0xffff0000u)};
#pragma unroll
                for (int j = 0; j < 4; ++j) { float ea = __expf(-fminf(fmaxf(a4[j], -40.f), 40.f)), eb = __expf(-fminf(fmaxf(b4[j], -40.f), 40.f)); acc[ai][bj][m][n][j] *= (1.f + eb) / (1.f + ea); }
              }
          asm volatile("" ::: "memory"); SCHED;
        }
        A = (const bf16_t*)(ws + O_DD); B0p += (size_t)2048 * 2048; B1p += (size_t)2048 * 2048;
        asm volatile("s_waitcnt vmcnt(0)" ::: "memory");
      }
      gemm_mainloop((const char*)(A + (size_t)arow0 * K), (const char*)B0p, (const char*)B1p, K, acc);
    }
    int fr = fr_, fq = fq_; asm volatile("" : "+v"(fr), "+v"(fq));
    if (kind == G_FFN1_GU || kind == G_FFN2_GU || kind == G_WIN_A || kind == G_WIN_META || kind == G_WIN_B) {
      float* rsl = (float*)shm_raw;
      const int tid2 = wid * 64 + (int)__builtin_amdgcn_mbcnt_hi(~0u, __builtin_amdgcn_mbcnt_lo(~0u, 0u));
      if (tid2 < 256) {
        const size_t row = (size_t)(arow0 + tid2); float sum;
        if (kind == G_FFN1_GU) sum = stats[row];
        else { const f32x4* pp = (const f32x4*)((const float*)(ws + (kind == G_FFN2_GU ? O_ST2 : O_ST1)) + row * 32); f32x4 a = pp[0];
#pragma unroll
          for (int i = 1; i < 8; ++i) a += pp[i];
          sum = (a[0] + a[1]) + (a[2] + a[3]); }
        rsl[tid2] = rsqrtf(sum * (1.f / 2048.f) + EPS);
      }
      __syncthreads();
    }
    if (kind == G_FFN1_GU || kind == G_FFN2_GU) {
      const float* rsl = (const float*)shm_raw;
      bf16_t* hid = (bf16_t*)(ws + O_HID);
#pragma unroll
      for (int ai = 0; ai < 2; ++ai)
#pragma unroll
        for (int m = 0; m < 4; ++m) {
          const int r = ai * 128 + wr * 64 + m * 16 + fr;
          if (meta && (r < 48 || r >= 64)) continue;
          const int prow = arow0 + r;
          const float rs = rsl[r];
          f32x4 hh[2];
#pragma unroll
          for (int n = 0; n < 2; ++n) {
            f32x4 g = acc[ai][0][m][n] * rs, u = acc[ai][1][m][n] * rs;
#pragma unroll
            for (int j = 0; j < 4; ++j) hh[n][j] = g[j] * sigm(g[j]) * u[j];
          }
          store_bf8(hid + (size_t)prow * DFF + pn * 128 + wc * 32 + fq * 8, hh[0], hh[1]);
          asm volatile("" ::: "memory"); SCHED;
        }
    } else if (kind == G_FFN1_D || kind == G_OUT || kind == G_FFN2_D) {
      const float* resA = (kind == G_FFN2_D) ? P.out : P.x;
      const bf16_t* resF = (kind == G_OUT) ? (const bf16_t*)(ws + O_F) : nullptr;
      float* outF32 = (kind == G_FFN1_D) ? nullptr : P.out;
      bf16_t* outB = (kind == G_FFN2_D) ? nullptr : (bf16_t*)(ws + O_ACTB);
      bf16_t* outF = (kind == G_FFN1_D && !meta) ? (bf16_t*)(ws + O_F) : nullptr;
      const float scale = (kind == G_OUT) ? 1.f : 0.5f;
      float* st = (kind == G_FFN1_D) ? (float*)(ws + O_ST1) : (kind == G_OUT ? (float*)(ws + O_ST2) : nullptr);
#pragma unroll
      for (int aim = 0; aim < 4; ++aim) {
        const int ai = aim >> 1, m0 = (aim & 1) * 2;
        f32x4 rres[2][2][2];
#pragma unroll
        for (int mm = 0; mm < 2; ++mm) {
          const int m = m0 + mm;
          const int r = ai * 128 + wr * 64 + m * 16 + fr;
          const bool rowok = !(meta && (r < 48 || r >= 64));
          const size_t prow = arow0 + r, nrow = nrow0 + r;
          const float* rp = meta ? (P.meta + (size_t)(rowok ? r - 48 : 0) * 2048) : (resA + nrow * 2048);
#pragma unroll
          for (int bj = 0; bj < 2; ++bj)
#pragma unroll
            for (int n = 0; n < 2; ++n) {
              const int col = pn * 256 + bj * 128 + wc * 32 + fq * 8 + n * 4;
              rres[mm][bj][n] = *(const f32x4*)(rp + col);
            }
        }
        asm volatile("" ::: "memory"); SCHED;
#pragma unroll
        for (int mm = 0; mm < 2; ++mm) {
          const int m = m0 + mm;
          const int r = ai * 128 + wr * 64 + m * 16 + fr;
          const bool rowok = !(meta && (r < 48 || r >= 64));
          const size_t prow = arow0 + r, nrow = nrow0 + r;
          float ss = 0.f;
#pragma unroll
          for (int bj = 0; bj < 2; ++bj)
#pragma unroll
            for (int n = 0; n < 2; ++n) {
              const int col = pn * 256 + bj * 128 + wc * 32 + fq * 8 + n * 4;
              f32x4 res = rres[mm][bj][n];
              if (resF) { const u32x2 w = *(const u32x2*)(resF + prow * 2048 + col); res[0] += __uint_as_float(w.x << 16); res[1] += __uint_as_float(w.x & 0xffff0000u); res[2] += __uint_as_float(w.y << 16); res[3] += __uint_as_float(w.y & 0xffff0000u); }
              const f32x4 d = acc[ai][bj][m][n] * scale, v = res + d;
              if (rowok) {
                if (outF32) *(f32x4*)(outF32 + nrow * 2048 + col) = v;
                if (outB) store_bf4(outB + prow * 2048 + col, v);
                if (outF) store_bf4(outF + prow * 2048 + col, d);
              }
              ss += v[0] * v[0] + v[1] * v[1] + v[2] * v[2] + v[3] * v[3];
            }
          ss += __shfl_xor(ss, 16); ss += __shfl_xor(ss, 32);
          if (fq == 0 && st && rowok) st[prow * 32 + pn * 4 + wc] = ss;
        }
        asm volatile("" ::: "memory"); SCHED;
      }
    } else if (kind == G_MERGE) {
      const bf16_t* gB = (const bf16_t*)P.out + (size_t)TR * 2048;
      bf16_t* mo = (bf16_t*)(ws + O_MRG);
#pragma unroll
      for (int ai = 0; ai < 2; ++ai) {
        u32x2 gw[4][2][2];
#pragma unroll
        for (int m = 0; m < 4; ++m) {
          const size_t nrow = nrow0 + ai * 128 + wr * 64 + m * 16 + fr;
#pragma unroll
          for (int bj = 0; bj < 2; ++bj)
#pragma unroll
            for (int n = 0; n < 2; ++n) gw[m][bj][n] = *(const u32x2*)(gB + nrow * 2048 + pn * 256 + bj * 128 + wc * 32 + fq * 8 + n * 4);
        }
        asm volatile("" ::: "memory"); SCHED;
#pragma unroll
        for (int m = 0; m < 4; ++m) {
          const size_t prow = arow0 + ai * 128 + wr * 64 + m * 16 + fr;
#pragma unroll
          for (int bj = 0; bj < 2; ++bj)
#pragma unroll
            for (int n = 0; n < 2; ++n) {
              const int col = pn * 256 + bj * 128 + wc * 32 + fq * 8 + n * 4;
              const u32x2 w = gw[m][bj][n];
              const float b4[4] = {__uint_as_float(w.x << 16), __uint_as_float(w.x & 0xffff0000u), __uint_as_float(w.y << 16), __uint_as_float(w.y & 0xffff0000u)};
              f32x4 v;
#pragma unroll
              for (int j = 0; j < 4; ++j) v[j] = acc[ai][bj][m][n][j] / (1.f + __expf(-fminf(fmaxf(b4[j], -40.f), 40.f)));
              store_bf4(mo + prow * 2048 + col, v);
            }
        }
        asm volatile("" ::: "memory"); SCHED;
      }
    } else {
      const float* rsl = (const float*)shm_raw;
      bf16_t* dst; int ld, c0; bool natural = false, isLow = false;
      if (pn < 4) { dst = (bf16_t*)(ws + O_GQ); ld = 1024; c0 = pn * 256; }
      else if (pn < 8) { dst = (bf16_t*)(ws + O_GK); ld = 1024; c0 = (pn - 4) * 256; }
      else if (pn < 16) { dst = (bf16_t*)(ws + O_GV); ld = 2048; c0 = (pn - 8) * 256; }
      else if (pn < 24) { dst = (bf16_t*)(ws + O_GR); ld = 2048; c0 = (pn - 16) * 256; }
      else if (pn == 24) { dst = nullptr; ld = 32; c0 = 0; isLow = true; }
      else if (pn < 33) { dst = (bf16_t*)(ws + O_DQ); ld = 2048; c0 = (pn - 25) * 256; }
      else if (pn < 41) { dst = (bf16_t*)(ws + O_DK); ld = 2048; c0 = (pn - 33) * 256; }
      else if (pn < 49) { dst = (bf16_t*)(ws + O_DV); ld = 2048; c0 = (pn - 41) * 256; }
      else if (pn < 57) { dst = (bf16_t*)P.out; ld = 2048; c0 = (pn - 49) * 256; natural = true; }
      else { dst = (bf16_t*)P.out + (size_t)TR * 2048; ld = 2048; c0 = (pn - 57) * 256; natural = true; }
      float* low = (float*)(ws + O_LOW);
      bool single = false;
      if (meta && pn >= 25) { single = true; if (pn >= 33 && pn < 41) dst = (bf16_t*)(ws + O_DKM); else if (pn >= 41 && pn < 49) dst = (bf16_t*)(ws + O_DVM); else natural = true; }
      if (!(meta && natural)) {
#pragma unroll
        for (int ai = 0; ai < 2; ++ai)
#pragma unroll
          for (int m = 0; m < 4; ++m) {
            const int r = ai * 128 + wr * 64 + m * 16 + fr;
            if (meta && r >= 64) continue;
            const size_t prow = arow0 + r, nrow = nrow0 + r;
            const float rs = rsl[r];
            const bool zero = meta && r < 48;
            if (!meta && !isLow) {
#pragma unroll
              for (int bj = 0; bj < 2; ++bj)
                store_bf8(dst + (natural ? nrow : prow) * ld + c0 + bj * 128 + wc * 32 + fq * 8, acc[ai][bj][m][0] * rs, acc[ai][bj][m][1] * rs);
            } else
#pragma unroll
            for (int bj = 0; bj < 2; ++bj)
#pragma unroll
              for (int n = 0; n < 2; ++n) {
                const int cc = bj * 128 + wc * 32 + fq * 8 + n * 4;
                f32x4 v = acc[ai][bj][m][n] * rs;
                if (zero) v = (f32x4){0.f, 0.f, 0.f, 0.f};
                if (isLow) {
                  if (cc < 32) { if (meta) { for (int b4 = 0; b4 < 4; ++b4) *(f32x4*)(low + (size_t)(b4 * LP + r) * 32 + cc) = v; } else *(f32x4*)(low + prow * 32 + cc) = v; }
                } else if (single) {
                  store_bf4(dst + (size_t)r * ld + c0 + cc, v);
                } else if (meta) {
                  for (int b4 = 0; b4 < 4; ++b4) store_bf4(dst + (size_t)(b4 * LP + r) * ld + c0 + cc, v);
                } else {
                  store_bf4(dst + (natural ? nrow : prow) * ld + c0 + cc, v);
                }
              }
            asm volatile("" ::: "memory"); SCHED;
          }
      }
    }
    asm volatile("s_waitcnt vmcnt(0)" ::: "memory");
    __syncthreads();
    if (gp == G_WIN_A && t < nPre && tid == 0) {
      __builtin_amdgcn_fence(__ATOMIC_RELEASE, "agent");
      asm volatile("s_waitcnt vmcnt(0)" ::: "memory");
      __hip_atomic_fetch_add((unsigned*)(ws + O_MCNT), 1u, __ATOMIC_RELAXED, __HIP_MEMORY_SCOPE_AGENT);
    }
  }
}

struct TReg { f32x4 v[8]; };
DEV void tt_load(const float* __restrict__ src, int K, int N, const float* __restrict__ gain, int tk, int tn, TReg& r) {
  const int tid = threadIdx.x, k0 = tk * 128, n0 = tn * 128;
#pragma unroll
  for (int i = 0; i < 8; ++i) {
    const int kr = i * 16 + (tid >> 5), nc = (tid & 31) * 4;
    f32x4 v = (f32x4){0.f, 0.f, 0.f, 0.f};
    if (n0 + nc < N) v = *(const f32x4*)(src + (size_t)(k0 + kr) * N + n0 + nc);
    if (gain) v = v * gain[k0 + kr];
    r.v[i] = v;
  }
}
DEV void tt_store(int K, int N, bf16_t* __restrict__ dst, bool winmap, int tk, int tn, const TReg& r) {
  const int tid = threadIdx.x;
  bf16_t* T = shm;
  const int k0 = tk * 128, n0 = tn * 128;
  __syncthreads();
#pragma unroll
  for (int i = 0; i < 8; ++i) {
    const int kr = i * 16 + (tid >> 5), nc = (tid & 31) * 4;
    unsigned* tp = (unsigned*)(T + kr * 130 + nc);
    tp[0] = pk2(r.v[i][0], r.v[i][1]); tp[1] = pk2(r.v[i][2], r.v[i][3]);
  }
  __syncthreads();
  const int nr = tid >> 2, n = n0 + nr;
  if (n < N) {
    const int drow = winmap ? (n < 6176 ? n : n + 224) : n;
#pragma unroll
    for (int q = 0; q < 4; ++q) {
      const int kk = (tid & 3) * 8 + q * 32;
      unsigned short e[8];
#pragma unroll
      for (int i = 0; i < 8; ++i) e[i] = T[(kk + i) * 130 + nr];
      u32x4 w; w.x = e[0] | ((unsigned)e[1] << 16); w.y = e[2] | ((unsigned)e[3] << 16); w.z = e[4] | ((unsigned)e[5] << 16); w.w = e[6] | ((unsigned)e[7] << 16);
      *(u32x4*)(dst + (size_t)drow * K + k0 + kk) = w;
    }
  }
}

DEV void transpose_job(const float* src, int K, int N, bf16_t* dst, const float* gain, bool winmap, int& tbase, int& t) {
  const int ntn = (N + 127) / 128, nt = (K / 128) * ntn, tend = tbase + nt;
  TReg cur, nxt;
  if (t < tend) { const int l = t - tbase; tt_load(src, K, N, gain, l / ntn, l % ntn, cur); }
  while (t < tend) {
    const int l = t - tbase, t2 = t + gridDim.x;
    if (t2 < tend) { const int l2 = t2 - tbase; tt_load(src, K, N, gain, l2 / ntn, l2 % ntn, nxt); }
    tt_store(K, N, dst, winmap, l / ntn, l % ntn, cur);
    cur = nxt; t = t2;
  }
  tbase += nt;
}

DEV void phase_prologue(const Params& P) {
  unsigned char* ws = P.ws;
  const int tid = threadIdx.x, gtid = blockIdx.x * NTHR + tid, gsz = gridDim.x * NTHR;
  { u32x4* z = (u32x4*)((bf16_t*)(ws + O_WIN) + (size_t)6176 * 2048); const int nz = 224 * 2048 / 8;
    for (int i = gtid; i < nz; i += gsz) z[i] = (u32x4){0u, 0u, 0u, 0u}; }
  { const int gw = (blockIdx.x * NTHR + tid) >> 6, nw = gsz >> 6, lane = tid & 63;
    bf16_t* xb = (bf16_t*)(ws + O_ACTB); float* st0 = (float*)(ws + O_ST);
    for (int r = gw; r < TR + 16; r += nw) {
      const float* src; size_t prow;
      if (r < TR) { src = P.x + (size_t)r * 2048; prow = (size_t)(r >> 12) * LP + 64 + (r & 4095); } else { src = P.meta + (size_t)(r - TR) * 2048; prow = 48 + (r - TR); }
      float ss = 0.f;
#pragma unroll
      for (int i = 0; i < 8; ++i) { const int c = i * 256 + lane * 4; f32x4 v = *(const f32x4*)(src + c); ss += v[0] * v[0] + v[1] * v[1] + v[2] * v[2] + v[3] * v[3]; store_bf4(xb + prow * 2048 + c, v); }
#pragma unroll
      for (int o = 32; o >= 1; o >>= 1) ss += __shfl_xor(ss, o);
      if (lane == 0) st0[prow] = ss;
    } }
  int tbase = 0, t = blockIdx.x;
  bf16_t* wf = (bf16_t*)(ws + O_WF); bf16_t* wsq = (bf16_t*)(ws + O_WS);
  transpose_job(P.w1g, 2048, DFF, wf + (size_t)DFF * 2048, P.n1, false, tbase, t);
  transpose_job(P.w1u, 2048, DFF, wf + (size_t)2 * DFF * 2048, P.n1, false, tbase, t);
  transpose_job(P.w1d, DFF, 2048, wf, nullptr, false, tbase, t);
  transpose_job(P.win, 2048, INW, (bf16_t*)(ws + O_WIN), P.nmix, true, tbase, t);
  transpose_job(P.wbg, 2048, 2048, wsq, nullptr, false, tbase, t);
  transpose_job(P.wbd, 2048, 2048, wsq + (size_t)2048 * 2048, nullptr, false, tbase, t);
  transpose_job(P.wout, 2048, 2048, wsq + (size_t)2 * 2048 * 2048, nullptr, false, tbase, t);
}

DEV f32x4 mfma16(bf16x8 a, bf16x8 b, f32x4 c) { return __builtin_amdgcn_mfma_f32_16x16x32_bf16(a, b, c, 0, 0, 0); }
#define LD8(p) (*reinterpret_cast<const bf16x8*>(p))

DEV void gla_prep_unit(const Params& P, int u, bool dummy = false) {
  unsigned char* ws = P.ws;
  const bool st_ok = !dummy || (P.ws == nullptr);
  int tid = threadIdx.x; asm volatile("" : "+v"(tid));
  const int w = tid >> 6, lane = tid & 63, fr = lane & 15, fq = lane >> 4;
  const int c = u % 65, bh = u / 65, b = bh >> 2, h = bh & 3;
  bf16_t* QD0 = shm; bf16_t* KI0 = QD0 + 64 * 264; bf16_t* QD1 = KI0 + 64 * 264; bf16_t* KI1 = QD1 + 64 * 264;
  float* LOWs = (float*)(KI1 + 64 * 264);
  bf16_t* gq = (bf16_t*)(ws + O_GQ); bf16_t* gk = (bf16_t*)(ws + O_GK);
  const size_t prow0 = (size_t)b * LP + c * 64;
  const int dir = tid >> 8, k = tid & 255, col = h * 256 + k;
  unsigned qk[64];
#pragma unroll
  for (int tt = 0; tt < 64; ++tt) { const int t = dir ? 63 - tt : tt; qk[tt] = (unsigned)gq[(prow0 + t) * 1024 + col] | ((unsigned)gk[(prow0 + t) * 1024 + col] << 16); }
  __syncthreads();
  { const int idx = tid * 4, row = idx >> 5, cl = idx & 31;
    *(f32x4*)(LOWs + idx) = *(const f32x4*)((const float*)(ws + O_LOW) + (prow0 + row) * 32 + cl); }
  __syncthreads();
  {
    const float* wa2 = dir ? P.wa2b : P.wa2f;
    float wv[16];
#pragma unroll
    for (int r = 0; r < 16; ++r) wv[r] = wa2[r * 1024 + col];
    const float bias = (dir ? P.bab : P.baf)[col];
    bf16_t* QD = dir ? QD1 : QD0; bf16_t* KI = dir ? KI1 : KI0;
    float bc = 0.f;
#pragma unroll
    for (int tt = 0; tt < 64; ++tt) {
      const int t = dir ? 63 - tt : tt;
      const f32x4* lr = (const f32x4*)(LOWs + t * 32 + dir * 16);
      const f32x4 l0 = lr[0], l1 = lr[1], l2 = lr[2], l3 = lr[3];
      float z = bias;
#pragma unroll
      for (int r = 0; r < 4; ++r) { z = fmaf(l0[r], wv[r], z); z = fmaf(l1[r], wv[4 + r], z); z = fmaf(l2[r], wv[8 + r], z); z = fmaf(l3[r], wv[12 + r], z); }
      const float ls = fminf(z, 0.f) - __logf(1.f + __expf(-fabsf(z)));
      const bool valid = !(c == 0 && t < 48);
      bc += valid ? ls * 0.0625f : 0.f;
      const float e = __expf(bc), ei = __expf(-bc);
      QD[t * 264 + k] = f2bf(__uint_as_float(qk[tt] << 16) * e * 0.0625f);
      KI[t * 264 + k] = f2bf(__uint_as_float(qk[tt] & 0xffff0000u) * ei);
    }
    if (st_ok) ((float*)(ws + O_DL))[((size_t)(bh * 2 + dir) * 65 + c) * 256 + k] = __expf(bc);
  }
  __syncthreads();
  if (c >= 1) {
    const int d = w >> 2, ti = w & 3;
    const bf16_t* QD = d ? QD1 : QD0; const bf16_t* KI = d ? KI1 : KI0;
    bf16_t* Pg = (bf16_t*)(ws + O_P) + (size_t)u * 4096;
#pragma unroll
    for (int tj = 0; tj < 4; ++tj) {
      f32x4 a4 = (f32x4){0.f, 0.f, 0.f, 0.f};
#pragma unroll
      for (int kk = 0; kk < 8; ++kk) a4 = mfma16(LD8(QD + (ti * 16 + fr) * 264 + kk * 32 + fq * 8), LD8(KI + (tj * 16 + fr) * 264 + kk * 32 + fq * 8), a4);
#pragma unroll
      for (int r = 0; r < 4; ++r) { const int i = ti * 16 + fq * 4 + r, j = tj * 16 + fr; const bool keep = d ? (j > i) : (j <= i); if (keep && st_ok) Pg[i * 64 + j] = f2bf(a4[r]); }
    }
  }
  bf16_t* qdb = (bf16_t*)(ws + O_QDB); bf16_t* kib = (bf16_t*)(ws + O_KIB);
#pragma unroll
  for (int i = 0; i < 4; ++i) {
    const int p = tid + 512 * i, tok = p >> 5, kc = (p & 31) * 8;
    const size_t g = (prow0 + tok) * 1024 + h * 256 + kc;
    if (st_ok) { *(u32x4*)(gq + g) = *(const u32x4*)(QD0 + tok * 264 + kc);
    *(u32x4*)(qdb + g) = *(const u32x4*)(QD1 + tok * 264 + kc); }
  }
  {
    const bf16_t* KI = dir ? KI1 : KI0;
    bf16_t* dst = (dir ? kib : gk) + (prow0 + (k >> 2)) * 1024 + h * 256 + (k & 3) * 64;
#pragma unroll
    for (int q = 0; q < 8; ++q) {
      unsigned e[8];
#pragma unroll
      for (int i = 0; i < 8; ++i) e[i] = KI[(q * 8 + i) * 264 + k];
      u32x4 wv4; wv4.x = e[0] | (e[1] << 16); wv4.y = e[2] | (e[3] << 16); wv4.z = e[4] | (e[5] << 16); wv4.w = e[6] | (e[7] << 16);
      if (st_ok) *(u32x4*)(dst + q * 8) = wv4;
    }
  }
  __syncthreads();
  bf16_t* gv = (bf16_t*)(ws + O_GV);
  bf16_t* VN = shm;
#pragma unroll
  for (int q = 0; q < 8; ++q) {
    const int p = tid + 512 * q, tok = p >> 6, vc = (p & 63) * 8;
    *(u32x4*)(VN + tok * 520 + vc) = *(const u32x4*)(gv + (prow0 + tok) * 2048 + h * 512 + vc);
  }
  __syncthreads();
  {
    const int v = tid;
    bf16_t* dst = gv + (prow0 + (v >> 3)) * 2048 + h * 512 + (v & 7) * 64;
#pragma unroll
    for (int q = 0; q < 8; ++q) {
      unsigned e[8];
#pragma unroll
      for (int i = 0; i < 8; ++i) e[i] = VN[(q * 8 + i) * 520 + v];
      u32x4 wv4; wv4.x = e[0] | (e[1] << 16); wv4.y = e[2] | (e[3] << 16); wv4.z = e[4] | (e[5] << 16); wv4.w = e[6] | (e[7] << 16);
      if (st_ok) *(u32x4*)(dst + q * 8) = wv4;
    }
  }
}

DEV void gla_scan_unit(const Params& P, int u) {
  unsigned char* ws = P.ws;
  int tid = threadIdx.x; asm volatile("" : "+v"(tid));
  const int w = tid >> 6, lane = tid & 63, fr = lane & 15, fq = lane >> 4;
  const int xj = u >> 3, sl = xj & 7, grp = (xj >> 3) * 8 + (u & 7);
  const int b = grp >> 3, h = (grp >> 1) & 3, dir = grp & 1;
  bf16_t* QDs = shm;
  bf16_t* KIT = QDs + 64 * 264;
  bf16_t* VT = KIT + 256 * 72;
  bf16_t* SBs = VT + 64 * 72;
  const bf16_t* qsrc = (const bf16_t*)(ws + (dir ? O_QDB : O_GQ));
  const bf16_t* ksrc = (const bf16_t*)(ws + (dir ? O_KIB : O_GK));
  const bf16_t* vsrc = (const bf16_t*)(ws + O_GV);
  const float* dlp = (const float*)(ws + O_DL) + (size_t)((b * 4 + h) * 2 + dir) * 65 * 256;
  bf16_t* osrc = (bf16_t*)P.out + (size_t)dir * TR * 2048;
  f32x4 S[2][4];
#pragma unroll
  for (int a = 0; a < 4; ++a) { S[0][a] = (f32x4){0.f, 0.f, 0.f, 0.f}; S[1][a] = (f32x4){0.f, 0.f, 0.f, 0.f}; }
  u32x4 rqA[4], rkA[4], rvA, rqB[4], rkB[4], rvB; f32x4 rdA0, rdA1, rdB0, rdB1;
  const int nsteps = dir ? 64 : 65;
#define SCAN_LOAD(RQ, RK, RV, RD0, RD1, cc) do { const size_t pr0 = (size_t)b * LP + (cc) * 64; \
    _Pragma("unroll") for (int i = 0; i < 4; ++i) { const int p = tid + 512 * i; \
      { const int tok = p >> 5, kc = (p & 31) * 8; RQ[i] = *(const u32x4*)(qsrc + (pr0 + tok) * 1024 + h * 256 + kc); } \
      { const int kr = p >> 3, tc = (p & 7) * 8; RK[i] = *(const u32x4*)(ksrc + (pr0 + (kr >> 2)) * 1024 + h * 256 + (kr & 3) * 64 + tc); } } \
    { const int vv = sl * 64 + (tid >> 3), tc = (tid & 7) * 8; RV = *(const u32x4*)(vsrc + (pr0 + (vv >> 3)) * 2048 + h * 512 + (vv & 7) * 64 + tc); } \
    RD0 = *(const f32x4*)(dlp + (cc) * 256 + (2 * w) * 16 + fq * 4); RD1 = *(const f32x4*)(dlp + (cc) * 256 + (2 * w + 1) * 16 + fq * 4); } while (0)
#define SCAN_STEP(RQ, RK, RV, RD0, RD1, s_) do { \
    const int c = dir ? 64 - (s_) : (s_); \
    const bool do_o = dir ? true : (c >= 1), do_upd = dir ? (c >= 2) : (c <= 63); \
    __syncthreads(); \
    _Pragma("unroll") for (int i = 0; i < 4; ++i) { const int p = tid + 512 * i; \
      *(u32x4*)(QDs + (p >> 5) * 264 + (p & 31) * 8) = RQ[i]; \
      *(u32x4*)(KIT + (p >> 3) * 72 + (p & 7) * 8) = RK[i]; } \
    *(u32x4*)(VT + (tid >> 3) * 72 + (tid & 7) * 8) = RV; \
    _Pragma("unroll") for (int vt = 0; vt < 4; ++vt) _Pragma("unroll") for (int kt = 0; kt < 2; ++kt) { \
        u32x2 pw; pw.x = pk2(S[kt][vt][0], S[kt][vt][1]); pw.y = pk2(S[kt][vt][2], S[kt][vt][3]); \
        *(u32x2*)(SBs + (vt * 16 + fr) * 264 + (2 * w + kt) * 16 + fq * 4) = pw; } \
    const f32x4 dl0 = RD0, dl1 = RD1; \
    __syncthreads(); \
    if ((s_) + 2 < nsteps) SCAN_LOAD(RQ, RK, RV, RD0, RD1, dir ? 64 - ((s_) + 2) : (s_) + 2); \
    if (do_o) { \
      const int ti = w >> 1; \
      _Pragma("unroll") for (int jj = 0; jj < 2; ++jj) { \
        const int tj = (w & 1) * 2 + jj; \
        f32x4 a4 = (f32x4){0.f, 0.f, 0.f, 0.f}; \
        _Pragma("unroll") for (int kk = 0; kk < 8; ++kk) a4 = mfma16(LD8(SBs + (tj * 16 + fr) * 264 + kk * 32 + fq * 8), LD8(QDs + (ti * 16 + fr) * 264 + kk * 32 + fq * 8), a4); \
        const size_t nrow = (size_t)b * SEQ + (c - 1) * 64 + ti * 16 + fr; \
        store_bf4(osrc + nrow * 2048 + h * 512 + sl * 64 + tj * 16 + fq * 4, a4); } } \
    if (do_upd) { \
      _Pragma("unroll") for (int kt = 0; kt < 2; ++kt) _Pragma("unroll") for (int vt = 0; vt < 4; ++vt) { \
          _Pragma("unroll") for (int kk = 0; kk < 2; ++kk) S[kt][vt] = mfma16(LD8(KIT + ((2 * w + kt) * 16 + fr) * 72 + kk * 32 + fq * 8), LD8(VT + (vt * 16 + fr) * 72 + kk * 32 + fq * 8), S[kt][vt]); \
          S[kt][vt] = S[kt][vt] * (kt ? dl1 : dl0); } } \
  } while (0)
  SCAN_LOAD(rqA, rkA, rvA, rdA0, rdA1, dir ? 64 : 0);
  SCAN_LOAD(rqB, rkB, rvB, rdB0, rdB1, dir ? 63 : 1);
  for (int s = 0; s < nsteps; s += 2) {
    SCAN_STEP(rqA, rkA, rvA, rdA0, rdA1, s);
    if (s + 1 < nsteps) SCAN_STEP(rqB, rkB, rvB, rdB0, rdB1, s + 1);
  }
#undef SCAN_STEP
#undef SCAN_LOAD
}

DEV void gla_finish_unit(const Params& P, int u, bool dummy = false) {
  unsigned char* ws = P.ws;
  const bool st_ok = !dummy || (P.ws == nullptr);
  int tid = threadIdx.x; asm volatile("" : "+v"(tid));
  const int w = tid >> 6, lane = tid & 63, fr = lane & 15, fq = lane >> 4;
  const int c = (u & 63) + 1, bh = u >> 6, b = bh >> 2, h = bh & 3;
  bf16_t* VTf = shm;
  bf16_t* Pl = VTf + 512 * 72;
  float* red = (float*)(Pl + 64 * 72);
  const size_t prow0 = (size_t)b * LP + c * 64, nrow0 = (size_t)b * SEQ + (c - 1) * 64;
  const bf16_t* gv = (const bf16_t*)(ws + O_GV);
  __syncthreads();
  { const int i = tid >> 3, j0 = (tid & 7) * 8;
    *(u32x4*)(Pl + i * 72 + j0) = *(const u32x4*)((const bf16_t*)(ws + O_P) + (size_t)(bh * 65 + c) * 4096 + i * 64 + j0); }
#pragma unroll
  for (int q = 0; q < 8; ++q) {
    const int p = tid + 512 * q, v = p >> 3, tc = (p & 7) * 8;
    *(u32x4*)(VTf + v * 72 + tc) = *(const u32x4*)(gv + (prow0 + (v >> 3)) * 2048 + h * 512 + (v & 7) * 64 + tc);
  }
  __syncthreads();
  f32x4 acc[4][4];
  const bf16_t* of = (const bf16_t*)P.out; const bf16_t* ob = of + (size_t)TR * 2048;
  float ss[4] = {0.f, 0.f, 0.f, 0.f};
#pragma unroll
  for (int vt = 0; vt < 4; ++vt)
#pragma unroll
    for (int it = 0; it < 4; ++it) {
      f32x4 a4 = (f32x4){0.f, 0.f, 0.f, 0.f};
#pragma unroll
      for (int kk = 0; kk < 2; ++kk) a4 = mfma16(LD8(VTf + (w * 64 + vt * 16 + fr) * 72 + kk * 32 + fq * 8), LD8(Pl + (it * 16 + fr) * 72 + kk * 32 + fq * 8), a4);
      const size_t g = (nrow0 + it * 16 + fr) * 2048 + h * 512 + w * 64 + vt * 16 + fq * 4;
      a4 = a4 + load_bf4(of + g) + load_bf4(ob + g);
      acc[vt][it] = a4;
      ss[it] += a4[0] * a4[0] + a4[1] * a4[1] + a4[2] * a4[2] + a4[3] * a4[3];
    }
#pragma unroll
  for (int it = 0; it < 4; ++it) { float s2 = ss[it]; s2 += __shfl_xor(s2, 16); s2 += __shfl_xor(s2, 32); if (fq == 0) red[w * 64 + it * 16 + fr] = s2; }
  __syncthreads();
  bf16_t* gr = (bf16_t*)(ws + O_GR);
#pragma unroll
  for (int it = 0; it < 4; ++it) {
    float tot = 0.f;
#pragma unroll
    for (int ww = 0; ww < 8; ++ww) tot += red[ww * 64 + it * 16 + fr];
    const float rs = rsqrtf(tot * (1.f / 512.f) + EPS);
#pragma unroll
    for (int vt = 0; vt < 4; ++vt) {
      const int vcol = w * 64 + vt * 16 + fq * 4;
      bf16_t* gp = gr + (prow0 + it * 16 + fr) * 2048 + h * 512 + vcol;
      const f32x4 g4 = load_bf4(gp), nw = *(const f32x4*)(P.gnorm + vcol);
      f32x4 y;
#pragma unroll
      for (int j = 0; j < 4; ++j) y[j] = acc[vt][it][j] * rs * nw[j] * (g4[j] * sigm(g4[j]));
      if (st_ok) store_bf4(gp, y);
    }
  }
}

constexpr int QBLK = 32, KVBLK = 64;
constexpr float ASCALE = 0.088388347648318440f;
constexpr float ATHR = 8.f;
constexpr int LDA_ = 2048;
constexpr size_t SHM_V = KVBLK * 128 * 2, SHM_K = KVBLK * 128 * 2, SHM_ATTN = 2 * SHM_V + 2 * SHM_K + 8 * 64 * 4;
#define KSWZ(row, colB) ((row) * 256 + ((colB) ^ (((row) & 7) << 4)))
#define SBAR() __builtin_amdgcn_sched_barrier(0)
DEV int crow(int r, int hi) { return (r & 3) + 8 * (r >> 2) + 4 * hi; }

template <int MODE> DEV void alibi(f32x16& p0, f32x16& p1, float base, float nslope) {
#pragma unroll
  for (int r = 0; r < 16; ++r) {
    const float cc = (float)((r & 3) + 8 * (r >> 2));
    p0[r] = fmaf(nslope, fabsf(base - cc), p0[r]);
    p1[r] = fmaf(nslope, fabsf(base - cc - 32.f), p1[r]);
    if (MODE == 1) { p0[r] = -1e30f; if (r < 8) p1[r] = -1e30f; }
    if (MODE == 2) { p0[r] = -1e30f; p1[r] = -1e30f; }
  }
}
DEV void partialSM(f32x16& p0, f32x16& p1, float& m_reg, float& mn, float& alpha) {
  constexpr float C = ASCALE * 1.4426950408889634f;
  float pmax = p0[0];
#pragma unroll
  for (int r = 1; r < 16; ++r) pmax = fmaxf(pmax, p0[r]);
#pragma unroll
  for (int r = 0; r < 16; ++r) pmax = fmaxf(pmax, p1[r]);
  { auto rr = __builtin_amdgcn_permlane32_swap(__float_as_uint(pmax), __float_as_uint(pmax), false, false);
    pmax = fmaxf(__uint_as_float(rr[0]), __uint_as_float(rr[1])); }
  if (__builtin_expect(__all(pmax - m_reg <= ATHR / ASCALE), 1)) { mn = m_reg; alpha = 1.f; }
  else { mn = fmaxf(m_reg, pmax); alpha = __builtin_amdgcn_exp2f((m_reg - mn) * C); m_reg = mn; }
  const float mnC = -mn * C;
#pragma unroll
  for (int r = 0; r < 16; ++r) p0[r] = fmaf(p0[r], C, mnC);
#pragma unroll
  for (int r = 0; r < 16; ++r) p1[r] = fmaf(p1[r], C, mnC);
#pragma unroll
  for (int r = 0; r < 16; ++r) p0[r] = __builtin_amdgcn_exp2f(p0[r]);
}
DEV void finishSM(f32x16& p0, f32x16& p1, float alpha, float& l_reg, bf16x8& pa0, bf16x8& pa1, bf16x8& pa2, bf16x8& pa3) {
#pragma unroll
  for (int r = 0; r < 16; ++r) p1[r] = __builtin_amdgcn_exp2f(p1[r]);
  float ps = 0;
#pragma unroll
  for (int r = 0; r < 16; ++r) ps += p0[r];
#pragma unroll
  for (int r = 0; r < 16; ++r) ps += p1[r];
  { auto rr = __builtin_amdgcn_permlane32_swap(__float_as_uint(ps), __float_as_uint(ps), false, false);
    ps = __uint_as_float(rr[0]) + __uint_as_float(rr[1]); }
  l_reg = l_reg * alpha + ps;
#define PK4(P_, BASE, OUT) do { unsigned a0 = pk2(P_[BASE + 0], P_[BASE + 1]), a1 = pk2(P_[BASE + 2], P_[BASE + 3]);   \
    unsigned b0 = pk2(P_[BASE + 4], P_[BASE + 5]), b1 = pk2(P_[BASE + 6], P_[BASE + 7]);                              \
    auto r0 = __builtin_amdgcn_permlane32_swap(a0, b0, false, false); auto r1 = __builtin_amdgcn_permlane32_swap(a1, b1, false, false); \
    u32x4 w_ = {r0[0], r1[0], r0[1], r1[1]}; OUT = *reinterpret_cast<bf16x8*>(&w_); } while (0)
  PK4(p0, 0, pa0); PK4(p0, 8, pa1); PK4(p1, 0, pa2); PK4(p1, 8, pa3);
#undef PK4
}
DEV void qkt(f32x16& p0, f32x16& p1, const bf16_t* Ks, const bf16x8* qr, int r32, int hi) {
  p0 = f32x16{}; p1 = f32x16{};
#pragma unroll
  for (int d0 = 0; d0 < 8; ++d0) { const int cb = (d0 * 16 + hi * 8) * 2;
    bf16x8 b0 = *reinterpret_cast<const bf16x8*>((const char*)Ks + KSWZ(r32, cb));
    bf16x8 b1 = *reinterpret_cast<const bf16x8*>((const char*)Ks + KSWZ(32 + r32, cb));
    p0 = __builtin_amdgcn_mfma_f32_32x32x16_bf16(b0, qr[d0], p0, 0, 0, 0);
    p1 = __builtin_amdgcn_mfma_f32_32x32x16_bf16(b1, qr[d0], p1, 0, 0, 0); }
}
DEV int v_st(int k, int c) { const int kk = (k & ~0xC) | ((k & 4) << 1) | ((k & 8) >> 1); return ((kk >> 3) * 4 + (c >> 5)) * 512 + ((kk & 7) * 32 + (c & 31)) * 2; }
DEV int v_rd_base(int lane) { return ((lane & 3) << 3) | (((lane >> 2) & 3) << 6) | (((lane >> 4) & 1) << 5) | (((lane >> 5) & 1) << 8); }
constexpr int v_rd_off(int d0, int ks, int half) { return d0 * 512 + ks * 4096 + half * 2048; }
template <int OFF> DEV s16x4 tr_read(int vb) { s16x4 r; asm volatile("ds_read_b64_tr_b16 %0, %1 offset:%2" : "=&v"(r) : "v"(vb), "i"(OFF) : "memory"); return r; }
template <int D0> DEV void pv_one(f32x16& od, int vb, bf16x8 pa0, bf16x8 pa1, bf16x8 pa2, bf16x8 pa3) {
  const s16x4 l0 = tr_read<v_rd_off(D0, 0, 0)>(vb), h0 = tr_read<v_rd_off(D0, 0, 1)>(vb), l1 = tr_read<v_rd_off(D0, 1, 0)>(vb), h1 = tr_read<v_rd_off(D0, 1, 1)>(vb);
  const s16x4 l2 = tr_read<v_rd_off(D0, 2, 0)>(vb), h2 = tr_read<v_rd_off(D0, 2, 1)>(vb), l3 = tr_read<v_rd_off(D0, 3, 0)>(vb), h3 = tr_read<v_rd_off(D0, 3, 1)>(vb);
  asm volatile("s_waitcnt lgkmcnt(0)" ::: "memory"); SBAR();
#define PK(L, H) (bf16x8){L[0], L[1], L[2], L[3], H[0], H[1], H[2], H[3]}
  od = __builtin_amdgcn_mfma_f32_32x32x16_bf16(pa0, PK(l0, h0), od, 0, 0, 0);
  od = __builtin_amdgcn_mfma_f32_32x32x16_bf16(pa1, PK(l1, h1), od, 0, 0, 0);
  od = __builtin_amdgcn_mfma_f32_32x32x16_bf16(pa2, PK(l2, h2), od, 0, 0, 0);
  od = __builtin_amdgcn_mfma_f32_32x32x16_bf16(pa3, PK(l3, h3), od, 0, 0, 0);
#undef PK
}
DEV void pv_d0(f32x16* o, int vb, bf16x8 pa0, bf16x8 pa1, bf16x8 pa2, bf16x8 pa3) {
  pv_one<0>(o[0], vb, pa0, pa1, pa2, pa3); pv_one<1>(o[1], vb, pa0, pa1, pa2, pa3); pv_one<2>(o[2], vb, pa0, pa1, pa2, pa3); pv_one<3>(o[3], vb, pa0, pa1, pa2, pa3);
}

DEV void attn_body(const bf16_t* __restrict__ Qb, const bf16_t* __restrict__ Kh, const bf16_t* __restrict__ Vh, const bf16_t* __restrict__ Km, const bf16_t* __restrict__ Vm, int qrel, float nslope, float slope, float kmax2, char* lds, f32x16 (&o)[4]) {
  int tid = threadIdx.x; asm volatile("" : "+v"(tid));
  const int wid = __builtin_amdgcn_readfirstlane(tid >> 6), lane = tid & 63, r32 = lane & 31, hi = lane >> 5;
  bf16_t* V_lds = (bf16_t*)lds; bf16_t* K_lds = (bf16_t*)(lds + 2 * SHM_V);
  float* wsl = (float*)(lds + 2 * SHM_V + 2 * SHM_K) + wid * 64; float* li_l = wsl; float* al_l = wsl + 32;
  float m_reg = -1e30f, l_reg = 0;
#pragma unroll
  for (int d = 0; d < 4; ++d) o[d] = f32x16{};
  bf16x8 qr[8];
  const bf16_t* Qw = Qb + (long)(wid * QBLK + r32) * LDA_ + hi * 8;
#pragma unroll
  for (int d0 = 0; d0 < 8; ++d0) qr[d0] = *reinterpret_cast<const bf16x8*>(Qw + d0 * 16);
  const float fbase = (float)(qrel + wid * QBLK + r32 - 4 * hi);
  const int sr = tid >> 4, sc = (tid & 15) * 8, vst0 = v_st(sr, sc), vst1 = v_st(32 + sr, sc);
  const int vb0 = (int)(uintptr_t)V_lds + v_rd_base(lane);
  struct { bf16x8 vs0, vs1, ks0, ks1; } sr_[2];
  float qn2 = 0.f;
#pragma unroll
  for (int d0 = 0; d0 < 8; ++d0)
#pragma unroll
    for (int e = 0; e < 8; ++e) { const float qv = __uint_as_float(((unsigned)(unsigned short)qr[d0][e]) << 16); qn2 = fmaf(qv, qv, qn2); }
  qn2 += __shfl_xor(qn2, 32);
#pragma unroll
  for (int of = 16; of >= 1; of >>= 1) qn2 = fmaxf(qn2, __shfl_xor(qn2, of));
  __syncthreads();
  if (lane == 0) wsl[0] = qn2;
  __syncthreads();
  { const float* w0 = (const float*)(lds + 2 * SHM_V + 2 * SHM_K); float mq = w0[0];
#pragma unroll
    for (int ww = 1; ww < 8; ++ww) mq = fmaxf(mq, w0[ww * 64]);
    qn2 = mq; }
  const float bnd = 2.f * ASCALE * sqrtf(qn2 * kmax2) * 1.02f + 1e-3f;
  const float dskip = fminf((104.f + bnd) / slope, 1e6f);
  int jlo = (int)ceilf(((float)(qrel - 63) - dskip) * (1.f / 64.f)); jlo = jlo < 0 ? 0 : jlo;
  int jhi = (int)floorf(((float)(qrel + 255) + dskip) * (1.f / 64.f)); jhi = jhi > 64 ? 64 : jhi;
  jlo = __builtin_amdgcn_readfirstlane(jlo); jhi = __builtin_amdgcn_readfirstlane(jhi);
  const int ntl = jhi - jlo + 1, NT = ntl + (ntl & 1);
#define TIDX(r) ((r) < ntl ? jlo + (r) : 65)
#define TCL(j) ((j) < 64 ? (j) : 64)
#define SLOAD(i, jt) do { const long k0_ = (long)TCL(jt) * KVBLK; const bf16_t* Vt_ = (jt) == 0 ? Vm : Vh; const bf16_t* Kt_ = (jt) == 0 ? Km : Kh; \
    sr_[i].vs0 = *reinterpret_cast<const bf16x8*>(&Vt_[(k0_ + sr) * LDA_ + sc]); sr_[i].vs1 = *reinterpret_cast<const bf16x8*>(&Vt_[(k0_ + 32 + sr) * LDA_ + sc]); \
    sr_[i].ks0 = *reinterpret_cast<const bf16x8*>(&Kt_[(k0_ + sr) * LDA_ + sc]); sr_[i].ks1 = *reinterpret_cast<const bf16x8*>(&Kt_[(k0_ + 32 + sr) * LDA_ + sc]); } while (0)
#define SWRITE(b, i) do { *(bf16x8*)((char*)V_lds + (b) * SHM_V + vst0) = sr_[i].vs0;          \
    *(bf16x8*)((char*)V_lds + (b) * SHM_V + vst1) = sr_[i].vs1; const int kc = sc * 2;               \
    *(bf16x8*)((char*)K_lds + (b) * SHM_K + KSWZ(sr, kc)) = sr_[i].ks0;                       \
    *(bf16x8*)((char*)K_lds + (b) * SHM_K + KSWZ(32 + sr, kc)) = sr_[i].ks1; } while (0)
#define SWAIT() asm volatile("s_waitcnt vmcnt(4)" ::: "memory")
#define RESC(a) do { if (__any((a) < 1.f)) { if (hi == 0) al_l[r32] = (a); asm volatile("s_waitcnt lgkmcnt(0)" ::: "memory"); \
    _Pragma("unroll") for (int d = 0; d < 4; ++d) _Pragma("unroll") for (int r = 0; r < 16; ++r) o[d][r] *= al_l[crow(r, hi)]; } } while (0)
  f32x16 pA0, pA1, pB0, pB1; float mnA, mnB, alA, alB; bf16x8 pa0, pa1, pa2, pa3;
  constexpr int SE = 0, SO = 1;
  __syncthreads();
  SLOAD(SE, jlo); asm volatile("s_waitcnt vmcnt(0)" ::: "memory"); SWRITE(0, SE); __syncthreads();
  qkt(pA0, pA1, K_lds, qr, r32, hi);
  if (jlo == 0) alibi<1>(pA0, pA1, fbase, nslope); else alibi<0>(pA0, pA1, fbase - 64.f * (float)jlo, nslope);
  partialSM(pA0, pA1, m_reg, mnA, alA);
  SLOAD(SO, TIDX(1)); SLOAD(SE, TIDX(2));
  SWAIT(); SWRITE(1, SO); __syncthreads();
  for (int j = 1; j + 1 < NT; j += 2) {
    SBAR(); qkt(pB0, pB1, (bf16_t*)((char*)K_lds + SHM_K), qr, r32, hi); alibi<0>(pB0, pB1, fbase - 64.f * (float)(jlo + j), nslope);
    finishSM(pA0, pA1, alA, l_reg, pa0, pa1, pa2, pa3); SBAR();
    SLOAD(SO, TIDX(j + 2)); SBAR();
    pv_d0(o, vb0, pa0, pa1, pa2, pa3); partialSM(pB0, pB1, m_reg, mnB, alB);
    __syncthreads(); SWAIT(); SWRITE(0, SE);
    RESC(alB); __syncthreads();
    SBAR(); qkt(pA0, pA1, K_lds, qr, r32, hi); alibi<0>(pA0, pA1, fbase - 64.f * (float)(jlo + j + 1), nslope);
    finishSM(pB0, pB1, alB, l_reg, pa0, pa1, pa2, pa3); SBAR();
    if (j + 3 < NT) SLOAD(SE, TIDX(j + 3)); SBAR();
    pv_d0(o, vb0 + (int)SHM_V, pa0, pa1, pa2, pa3); partialSM(pA0, pA1, m_reg, mnA, alA);
    __syncthreads(); SWAIT(); SWRITE(1, SO);
    RESC(alA); __syncthreads();
  }
  SBAR(); qkt(pB0, pB1, (bf16_t*)((char*)K_lds + SHM_K), qr, r32, hi);
  if (ntl & 1) alibi<2>(pB0, pB1, fbase, nslope); else alibi<0>(pB0, pB1, fbase - 64.f * (float)jhi, nslope);
  finishSM(pA0, pA1, alA, l_reg, pa0, pa1, pa2, pa3); SBAR();
  pv_d0(o, vb0, pa0, pa1, pa2, pa3); partialSM(pB0, pB1, m_reg, mnB, alB);
  __syncthreads(); RESC(alB);
  finishSM(pB0, pB1, alB, l_reg, pa0, pa1, pa2, pa3); SBAR();
  pv_d0(o, vb0 + (int)SHM_V, pa0, pa1, pa2, pa3);
  if (hi == 0) li_l[r32] = l_reg; asm volatile("s_waitcnt lgkmcnt(0)" ::: "memory");
#pragma unroll
  for (int r = 0; r < 16; ++r) { const float rl = __builtin_amdgcn_rcpf(li_l[crow(r, hi)]);
#pragma unroll
    for (int d = 0; d < 4; ++d) o[d][r] *= rl; }
#undef SLOAD
#undef SWRITE
#undef SWAIT
#undef RESC
#undef TCL
#undef TIDX
}

DEV void attn_unit(const Params& P, int u) {
  unsigned char* ws = P.ws;
  const int tid_ = threadIdx.x, wid = __builtin_amdgcn_readfirstlane(tid_ >> 6);
  const int cc_ = u & 255, b = u >> 8, hg = cc_ & 7, qblk = (cc_ >> 3) & 15, vh = (cc_ >> 7) & 1;
  const unsigned long long tlo = 0x4712560374216530ull, thi = 0x1247035621743065ull;
  const unsigned trow = (unsigned)((hg < 4 ? tlo >> (16 * hg) : thi >> (16 * (hg - 4))) & 0xffffull);
  const int h = (int)((trow >> (4 * b)) & 7u);
  const bf16_t* dq = (const bf16_t*)(ws + O_DQ); const bf16_t* dk = (const bf16_t*)(ws + O_DK); const bf16_t* dv = (const bf16_t*)(ws + O_DV);
  const size_t brow = (size_t)b * LP; const int qrel = 64 + qblk * 256;
  const float slope = __int_as_float(0x3f800000 - ((h + 1) << 23));
  const float nslope = -slope / ASCALE;
  unsigned* stash = (unsigned*)(shm_raw + SHM_ATTN);
  f32x16 o[4];
  for (int mp = 0; mp < 2; ++mp) {
    attn_body(dq + (brow + qrel) * 2048 + h * 256 + mp * 128, dk + brow * 2048 + h * 256 + mp * 128, dv + brow * 2048 + h * 256 + vh * 128,
              (const bf16_t*)(ws + O_DKM) + h * 256 + mp * 128, (const bf16_t*)(ws + O_DVM) + h * 256 + vh * 128, qrel, nslope, slope,
              __uint_as_float(((const unsigned*)(ws + O_KMAX))[b * 16 + h * 2 + mp]), (char*)shm_raw, o);
    if (mp == 0) {
      int tid = tid_; asm volatile("" : "+v"(tid));
#pragma unroll
      for (int d = 0; d < 4; ++d)
#pragma unroll
        for (int r = 0; r < 16; r += 2) stash[(d * 8 + (r >> 1)) * 512 + tid] = pk2(o[d][r], o[d][r + 1]);
    }
  }
  int tid = tid_; asm volatile("" : "+v"(tid));
  const int lane = tid & 63, r32 = lane & 31, hi = lane >> 5;
  const float lam = ((const float*)(shm_raw + DYN_LDS_MAIN + 8))[0];
  bf16_t* dd = (bf16_t*)(ws + O_DD); float* dst = (float*)(ws + O_DST);
  const size_t prow = brow + qrel + wid * 32;
  float ss[16];
#pragma unroll
  for (int r = 0; r < 16; ++r) ss[r] = 0.f;
#pragma unroll
  for (int d = 0; d < 4; ++d)
#pragma unroll
    for (int r = 0; r < 16; r += 2) {
      const unsigned s2 = stash[(d * 8 + (r >> 1)) * 512 + tid];
      const float v0 = __uint_as_float(s2 << 16) - lam * o[d][r], v1 = __uint_as_float(s2 & 0xffff0000u) - lam * o[d][r + 1];
      ss[r] += v0 * v0; ss[r + 1] += v1 * v1;
      dd[(prow + crow(r, hi)) * 2048 + h * 256 + vh * 128 + d * 32 + r32] = f2bf(v0);
      dd[(prow + crow(r + 1, hi)) * 2048 + h * 256 + vh * 128 + d * 32 + r32] = f2bf(v1);
    }
#pragma unroll
  for (int r = 0; r < 16; ++r) {
    float s = ss[r];
#pragma unroll
    for (int of = 16; of >= 1; of >>= 1) s += __shfl_xor(s, of);
    if (r32 == 0) dst[(prow + crow(r, hi)) * 16 + h * 2 + vh] = s;
  }
}

DEV void l2_sweep(const Params& P) {
  const f32x4* src = (const f32x4*)P.x + (size_t)(blockIdx.x & 63) * 131072;
  f32x4 a = (f32x4){0.f, 0.f, 0.f, 0.f};
  for (int i = threadIdx.x; i < 131072; i += NTHR) a += src[i];
  if (a[0] + a[1] + a[2] + a[3] == 123456.789f) ((float*)(P.ws + O_DST))[0] = 1.f;
}
#define XB_TMO      128
#define XB_XCNT(j)  (256  + 64 * (j))
#define XB_XSUB(j)  (1280 + 64 * (j))
#define XB_XGEN(j)  (2304 + 64 * (j))
#define XB_TOP      3328
#define XB_TOPGEN   3392
#define XCD_BAR_WORDS 3456
#define XB_SPIN_CAP (1u << 22)
DEV unsigned xb_ld(unsigned* p) { return __hip_atomic_load(p, __ATOMIC_RELAXED, __HIP_MEMORY_SCOPE_AGENT); }
DEV unsigned xb_add(unsigned* p, unsigned v) { return __hip_atomic_fetch_add(p, v, __ATOMIC_RELAXED, __HIP_MEMORY_SCOPE_AGENT); }
DEV unsigned xb_xcc_id() { return (unsigned)__builtin_amdgcn_s_getreg((3 << 11) | 20) & 0xFu; }
#define XB_SPIN(cond, bar) do { unsigned _sp = 0; while (cond) { __builtin_amdgcn_s_sleep(1); \
    if ((++_sp & 255u) == 0u) { if (xb_ld(&(bar)[XB_TMO])) break; if (_sp > XB_SPIN_CAP) { atomicAdd(&(bar)[XB_TMO], 1u); break; } } } } while (0)
struct XcdBarrier { unsigned* bar; unsigned x; volatile LAS unsigned* st; };
DEV XcdBarrier xcd_barrier_post(unsigned* bar, volatile LAS unsigned* st) {
  XcdBarrier b; b.bar = bar; b.x = xb_xcc_id(); b.st = st;
  if (threadIdx.x == 0) (void)xb_add(&bar[XB_XCNT(b.x)], 1u);
  return b;
}
DEV void xcd_barrier_complete(unsigned* bar, unsigned x, unsigned& nloc, unsigned& nx) {
  const unsigned G = gridDim.x * gridDim.y * gridDim.z;
  unsigned sum, cnt, mine, sp = 0u;
  for (;;) {
    sum = 0u; cnt = 0u; mine = 0u;
#pragma unroll
    for (unsigned j = 0; j < 16; ++j) { const unsigned c = xb_ld(&bar[XB_XCNT(j)]); sum += c; cnt += (c > 0u) ? 1u : 0u; mine = (j == x) ? c : mine; }
    if (sum == G) break;
    __builtin_amdgcn_s_sleep(1);
    if ((++sp & 255u) == 0u) { if (xb_ld(&bar[XB_TMO])) break; if (sp > XB_SPIN_CAP) { atomicAdd(&bar[XB_TMO], 1u); break; } }
  }
  nloc = mine > 0u ? mine : 1u; nx = cnt > 0u ? cnt : 1u;
}
DEV void xcd_barrier(const XcdBarrier& b) {
  asm volatile("s_waitcnt vmcnt(0) lgkmcnt(0)" ::: "memory");
  __syncthreads();
  if (threadIdx.x == 0) {
    unsigned* bar = b.bar;
    __builtin_amdgcn_s_waitcnt(0);
    unsigned nloc = b.st[0], nx = b.st[1];
    if (nloc == 0u) { xcd_barrier_complete(bar, b.x, nloc, nx); b.st[0] = nloc; b.st[1] = nx; }
    const unsigned old = xb_add(&bar[XB_XSUB(b.x)], 1u);
    const unsigned gen = old / nloc;
    if (old + 1u == (gen + 1u) * nloc) {
      __builtin_amdgcn_fence(__ATOMIC_RELEASE, "agent");
      asm volatile("s_waitcnt vmcnt(0)" ::: "memory");
      const unsigned og = xb_add(&bar[XB_TOP], 1u);
      const unsigned tg = og / nx;
      if (og + 1u == (tg + 1u) * nx) xb_add(&bar[XB_TOPGEN], 1u);
      else XB_SPIN(xb_ld(&bar[XB_TOPGEN]) == tg, bar);
      __builtin_amdgcn_fence(__ATOMIC_ACQUIRE, "agent");
      xb_add(&bar[XB_XGEN(b.x)], 1u);
      asm volatile("s_waitcnt vmcnt(0)" ::: "memory");
    } else {
      XB_SPIN(xb_ld(&bar[XB_XGEN(b.x)]) == gen, bar);
      __builtin_amdgcn_fence(__ATOMIC_ACQUIRE, "agent");
      asm volatile("s_waitcnt vmcnt(0)" ::: "memory");
    }
  }
  __syncthreads();
}
DEV void gsync_now(const Params& P) {
  XcdBarrier b; b.bar = (unsigned*)(P.ws + O_BAR); b.x = xb_xcc_id(); b.st = (volatile LAS unsigned*)((LAS unsigned char*)shm_raw + DYN_LDS_MAIN);
  xcd_barrier(b);
}
#define gsync(g) gsync_now(P)
#ifndef REP
#define REP 0
#endif
#ifndef DBG_STOP
#define DBG_STOP 0
#endif
DEV void dbg_dump(const Params& P, size_t off, int ld = 2048) {
  const int tid = threadIdx.x, lane = tid & 63, gw = (blockIdx.x * NTHR + tid) >> 6, nw = (gridDim.x * NTHR) >> 6;
  const bf16_t* buf = (const bf16_t*)(P.ws + off);
  for (int r = gw; r < TR; r += nw) {
    const size_t prow = (size_t)(r >> 12) * LP + 64 + (r & 4095);
    for (int i = 0; i < 8; ++i) { const int c = i * 256 + lane * 4; f32x4 v = (f32x4){0.f, 0.f, 0.f, 0.f}; if (c < ld) v = load_bf4(buf + prow * ld + c); for (int j = 0; j < 4; ++j) if (!(fabsf(v[j]) < 1e30f)) v[j] = 10000.f; *(f32x4*)(P.out + (size_t)r * 2048 + c) = v; }
  }
}
#define STOP_AT(k, off) if (DBG_STOP == (k)) { dbg_dump(P, off); return; }
#define STOP_AT2(k, off) if (DBG_STOP == (k)) { dbg_dump(P, off, 1024); return; }
#ifndef ONLY
#define PH(n) true
#else
#define PH(n) ((ONLY) == (n))
#endif
__global__ void __launch_bounds__(NTHR, 2) mega(Params P) {
  cg::grid_group grid = cg::this_grid();
  unsigned char* ws = P.ws;
  volatile LAS unsigned* xst = (volatile LAS unsigned*)((LAS unsigned char*)shm_raw + DYN_LDS_MAIN);
  if (threadIdx.x == 0) { xst[0] = 0u; xst[1] = 0u; xst[2] = 0u; xst[3] = 0u; }
  __syncthreads();
  (void)xcd_barrier_post((unsigned*)(ws + O_BAR), xst);
  if (P.ws == nullptr) grid.sync();
  if (PH(0)) phase_prologue(P);
  if (REP & 4) phase_prologue(P);
  gsync(grid);
  if (PH(1)) for (int gp = G_FFN1_GU; gp <= G_WIN_A; ++gp) { gemm_phase(P, gp); if ((REP & 1) || ((REP & 64) && gp == G_FFN1_GU) || ((REP & 128) && gp == G_FFN1_D)) gemm_phase(P, gp); gsync(grid); if (gp == G_FFN1_D) { STOP_AT(1, O_ACTB) } if (gp == G_WIN_META) { STOP_AT(6, O_GV) } }
  if (PH(2)) for (int u = blockIdx.x; u < 16 * 65; u += gridDim.x) gla_prep_unit(P, u);
  if (REP & 32) for (int u = blockIdx.x; u < 16 * 65; u += gridDim.x) gla_prep_unit(P, u, true);
  gsync(grid);
  STOP_AT2(7, O_KIB)
  STOP_AT2(10, O_QDB)
  if (DBG_STOP == 11) {
    const int tid = threadIdx.x, lane = tid & 63, gw = (blockIdx.x * NTHR + tid) >> 6, nw = (gridDim.x * NTHR) >> 6;
    const bf16_t* b0 = (const bf16_t*)(ws + O_GK); const bf16_t* b1 = (const bf16_t*)(ws + O_GV); const float* dl = (const float*)(ws + O_DL);
    for (int r = gw; r < TR; r += nw) { const size_t prow = (size_t)(r >> 6) * LP + (r & 63);
      for (int i = 0; i < 8; ++i) { const int c = i * 256 + lane * 4; f32x4 v = (f32x4){0.f, 0.f, 0.f, 0.f};
        if (r < 256) v = c < 1024 ? load_bf4(b0 + prow * 1024 + c) : load_bf4(b1 + prow * 2048 + c - 1024);
        else if (r < 272 && c < 256) v = *(const f32x4*)(dl + (size_t)((r - 256) * 2) * 65 * 256 + c);
        *(f32x4*)(P.out + (size_t)r * 2048 + c) = v; } }
    return;
  }
  if (DBG_STOP == 9) {
    const int tid = threadIdx.x, lane = tid & 63, gw = (blockIdx.x * NTHR + tid) >> 6, nw = (gridDim.x * NTHR) >> 6;
    const bf16_t* b0 = (const bf16_t*)(ws + O_GQ); const bf16_t* b1 = (const bf16_t*)(ws + O_GK);
    for (int r = gw; r < TR; r += nw) { const size_t prow = (size_t)(r >> 12) * LP + 64 + (r & 4095);
      for (int i = 0; i < 8; ++i) { const int c = i * 256 + lane * 4; *(f32x4*)(P.out + (size_t)r * 2048 + c) = c < 1024 ? load_bf4(b0 + prow * 1024 + c) : load_bf4(b1 + prow * 1024 + c - 1024); } }
    return;
  }
  if (PH(3)) for (int u = blockIdx.x; u < 256; u += gridDim.x) gla_scan_unit(P, u);
  if (REP & 8) for (int u = blockIdx.x; u < 256; u += gridDim.x) gla_scan_unit(P, u);
  gsync(grid);
  if (DBG_STOP == 8) {
    const int tid = threadIdx.x, lane = tid & 63, gw = (blockIdx.x * NTHR + tid) >> 6, nw = (gridDim.x * NTHR) >> 6;
    const bf16_t* of = (const bf16_t*)P.out; const bf16_t* ob = of + (size_t)TR * 2048; bf16_t* g = (bf16_t*)(ws + O_GR);
    for (int r = gw; r < TR; r += nw) { const size_t prow = (size_t)(r >> 12) * LP + 64 + (r & 4095);
      for (int i = 0; i < 8; ++i) { const int c = i * 256 + lane * 4; store_bf4(g + prow * 2048 + c, load_bf4(of + (size_t)r * 2048 + c) + load_bf4(ob + (size_t)r * 2048 + c)); } }
    gsync(grid);
    dbg_dump(P, O_GR); return;
  }
  if (PH(4)) for (int u = blockIdx.x; u < 1024; u += gridDim.x) gla_finish_unit(P, u);
  if (REP & 16) for (int u = blockIdx.x; u < 1024; u += gridDim.x) gla_finish_unit(P, u, true);
  gsync(grid);
  STOP_AT(2, O_GR)
  if (PH(1)) gemm_phase(P, G_WIN_B);
  if (REP & 1) gemm_phase(P, G_WIN_B);
  gsync(grid);
  if (PH(5)) {
    int tid = threadIdx.x; asm volatile("" : "+v"(tid)); const int lane = tid & 63;
    const int gw = (blockIdx.x * NTHR + tid) >> 6, nw = (gridDim.x * NTHR) >> 6;
    const int kb = gw & 3; const bf16_t* dk = (const bf16_t*)(ws + O_DK); const bf16_t* dkm = (const bf16_t*)(ws + O_DKM);
    unsigned* km = (unsigned*)(ws + O_KMAX);
    float mx = 0.f;
    for (int r = gw >> 2; r < SEQ + 16; r += nw >> 2) {
      const bf16_t* rowp = r < SEQ ? dk + ((size_t)kb * LP + 64 + r) * 2048 : dkm + (size_t)(48 + r - SEQ) * 2048;
      float ssq = 0.f;
#pragma unroll
      for (int i = 0; i < 8; ++i) { const f32x4 v = load_bf4(rowp + lane * 32 + i * 4); ssq += v[0] * v[0] + v[1] * v[1] + v[2] * v[2] + v[3] * v[3]; }
      ssq += __shfl_xor(ssq, 1); ssq += __shfl_xor(ssq, 2);
      mx = fmaxf(mx, ssq);
    }
    if ((lane & 3) == 0) atomicMax(km + kb * 16 + (lane >> 2), __float_as_uint(mx));
  }
  gsync(grid);
  if (PH(5)) {
    float s1 = 0.f, s2 = 0.f;
    for (int i = 0; i < 128; ++i) { s1 = fmaf(P.lq1[i], P.lk1[i], s1); s2 = fmaf(P.lq2[i], P.lk2[i], s2); }
    const float lam = __expf(s1) - __expf(s2) + 0.2f;
    { float* lw = (float*)(shm_raw + DYN_LDS_MAIN + 8); if (threadIdx.x == 0) lw[0] = lam; }
    __syncthreads();
    for (int u = blockIdx.x; u < 1024; u += gridDim.x) attn_unit(P, u);
    if (REP & 2) for (int u = blockIdx.x; u < 1024; u += gridDim.x) attn_unit(P, u);
  }
  gsync(grid);
  if (PH(6)) {
    int tid = threadIdx.x; asm volatile("" : "+v"(tid)); const int lane = tid & 63;
    const int gw = (blockIdx.x * NTHR + tid) >> 6, nw = (gridDim.x * NTHR) >> 6;
    bf16_t* dd = (bf16_t*)(ws + O_DD); const float* dst = (const float*)(ws + O_DST);
    for (int r = gw; r < TR; r += nw) {
      const size_t prow = (size_t)(r >> 12) * LP + 64 + (r & 4095);
      const int col = lane * 32, hh = col >> 8;
      const float rs = rsqrtf((dst[prow * 16 + hh * 2] + dst[prow * 16 + hh * 2 + 1]) * (1.f / 256.f) + EPS) * 0.8f;
#pragma unroll
      for (int i = 0; i < 8; ++i) { bf16_t* p = dd + prow * 2048 + col + i * 4; f32x4 v = load_bf4(p); const f32x4 nw4 = *(const f32x4*)(P.dnorm + ((col + i * 4) & 255)); v = v * nw4 * rs; store_bf4(p, v); }
    }
    int tbase = 0, t = blockIdx.x; bf16_t* wf = (bf16_t*)(ws + O_WF);
    transpose_job(P.w2g, 2048, DFF, wf + (size_t)DFF * 2048, P.n2, false, tbase, t);
    transpose_job(P.w2u, 2048, DFF, wf + (size_t)2 * DFF * 2048, P.n2, false, tbase, t);
    transpose_job(P.w2d, DFF, 2048, wf, nullptr, false, tbase, t);
  }
  gsync(grid);
  STOP_AT(3, O_DD)
  if (PH(1)) for (int gp = G_MERGE; gp <= G_FFN2_D; ++gp) { gemm_phase(P, gp); if (((REP & 1) && gp != G_FFN2_D) || ((REP & 256) && gp == G_OUT) || ((REP & 512) && gp == G_MERGE)) gemm_phase(P, gp); gsync(grid); if (gp == G_MERGE) { STOP_AT(4, O_MRG) } if (gp == G_OUT) { STOP_AT(5, O_ACTB) } }
  if (PH(7)) {
    int tid = threadIdx.x; asm volatile("" : "+v"(tid)); const int lane = tid & 63;
    const int gw = (blockIdx.x * NTHR + tid) >> 6, nw = (gridDim.x * NTHR) >> 6;
    for (int r = gw; r < TR; r += nw) {
      float* p = P.out + (size_t)r * 2048;
      f32x4 v[8]; float ss = 0.f;
#pragma unroll
      for (int i = 0; i < 8; ++i) { v[i] = *(f32x4*)(p + i * 256 + lane * 4); ss += v[i][0] * v[i][0] + v[i][1] * v[i][1] + v[i][2] * v[i][2] + v[i][3] * v[i][3]; }
#pragma unroll
      for (int o = 32; o >= 1; o >>= 1) ss += __shfl_xor(ss, o);
      const float rs = rsqrtf(ss * (1.f / 2048.f) + EPS);
#pragma unroll
      for (int i = 0; i < 8; ++i) { const int c = i * 256 + lane * 4; const f32x4 g = *(const f32x4*)(P.nfin + c); *(f32x4*)(p + c) = v[i] * g * rs; }
    }
  }
}

constexpr size_t DYN_LDS = DYN_LDS_MAIN + 16;
static_assert(DYN_LDS >= 8 * HT * 2 && DYN_LDS >= SHM_ATTN + 65536, "lds");

extern "C" void kernel_launch(void* const* d_in, const int* in_sizes, int n_in, void* d_out, int out_size, void* d_ws, size_t ws_size, hipStream_t stream) {
  if (n_in != 26 || ws_size < WS_TOTAL || out_size != TR * 2048) { fprintf(stderr, "kernel_launch: bad shapes n_in %d ws %zu need %zu out %d\n", n_in, ws_size, WS_TOTAL, out_size); return; }
  static int grid_blocks = 0;
  if (!grid_blocks) {
    hipFuncSetAttribute((const void*)mega, hipFuncAttributeMaxDynamicSharedMemorySize, (int)DYN_LDS);
    int dev = 0, cus = 0, per_cu = 0;
    hipGetDevice(&dev);
    hipDeviceGetAttribute(&cus, hipDeviceAttributeMultiprocessorCount, dev);
    hipOccupancyMaxActiveBlocksPerMultiprocessor(&per_cu, mega, NTHR, DYN_LDS);
    if (per_cu < 1) per_cu = 1;
    grid_blocks = cus;
  }
  Params p{};
  const float** pp = (const float**)&p;
  for (int i = 0; i < 26; ++i) pp[i] = (const float*)d_in[i];
  p.out = (float*)d_out; p.ws = (unsigned char*)d_ws;
  hipMemsetAsync((unsigned char*)d_ws + O_BAR, 0, 16384, stream);
  void* args[] = {&p};
  hipError_t e = hipLaunchCooperativeKernel((void*)mega, dim3(grid_blocks), dim3(NTHR), args, DYN_LDS, stream);
  if (e != hipSuccess) fprintf(stderr, "cooperative launch failed: %s (grid %d)\n", hipGetErrorString(e), grid_blocks);
}
```
